# Optimizing an MI355X kernel written in HIP

```python
import jax
import jax.numpy as jnp
from jax import lax
import numpy as np

D_MODEL = 1024
BATCH = 4
SEQ = 4096
DEPTH = 1

CTX_LEN = 256
GRID_W = 64
CHUNK = 64
EPS = 1e-6
GLA_HEADS = 4
GLA_DK = D_MODEL // 2
GLA_DV = D_MODEL
GLA_DK_HEAD = GLA_DK // GLA_HEADS
GLA_DV_HEAD = GLA_DV // GLA_HEADS
GLA_RANK = 16
GLA_TAU = 16.0
MLSTM_HEADS = 4
MLSTM_DK = D_MODEL // 2
MLSTM_DV = D_MODEL
MLSTM_DK_HEAD = MLSTM_DK // MLSTM_HEADS
MLSTM_DV_HEAD = MLSTM_DV // MLSTM_HEADS
MLSTM_CONV = 3
D_FF = -(-8 * D_MODEL // (3 * 256)) * 256
IN_SIZES = (GLA_DK, GLA_DK, GLA_DV, GLA_DV, 2 * GLA_RANK,
            MLSTM_DK, MLSTM_DK, MLSTM_DV, MLSTM_DV, 4 * MLSTM_HEADS,
            2 * D_MODEL)
N_IN = sum(IN_SIZES)

kernel_name = 'hybrid_gla_mlstm_prefix_dit_block'


def _rms_norm(x, g):
    xf = x.astype(jnp.float32)
    y = xf * lax.rsqrt(jnp.mean(xf * xf, axis=-1, keepdims=True) + EPS)
    return (y * g.astype(jnp.float32)).astype(x.dtype)


def _modulate(h, shift, scale):
    return h * (1 + scale) + shift


def _swiglu(u, w_in, w_out):
    a, b = jnp.split(u @ w_in, 2, axis=-1)
    return (jax.nn.silu(a) * b) @ w_out


def _split_cols(a):
    idx = [int(s) for s in np.cumsum(IN_SIZES)[:-1]]
    return jnp.split(a, idx, axis=-1)


def _heads(a, n):
    B, T, C = a.shape
    return a.reshape(B, T, n, C // n).transpose(0, 2, 1, 3)


def _head_rms_norm(h, g, dtype):
    h = h * lax.rsqrt(jnp.mean(h * h, axis=-1, keepdims=True) + EPS)
    B, H, T, d = h.shape
    return (h.transpose(0, 2, 1, 3).reshape(B, T, H * d) * g.astype(jnp.float32)).astype(dtype)


def _to_colmajor(a):
    B, T, C = a.shape
    rows = T // GRID_W
    return a.reshape(B, rows, GRID_W, C).swapaxes(1, 2).reshape(B, T, C)


def _from_colmajor(a):
    B, T, C = a.shape
    rows = T // GRID_W
    return a.reshape(B, GRID_W, rows, C).swapaxes(1, 2).reshape(B, T, C)


def _centred_conv(a, w, b):
    pad = MLSTM_CONV // 2
    T = a.shape[1]
    ap = jnp.pad(a, ((0, 0), (pad, pad), (0, 0)))
    return sum(ap[:, j:j + T] * w[j] for j in range(MLSTM_CONV)) + b


def _chunks(a):
    B, H, T = a.shape[:3]
    a = a.reshape((B, H, T // CHUNK, CHUNK) + a.shape[3:])
    return jnp.moveaxis(a, 2, 0)


def _unchunk(o, T):
    o = jnp.moveaxis(o, 0, 2)
    return o.reshape(o.shape[:2] + (T,) + o.shape[4:])


def _gla_scan(q, k, v, log_a, s0):
    mask = jnp.tril(jnp.ones((CHUNK, CHUNK), dtype=bool))

    def step(s, inp):
        qc, kc, vc, gc = inp
        b = jnp.cumsum(gc, axis=2)
        b_last = b[:, :, -1:, :]
        q_dec = qc * jnp.exp(b)
        scores = jnp.einsum('bhld,bhmd->bhlm', q_dec, kc * jnp.exp(-b))
        scores = jnp.where(mask, scores, 0.0)
        o = (jnp.einsum('bhlm,bhmv->bhlv', scores, vc)
             + jnp.einsum('bhld,bhdv->bhlv', q_dec, s))
        s_new = (jnp.exp(b_last[:, :, 0, :, None]) * s
                 + jnp.einsum('bhld,bhlv->bhdv', kc * jnp.exp(b_last - b), vc))
        return s_new, o

    s_fin, o = lax.scan(step, s0, tuple(_chunks(a) for a in (q, k, v, log_a)))
    return _unchunk(o, q.shape[2]), s_fin


def _mlstm_scan(q, k, v, log_i, log_f, state0):
    mask = jnp.tril(jnp.ones((CHUNK, CHUNK), dtype=bool))

    def step(carry, inp):
        c, nv, m = carry
        qc, kc, vc, ic, fc = inp
        b = jnp.cumsum(fc, axis=-1)
        log_intra = b[..., :, None] - b[..., None, :] + ic[..., None, :]
        log_intra = jnp.where(mask, log_intra, -jnp.inf)
        log_inter = b + m[..., None]
        m_q = jnp.maximum(log_inter, jnp.max(log_intra, axis=-1))
        w_intra = jnp.exp(log_intra - m_q[..., None]) * jnp.einsum('bhld,bhmd->bhlm', qc, kc)
        w_inter = jnp.exp(log_inter - m_q)
        num = (jnp.einsum('bhlm,bhmv->bhlv', w_intra, vc)
               + w_inter[..., None] * jnp.einsum('bhld,bhdv->bhlv', qc, c))
        den = jnp.sum(w_intra, axis=-1) + w_inter * jnp.einsum('bhld,bhd->bhl', qc, nv)
        h = num / jnp.maximum(jnp.abs(den), jnp.exp(-m_q))[..., None]
        b_last = b[..., -1]
        log_key = b_last[..., None] - b + ic
        m_new = jnp.maximum(b_last + m, jnp.max(log_key, axis=-1))
        w_key = jnp.exp(log_key - m_new[..., None])
        decay = jnp.exp(b_last + m - m_new)
        c_new = decay[..., None, None] * c + jnp.einsum('bhl,bhld,bhlv->bhdv', w_key, kc, vc)
        n_new = decay[..., None] * nv + jnp.einsum('bhl,bhld->bhd', w_key, kc)
        return (c_new, n_new, m_new), h

    state, h = lax.scan(step, state0, tuple(_chunks(a) for a in (q, k, v, log_i, log_f)))
    return _unchunk(h, q.shape[2]), state


def _flip_t(a):
    return jnp.flip(a, axis=2)


def _identity(a):
    return a


def _bidirectional(scan_fn, lat_dirs, ctx_dirs, init):
    outs_l, outs_c = [], []
    for d in range(2):
        flip = _flip_t if d == 1 else _identity
        o_c, st = scan_fn(*[flip(a) for a in ctx_dirs[d]], init)
        o_l, _ = scan_fn(*[flip(a) for a in lat_dirs[d]], st)
        outs_l.append(flip(o_l))
        outs_c.append(flip(o_c))
    return outs_l[0] + outs_l[1], outs_c[0] + outs_c[1]


def _gla_inputs(q, k, v, lr, w_up, b_dec):
    B, T, _ = q.shape
    q = _heads(q, GLA_HEADS).astype(jnp.float32) * GLA_DK_HEAD ** -0.5
    k = _heads(k, GLA_HEADS).astype(jnp.float32)
    v = _heads(v, GLA_HEADS).astype(jnp.float32)
    lr = lr.reshape(B, T, 2, GLA_RANK)
    z = jnp.einsum('btdr,drk->dbtk', lr, w_up) + b_dec[:, None, None, :]
    log_a = jax.nn.log_sigmoid(z.astype(jnp.float32)) / GLA_TAU
    return ((q, k, v, _heads(log_a[0], GLA_HEADS)),
            (q, k, v, _heads(log_a[1], GLA_HEADS)))


def _mlstm_inputs(q, k, v, gates, conv_w, conv_b, b_gate):
    qk = jax.nn.silu(_centred_conv(jnp.concatenate([q, k], axis=-1), conv_w, conv_b))
    q, k = jnp.split(qk, 2, axis=-1)
    q = _heads(q, MLSTM_HEADS).astype(jnp.float32)
    k = _heads(k, MLSTM_HEADS).astype(jnp.float32) * MLSTM_DK_HEAD ** -0.5
    v = _heads(v, MLSTM_HEADS).astype(jnp.float32)
    B, T, _ = gates.shape
    g = (gates.reshape(B, T, 4, MLSTM_HEADS) + b_gate).astype(jnp.float32)
    g = g.transpose(2, 0, 3, 1)
    return ((q, k, v, g[0], jax.nn.log_sigmoid(g[1])),
            (q, k, v, g[2], jax.nn.log_sigmoid(g[3])))


def _mixer(u, u_c, w_in, gla_w_up, gla_b_dec, gla_norm_g, conv_w, conv_b, b_gate,
           mlstm_norm_g, w_br_gla, w_br_mlstm, w_out, need_ctx):
    B = u.shape[0]
    p = _split_cols(u @ w_in)
    pc = _split_cols(u_c @ w_in)
    gla_lat = _gla_inputs(p[0], p[1], p[2], p[4], gla_w_up, gla_b_dec)
    gla_ctx = _gla_inputs(pc[0], pc[1], pc[2], pc[4], gla_w_up, gla_b_dec)
    s0 = jnp.zeros((B, GLA_HEADS, GLA_DK_HEAD, GLA_DV_HEAD), jnp.float32)
    o_l, o_c = _bidirectional(_gla_scan, gla_lat, gla_ctx, s0)
    cm = [_to_colmajor(p[j]) for j in (5, 6, 7, 9)]
    m_lat = _mlstm_inputs(*cm, conv_w, conv_b, b_gate)
    m_ctx = _mlstm_inputs(pc[5], pc[6], pc[7], pc[9], conv_w, conv_b, b_gate)
    st0 = (jnp.zeros((B, MLSTM_HEADS, MLSTM_DK_HEAD, MLSTM_DV_HEAD), jnp.float32),
           jnp.zeros((B, MLSTM_HEADS, MLSTM_DK_HEAD), jnp.float32),
           jnp.zeros((B, MLSTM_HEADS), jnp.float32))
    h_l, h_c = _bidirectional(_mlstm_scan, m_lat, m_ctx, st0)

    def merge(pp, o, h):
        y_gla = _head_rms_norm(o, gla_norm_g, u.dtype) * jax.nn.silu(pp[3])
        y_m = h * jax.nn.sigmoid(pp[8])
        gate_gla, gate_m = jnp.split(jax.nn.sigmoid(pp[10]), 2, axis=-1)
        y = gate_gla * (y_gla @ w_br_gla) + gate_m * (y_m @ w_br_mlstm)
        return y @ w_out

    mix = merge(p, o_l, _from_colmajor(_head_rms_norm(h_l, mlstm_norm_g, u.dtype)))
    mix_c = merge(pc, o_c, _head_rms_norm(h_c, mlstm_norm_g, u.dtype)) if need_ctx else None
    return mix, mix_c


def setup_inputs(seed: int = 0) -> dict:
    key = jax.random.key(seed)
    ks = jax.random.split(key, 24)

    def nrm(k, shape, scale):
        return jax.random.normal(k, shape, jnp.float32) * scale

    D, L = D_MODEL, DEPTH
    f_bias = jnp.stack([jnp.zeros((MLSTM_HEADS,), jnp.float32),
                        jnp.linspace(3.0, 6.0, MLSTM_HEADS, dtype=jnp.float32),
                        jnp.zeros((MLSTM_HEADS,), jnp.float32),
                        jnp.linspace(3.0, 6.0, MLSTM_HEADS, dtype=jnp.float32)])
    return {
        'x': nrm(ks[0], (BATCH, SEQ, D), 1.0),
        'c': nrm(ks[1], (BATCH, D), 1.0),
        'ctx': nrm(ks[2], (BATCH, CTX_LEN, D), 1.0),
        'c_ctx': nrm(ks[3], (D,), 1.0),
        'w_ada': nrm(ks[4], (L, D, 6 * D), D ** -0.5),
        'b_ada': nrm(ks[5], (L, 6 * D), 0.01),
        'norm1_g': 1.0 + nrm(ks[6], (L, D), 0.01),
        'w_in': nrm(ks[7], (L, D, N_IN), D ** -0.5),
        'gla_w_up': nrm(ks[8], (L, 2, GLA_RANK, GLA_DK), GLA_RANK ** -0.5),
        'gla_b_dec': nrm(ks[9], (L, 2, GLA_DK), 0.1),
        'gla_norm_g': 1.0 + nrm(ks[10], (L, GLA_DV), 0.01),
        'mlstm_conv_w': nrm(ks[11], (L, MLSTM_CONV, 2 * MLSTM_DK), MLSTM_CONV ** -0.5),
        'mlstm_conv_b': nrm(ks[12], (L, 2 * MLSTM_DK), 0.01),
        'mlstm_b_gate': nrm(ks[13], (L, 4, MLSTM_HEADS), 0.1) + f_bias,
        'mlstm_norm_g': 1.0 + nrm(ks[14], (L, MLSTM_DV), 0.01),
        'w_br_gla': nrm(ks[15], (L, GLA_DV, D), GLA_DV ** -0.5),
        'w_br_mlstm': nrm(ks[16], (L, MLSTM_DV, D), MLSTM_DV ** -0.5),
        'w_out': nrm(ks[17], (L, D, D), D ** -0.5),
        'norm2_g': 1.0 + nrm(ks[18], (L, D), 0.01),
        'w_ffn_in': nrm(ks[19], (L, D, 2 * D_FF), D ** -0.5),
        'w_ffn_out': nrm(ks[20], (L, D_FF, D), D_FF ** -0.5),
        'final_g': 1.0 + nrm(ks[21], (D,), 0.01),
    }


def reference(x, c, ctx, c_ctx, w_ada, b_ada, norm1_g, w_in, gla_w_up, gla_b_dec,
              gla_norm_g, mlstm_conv_w, mlstm_conv_b, mlstm_b_gate, mlstm_norm_g,
              w_br_gla, w_br_mlstm, w_out, norm2_g, w_ffn_in, w_ffn_out, final_g):
    h_ctx = ctx
    silu_c = jax.nn.silu(c)
    silu_cc = jax.nn.silu(c_ctx)
    for i in range(DEPTH):
        need_ctx = i + 1 < DEPTH
        mod = (silu_c @ w_ada[i] + b_ada[i])[:, None, :]
        mod_c = silu_cc @ w_ada[i] + b_ada[i]
        sh1, sc1, g1, sh2, sc2, g2 = jnp.split(mod, 6, axis=-1)
        sh1c, sc1c, g1c, sh2c, sc2c, g2c = jnp.split(mod_c, 6, axis=-1)
        u = _modulate(_rms_norm(x, norm1_g[i]), sh1, sc1)
        u_c = _modulate(_rms_norm(h_ctx, norm1_g[i]), sh1c, sc1c)
        mix, mix_c = _mixer(u, u_c, w_in[i], gla_w_up[i], gla_b_dec[i], gla_norm_g[i],
                            mlstm_conv_w[i], mlstm_conv_b[i], mlstm_b_gate[i], mlstm_norm_g[i],
                            w_br_gla[i], w_br_mlstm[i], w_out[i], need_ctx)
        x = x + g1 * mix
        x = x + g2 * _swiglu(_modulate(_rms_norm(x, norm2_g[i]), sh2, sc2),
                             w_ffn_in[i], w_ffn_out[i])
        if need_ctx:
            h_ctx = h_ctx + g1c * mix_c
            h_ctx = h_ctx + g2c * _swiglu(_modulate(_rms_norm(h_ctx, norm2_g[i]), sh2c, sc2c),
                                          w_ffn_in[i], w_ffn_out[i])
    return _rms_norm(x, final_g)
```

```cpp
#include <hip/hip_runtime.h>
#include <cstdint>
#include <cstddef>

constexpr int D = 1024, NB = 4, SEQ = 4096, CTX = 256, TT = SEQ + CTX;
constexpr int NIN = 8240, DFF = 2816;
constexpr int C_GQ = 0, C_GK = 512, C_GV = 1024, C_GOG = 2048, C_LR = 3072, C_MQ = 3104, C_MK = 3616, C_MV = 4128, C_MOG = 5152, C_MG = 6176, C_MRG = 6192;
constexpr float EPS = 1e-6f;

__device__ __forceinline__ float siluf(float x) { return x / (1.f + __expf(-x)); }
__device__ __forceinline__ float sigmf(float x) { return 1.f / (1.f + __expf(-x)); }
__device__ __forceinline__ float logsigf(float z) { return fminf(z, 0.f) - log1pf(__expf(-fabsf(z))); }

__global__ void k_mod(const float* __restrict__ c, const float* __restrict__ cctx, const float* __restrict__ w_ada, const float* __restrict__ b_ada, float* __restrict__ mod) {
    const int n = blockIdx.x * blockDim.x + threadIdx.x, r = blockIdx.y;
    if (n >= 6 * D) return;
    const float* src = r < 4 ? c + r * D : cctx;
    float acc = 0.f;
    for (int k = 0; k < D; ++k) acc += siluf(src[k]) * w_ada[(size_t)k * 6 * D + n];
    mod[r * 6 * D + n] = acc + b_ada[n];
}

__device__ __forceinline__ float block_sum_256(float v, float* sh) {
    for (int o = 32; o > 0; o >>= 1) v += __shfl_xor(v, o);
    const int w = threadIdx.x >> 6;
    __syncthreads();
    if ((threadIdx.x & 63) == 0) sh[w] = v;
    __syncthreads();
    return sh[0] + sh[1] + sh[2] + sh[3];
}

__global__ void k_norm_mod(const float* __restrict__ xlat, const float* __restrict__ xctx, const float* __restrict__ g, const float* __restrict__ mod_lat, const float* __restrict__ mod_ctx,
                           int shift_idx, float* __restrict__ out) {
    __shared__ float sh[4];
    const int row = blockIdx.x;
    const float* in = row < SEQ ? xlat + (size_t)row * D : xctx + (size_t)(row - SEQ) * D;
    const float* mod = row < SEQ ? mod_lat : mod_ctx;
    float v[4]; float s = 0.f;
    for (int j = 0; j < 4; ++j) { v[j] = in[threadIdx.x + 256 * j]; s += v[j] * v[j]; }
    s = block_sum_256(s, sh);
    const float r = rsqrtf(s / D + EPS);
    for (int j = 0; j < 4; ++j) { const int cidx = threadIdx.x + 256 * j;
        out[(size_t)row * D + cidx] = v[j] * r * g[cidx] * (1.f + mod[(shift_idx + 1) * D + cidx]) + mod[shift_idx * D + cidx]; }
}

__global__ void __launch_bounds__(256) k_gemm(const float* __restrict__ A, int lda, const float* __restrict__ B, int ldb, float* __restrict__ C, int ldc, int M, int N, int K) {
    __shared__ float As[16][64 + 4], Bs[16][64 + 4];
    const int tx = threadIdx.x & 15, ty = threadIdx.x >> 4;
    const int m0 = blockIdx.y * 64, n0 = blockIdx.x * 64;
    float acc[4][4] = {};
    for (int k0 = 0; k0 < K; k0 += 16) {
        for (int i = threadIdx.x; i < 64 * 16; i += 256) { const int r = i >> 4, kk = i & 15; As[kk][r] = A[(size_t)(m0 + r) * lda + k0 + kk]; }
        for (int i = threadIdx.x; i < 64 * 16; i += 256) { const int kk = i >> 6, cc = i & 63; Bs[kk][cc] = (n0 + cc < N) ? B[(size_t)(k0 + kk) * ldb + n0 + cc] : 0.f; }
        __syncthreads();
#pragma unroll
        for (int kk = 0; kk < 16; ++kk) {
            float a[4], b[4];
#pragma unroll
            for (int i = 0; i < 4; ++i) { a[i] = As[kk][ty * 4 + i]; b[i] = Bs[kk][tx * 4 + i]; }
#pragma unroll
            for (int i = 0; i < 4; ++i)
#pragma unroll
                for (int j = 0; j < 4; ++j) acc[i][j] += a[i] * b[j];
        }
        __syncthreads();
    }
    for (int i = 0; i < 4; ++i)
        for (int j = 0; j < 4; ++j) { const int cc = n0 + tx * 4 + j; if (cc < N) C[(size_t)(m0 + ty * 4 + i) * ldc + cc] = acc[i][j]; }
}

__global__ void __launch_bounds__(256) k_gla(const float* __restrict__ P, const float* __restrict__ w_up, const float* __restrict__ b_dec, float* __restrict__ Out) {
    __shared__ float sa[128], sk[128], sq[128], slr[16];
    const int h = blockIdx.x, dir = blockIdx.y, tid = threadIdx.x;
    float S[128];
#pragma unroll
    for (int d = 0; d < 128; ++d) S[d] = 0.f;
    for (int s = 0; s < TT; ++s) {
        int row; bool lat;
        if (s < CTX) { row = SEQ + (dir ? CTX - 1 - s : s); lat = false; } else { const int j = s - CTX; row = dir ? SEQ - 1 - j : j; lat = true; }
        const float* p = P + (size_t)row * NIN;
        if (tid < 16) slr[tid] = p[C_LR + 16 * dir + tid];
        __syncthreads();
        if (tid < 128) {
            float z = b_dec[dir * 512 + 128 * h + tid];
            for (int r = 0; r < 16; ++r) z += slr[r] * w_up[(size_t)(dir * 16 + r) * 512 + 128 * h + tid];
            sa[tid] = __expf(logsigf(z) * (1.f / 16.f));
            sk[tid] = p[C_GK + 128 * h + tid];
        } else sq[tid - 128] = p[C_GQ + 128 * h + tid - 128] * 0.08838834764831845f;
        const float v = p[C_GV + 256 * h + tid];
        __syncthreads();
        float o = 0.f;
#pragma unroll
        for (int d = 0; d < 128; ++d) { S[d] = sa[d] * S[d] + sk[d] * v; o += sq[d] * S[d]; }
        if (lat) Out[((size_t)dir * SEQ + row) * D + 256 * h + tid] = o;
        __syncthreads();
    }
}

__device__ __forceinline__ int cm_to_row(int tp) { return (tp & 63) * 64 + (tp >> 6); }
__global__ void __launch_bounds__(256) k_mlstm(const float* __restrict__ P, const float* __restrict__ conv_w, const float* __restrict__ conv_b, const float* __restrict__ b_gate, float* __restrict__ Out) {
    __shared__ float sk[128], sq[128], sn[128];
    const int h = blockIdx.x, dir = blockIdx.y, tid = threadIdx.x;
    float C[128];
#pragma unroll
    for (int d = 0; d < 128; ++d) C[d] = 0.f;
    if (tid < 128) sn[tid] = 0.f;
    float m = 0.f;
    const int gi = dir ? 2 : 0;
    __syncthreads();
    for (int s = 0; s < TT; ++s) {
        int row, rprev, rnext; bool lat;
        if (s < CTX) { const int i = dir ? CTX - 1 - s : s; row = SEQ + i; rprev = i > 0 ? row - 1 : -1; rnext = i < CTX - 1 ? row + 1 : -1; lat = false; }
        else { const int j = s - CTX; const int tp = dir ? SEQ - 1 - j : j; row = cm_to_row(tp); rprev = tp > 0 ? cm_to_row(tp - 1) : -1; rnext = tp < SEQ - 1 ? cm_to_row(tp + 1) : -1; lat = true; }
        const float* p = P + (size_t)row * NIN;
        {
            const int d = tid & 127; const bool isk = tid < 128;
            const int ch = (isk ? 512 : 0) + 128 * h + d;
            const int col = (isk ? C_MK : C_MQ) + 128 * h + d;
            float a = conv_b[ch] + conv_w[1 * 1024 + ch] * p[col];
            if (rprev >= 0) a += conv_w[0 * 1024 + ch] * P[(size_t)rprev * NIN + col];
            if (rnext >= 0) a += conv_w[2 * 1024 + ch] * P[(size_t)rnext * NIN + col];
            a = siluf(a);
            if (isk) sk[d] = a * 0.08838834764831845f; else sq[d] = a;
        }
        const float li = p[C_MG + 4 * gi + h] + b_gate[gi * 4 + h];
        const float lf = logsigf(p[C_MG + 4 * (gi + 1) + h] + b_gate[(gi + 1) * 4 + h]);
        const float mn = fmaxf(lf + m, li);
        const float dec = __expf(lf + m - mn), ip = __expf(li - mn);
        m = mn;
        const float v = p[C_MV + 256 * h + tid];
        __syncthreads();
        if (tid < 128) sn[tid] = dec * sn[tid] + ip * sk[tid];
        __syncthreads();
        float num = 0.f, den = 0.f;
#pragma unroll
        for (int d = 0; d < 128; ++d) { C[d] = dec * C[d] + (ip * v) * sk[d]; num += C[d] * sq[d]; den += sn[d] * sq[d]; }
        if (lat) Out[((size_t)dir * SEQ + row) * D + 256 * h + tid] = num / fmaxf(fabsf(den), __expf(-mn));
        __syncthreads();
    }
}

__global__ void __launch_bounds__(256) k_headnorm_gate(const float* __restrict__ A0, const float* __restrict__ A1, const float* __restrict__ g, const float* __restrict__ P, int gcol, int mode, float* __restrict__ Y) {
    __shared__ float sh[4];
    const int row = blockIdx.x;
    for (int h = 0; h < 4; ++h) {
        const int cidx = 256 * h + threadIdx.x;
        const float v = A0[(size_t)row * D + cidx] + A1[(size_t)row * D + cidx];
        const float s = block_sum_256(v * v, sh);
        const float r = rsqrtf(s / 256.f + EPS);
        const float gt = P[(size_t)row * NIN + gcol + cidx];
        Y[(size_t)row * D + cidx] = v * r * g[cidx] * (mode == 0 ? siluf(gt) : sigmf(gt));
        __syncthreads();
    }
}

__global__ void k_merge(const float* __restrict__ P, const float* __restrict__ B1, const float* __restrict__ B2, float* __restrict__ Y) {
    const size_t i = (size_t)blockIdx.x * blockDim.x + threadIdx.x;
    const int row = (int)(i / D), cidx = (int)(i % D);
    Y[i] = sigmf(P[(size_t)row * NIN + C_MRG + cidx]) * B1[i] + sigmf(P[(size_t)row * NIN + C_MRG + 1024 + cidx]) * B2[i];
}
__global__ void k_resid(const float* __restrict__ X, const float* __restrict__ gate, const float* __restrict__ MIX, float* __restrict__ X1) {
    const size_t i = (size_t)blockIdx.x * blockDim.x + threadIdx.x;
    X1[i] = X[i] + gate[i % D] * MIX[i];
}
__global__ void k_swiglu(const float* __restrict__ A, float* __restrict__ H) {
    const size_t i = (size_t)blockIdx.x * blockDim.x + threadIdx.x;
    const int row = (int)(i / DFF), j = (int)(i % DFF);
    H[i] = siluf(A[(size_t)row * 2 * DFF + j]) * A[(size_t)row * 2 * DFF + DFF + j];
}
__global__ void __launch_bounds__(256) k_final(const float* __restrict__ X, const float* __restrict__ g, float* __restrict__ out) {
    __shared__ float sh[4];
    const int row = blockIdx.x;
    float v[4]; float s = 0.f;
    for (int j = 0; j < 4; ++j) { v[j] = X[(size_t)row * D + threadIdx.x + 256 * j]; s += v[j] * v[j]; }
    s = block_sum_256(s, sh);
    const float r = rsqrtf(s / D + EPS);
    for (int j = 0; j < 4; ++j) out[(size_t)row * D + threadIdx.x + 256 * j] = v[j] * r * g[threadIdx.x + 256 * j];
}

static void gemm(const float* A, int lda, const float* B, int ldb, float* C, int ldc, int M, int N, int K, hipStream_t st) {
    dim3 grid((N + 63) / 64, M / 64);
    hipLaunchKernelGGL(k_gemm, grid, dim3(256), 0, st, A, lda, B, ldb, C, ldc, M, N, K);
}

extern "C" void kernel_launch(void* const* d_in, const int* in_sizes, int n_in, void* d_out, int out_size, void* d_ws, size_t ws_size, hipStream_t stream) {
    const float* x = (const float*)d_in[0]; const float* c = (const float*)d_in[1]; const float* ctx = (const float*)d_in[2]; const float* cctx = (const float*)d_in[3];
    const float* w_ada = (const float*)d_in[4]; const float* b_ada = (const float*)d_in[5]; const float* norm1_g = (const float*)d_in[6]; const float* w_in = (const float*)d_in[7];
    const float* gla_w_up = (const float*)d_in[8]; const float* gla_b_dec = (const float*)d_in[9]; const float* gla_norm_g = (const float*)d_in[10];
    const float* conv_w = (const float*)d_in[11]; const float* conv_b = (const float*)d_in[12]; const float* b_gate = (const float*)d_in[13]; const float* mlstm_norm_g = (const float*)d_in[14];
    const float* w_br_gla = (const float*)d_in[15]; const float* w_br_mlstm = (const float*)d_in[16]; const float* w_out = (const float*)d_in[17]; const float* norm2_g = (const float*)d_in[18];
    const float* w_ffn_in = (const float*)d_in[19]; const float* w_ffn_out = (const float*)d_in[20]; const float* final_g = (const float*)d_in[21];
    float* out = (float*)d_out;
    float* ws = (float*)d_ws; size_t off = 0;
    auto take = [&](size_t n) { float* p = ws + off; off += (n + 63) & ~(size_t)63; return p; };
    float* mod = take(5 * 6 * D);
    float* U = take((size_t)TT * D);
    float* P = take((size_t)TT * NIN);
    float* O2 = take((size_t)2 * SEQ * D);
    float* H2 = take((size_t)2 * SEQ * D);
    float* Y1 = take((size_t)SEQ * D);
    float* Y2 = take((size_t)SEQ * D);
    if (off * 4 > ws_size) return;
    float* B1 = P; float* B2 = B1 + (size_t)SEQ * D; float* Y = B2 + (size_t)SEQ * D; float* MIX = O2; float* X1 = O2 + (size_t)SEQ * D;
    float* U2 = H2; float* Aff = P; float* Hf = H2 + (size_t)SEQ * D  ; float* F = U;

    hipLaunchKernelGGL(k_mod, dim3(6 * D / 256, 5), dim3(256), 0, stream, c, cctx, w_ada, b_ada, mod);
    for (int b = 0; b < NB; ++b) {
        const float* xb = x + (size_t)b * SEQ * D; const float* cb = ctx + (size_t)b * CTX * D; const float* modb = mod + (size_t)b * 6 * D; const float* modc = mod + (size_t)4 * 6 * D;
        float* outb = out + (size_t)b * SEQ * D;
        hipLaunchKernelGGL(k_norm_mod, dim3(TT), dim3(256), 0, stream, xb, cb, norm1_g, modb, modc, 0, U);
        gemm(U, D, w_in, NIN, P, NIN, TT, NIN, D, stream);
        hipLaunchKernelGGL(k_gla, dim3(4, 2), dim3(256), 0, stream, P, gla_w_up, gla_b_dec, O2);
        hipLaunchKernelGGL(k_mlstm, dim3(4, 2), dim3(256), 0, stream, P, conv_w, conv_b, b_gate, H2);
        hipLaunchKernelGGL(k_headnorm_gate, dim3(SEQ), dim3(256), 0, stream, O2, O2 + (size_t)SEQ * D, gla_norm_g, P, C_GOG, 0, Y1);
        hipLaunchKernelGGL(k_headnorm_gate, dim3(SEQ), dim3(256), 0, stream, H2, H2 + (size_t)SEQ * D, mlstm_norm_g, P, C_MOG, 1, Y2);
        float* tB1 = O2; float* tB2 = H2;
        gemm(Y1, D, w_br_gla, D, tB1, D, SEQ, D, D, stream);
        gemm(Y2, D, w_br_mlstm, D, tB2, D, SEQ, D, D, stream);
        hipLaunchKernelGGL(k_merge, dim3(SEQ * D / 256), dim3(256), 0, stream, P, tB1, tB2, Y1  );
        (void)B1; (void)B2; (void)Y; (void)MIX; (void)X1; (void)U2; (void)Hf;
        float* mix = Y2;
        gemm(Y1, D, w_out, D, mix, D, SEQ, D, D, stream);
        float* x1 = O2;
        hipLaunchKernelGGL(k_resid, dim3(SEQ * D / 256), dim3(256), 0, stream, xb, modb + 2 * D, mix, x1);
        float* u2 = H2;
        hipLaunchKernelGGL(k_norm_mod, dim3(SEQ), dim3(256), 0, stream, x1, x1, norm2_g, modb, modb, 3, u2);
        gemm(u2, D, w_ffn_in, 2 * DFF, Aff, 2 * DFF, SEQ, 2 * DFF, D, stream);
        float* hf = P + (size_t)SEQ * 2 * DFF;
        hipLaunchKernelGGL(k_swiglu, dim3(SEQ * DFF / 256), dim3(256), 0, stream, Aff, hf);
        gemm(hf, DFF, w_ffn_out, D, F, D, SEQ, D, DFF, stream);
        float* x2 = u2;
        hipLaunchKernelGGL(k_resid, dim3(SEQ * D / 256), dim3(256), 0, stream, x1, modb + 5 * D, F, x2);
        hipLaunchKernelGGL(k_final, dim3(SEQ), dim3(256), 0, stream, x2, final_g, outb);
    }
}
```

```cpp
#include <hip/hip_runtime.h>
#include <cstdio>
#include <cstdint>
#ifndef MK_N_LAUNCHES
#define MK_N_LAUNCHES 1
#endif
namespace pg8 {
#define PG8_LAS __attribute__((address_space(3)))
typedef unsigned short bf16_t;
typedef short bf16x8 __attribute__((ext_vector_type(8)));
typedef float f32x4 __attribute__((ext_vector_type(4)));
typedef unsigned u32x4 __attribute__((ext_vector_type(4)));
constexpr int BM = 256, BK = 64, HALF = 128, HTB = HALF * BK * 2  , STAGE_BYTES = 8 * HTB, NXCD = 8, WGM = 8;

__host__ __device__ __forceinline__ int lds_byte(int r, int c) { const int st = (r >> 4) * 2 + (c >> 5), rr = r & 15, cc = c & 31, ob = rr * 64 + cc * 2; return st * 1024 + (ob ^ (((ob >> 9) & 1) << 5)); }
__host__ __device__ __forceinline__ void stage_rc(int b, int& R, int& C) { const int st = b / 1024, sb = b % 1024, swz = sb ^ (((sb >> 9) & 1) << 5); R = (st >> 1) * 16 + swz / 64; C = (st & 1) * 32 + (swz % 64) / 2; }
__host__ __device__ __forceinline__ int perm32(int rho) { const int n = rho >> 4, i = rho & 15; return 8 * (i >> 2) + 4 * n + (i & 3); }

struct Unit { int pm, pn; };
struct Gemm { const bf16_t* A; const bf16_t* Bt; int M, N, K; };

struct StaticOrder {
    int nM, nN, nwg, G, c;
    __host__ __device__ void init(int M, int N, int G_, int c_) { nM = M / BM; nN = N / BM; nwg = nM * nN; G = G_; c = c_; }
    __host__ __device__ bool next(int i, Unit& u) const {
        const long L = (long)i * G + c; if (L >= nwg) return false;
        int wgid = (int)L; { const int q = nwg / NXCD, r = nwg % NXCD, xcd = wgid % NXCD, off = wgid / NXCD; wgid = (xcd < r ? xcd * (q + 1) : r * (q + 1) + (xcd - r) * q) + off; }
        const int nig = WGM * nN, gid = wgid / nig, fm = gid * WGM, gsz = (nM - fm) < WGM ? (nM - fm) : WGM;
        u.pm = fm + ((wgid % nig) % gsz); u.pn = (wgid % nig) / gsz; return true;
    }
    __device__ __forceinline__ void a_ready(const Unit&) const {}
    __device__ __forceinline__ void done(const Unit&) const {}
};

__device__ __forceinline__ unsigned cvt_pk_bf16(float lo, float hi) { unsigned r; asm volatile("v_cvt_pk_bf16_f32 %0, %1, %2" : "=v"(r) : "v"(lo), "v"(hi)); return r; }
typedef float f32x2 __attribute__((ext_vector_type(2)));
__device__ __forceinline__ float sigm_f(float x) { return __builtin_amdgcn_rcpf(1.f + __expf(-x)); }
__device__ __forceinline__ float silu_f(float x) { return x * sigm_f(x); }
__device__ __forceinline__ float bf_lo(unsigned w) { return __uint_as_float(w << 16); }
__device__ __forceinline__ float bf_hi(unsigned w) { return __uint_as_float(w & 0xffff0000u); }
__device__ __forceinline__ u32x4 pack8(const f32x4& a, const f32x4& b) { u32x4 w; w.x = cvt_pk_bf16(a[0], a[1]); w.y = cvt_pk_bf16(a[2], a[3]); w.z = cvt_pk_bf16(b[0], b[1]); w.w = cvt_pk_bf16(b[2], b[3]); return w; }

struct EpiScanIn {
    static constexpr bool PERM = true, AFTER_DRAIN = false;
    bf16_t* SIN; float* SMALL;
    __device__ __forceinline__ void operator()(const f32x4 (&acc)[2][2][4][2], const Unit& u, int wr, int wc, int fr, int fq) const {
        const int row0 = u.pm * BM + wr * 64 + fr;
        if (u.pn < 16) {
#pragma unroll
            for (int ai = 0; ai < 2; ++ai)
#pragma unroll
                for (int m = 0; m < 4; ++m) { bf16_t* rowp = SIN + (size_t)(row0 + ai * HALF + m * 16) * 4096 + u.pn * BM + wc * 32 + 8 * fq;
#pragma unroll
                    for (int bj = 0; bj < 2; ++bj) *(u32x4*)(rowp + bj * HALF) = pack8(acc[ai][bj][m][0], acc[ai][bj][m][1]); }
        } else if (wc < 2) {
#pragma unroll
            for (int ai = 0; ai < 2; ++ai)
#pragma unroll
                for (int m = 0; m < 4; ++m) { float* p = SMALL + (size_t)(row0 + ai * HALF + m * 16) * 64 + wc * 32 + 8 * fq;
                    *(f32x4*)p = acc[ai][0][m][0]; *(f32x4*)(p + 4) = acc[ai][0][m][1]; }
        }
    }
};

struct EpiOutGate {
    static constexpr bool PERM = true, AFTER_DRAIN = false;
    const bf16_t* OHo; const bf16_t* OHh; const float* gg; const float* mg; bf16_t* Y1; bf16_t* Y2; PG8_LAS float* st;
    __device__ __forceinline__ void operator()(const f32x4 (&acc)[2][2][4][2], const Unit& u, int wr, int wc, int fr, int fq) const {
        const bool isg = u.pn < 4; const int head = u.pn & 3;
        const bf16_t* src = (isg ? OHo : OHh) + head * 256; const float* gain = (isg ? gg : mg) + head * 256; bf16_t* dst = (isg ? Y1 : Y2) + head * 256;
        const int row0 = u.pm * BM + wr * 64 + fr, cb = wc * 32 + 8 * fq;
#pragma unroll
        for (int ai = 0; ai < 2; ++ai)
#pragma unroll
            for (int m = 0; m < 4; ++m) { float s = 0.f; const bf16_t* rp = src + (size_t)(row0 + ai * HALF + m * 16) * 1024 + cb;
#pragma unroll
                for (int bj = 0; bj < 2; ++bj) { const u32x4 w = *(const u32x4*)(rp + bj * HALF);
                    float a; a = bf_lo(w.x); s += a * a; a = bf_hi(w.x); s += a * a; a = bf_lo(w.y); s += a * a; a = bf_hi(w.y); s += a * a;
                    a = bf_lo(w.z); s += a * a; a = bf_hi(w.z); s += a * a; a = bf_lo(w.w); s += a * a; a = bf_hi(w.w); s += a * a; }
                s += __shfl_xor(s, 16); s += __shfl_xor(s, 32);
                if (fq == 0) st[(ai * HALF + wr * 64 + m * 16 + fr) * 4 + wc] = s; }
        asm volatile("s_waitcnt lgkmcnt(0)" ::: "memory"); __builtin_amdgcn_s_barrier(); asm volatile("" ::: "memory");
        f32x4 g8[2][2];
#pragma unroll
        for (int bj = 0; bj < 2; ++bj) { g8[bj][0] = *(const f32x4*)(gain + cb + bj * HALF); g8[bj][1] = *(const f32x4*)(gain + cb + bj * HALF + 4); }
#pragma unroll
        for (int ai = 0; ai < 2; ++ai)
#pragma unroll
            for (int m = 0; m < 4; ++m) { const int rl = ai * HALF + wr * 64 + m * 16 + fr; const f32x4 t = *(const PG8_LAS f32x4*)(st + rl * 4);
                const float rstd = __builtin_amdgcn_rsqf(((t[0] + t[1]) + (t[2] + t[3])) * (1.f / 256.f) + 1e-6f);
                const bf16_t* rp = src + (size_t)(row0 + ai * HALF + m * 16) * 1024 + cb; bf16_t* dp = dst + (size_t)(row0 + ai * HALF + m * 16) * 1024 + cb;
#pragma unroll
                for (int bj = 0; bj < 2; ++bj) { const u32x4 w = *(const u32x4*)(rp + bj * HALF);
                    f32x4 o0 = {bf_lo(w.x), bf_hi(w.x), bf_lo(w.y), bf_hi(w.y)}, o1 = {bf_lo(w.z), bf_hi(w.z), bf_lo(w.w), bf_hi(w.w)};
                    f32x4 a0 = acc[ai][bj][m][0], a1 = acc[ai][bj][m][1];
#pragma unroll
                    for (int e = 0; e < 4; ++e) { a0[e] = isg ? silu_f(a0[e]) : sigm_f(a0[e]); a1[e] = isg ? silu_f(a1[e]) : sigm_f(a1[e]); }
                    o0 = o0 * rstd * g8[bj][0] * a0; o1 = o1 * rstd * g8[bj][1] * a1;
                    *(u32x4*)(dp + bj * HALF) = pack8(o0, o1); } }
        asm volatile("s_waitcnt lgkmcnt(0)" ::: "memory"); __builtin_amdgcn_s_barrier(); asm volatile("" ::: "memory");
    }
};

struct EpiMerge {
    static constexpr bool PERM = true, AFTER_DRAIN = false;
    float* T; float* T2; bf16_t* Y;
    __device__ __forceinline__ void operator()(const f32x4 (&acc)[2][2][4][2], const Unit& u, int wr, int wc, int fr, int fq) const {
        const int step = u.pn >= 37 ? 2 : (u.pn >= 33 ? 0 : (u.pn >= 29 ? 3 : 1));
        const int opm = u.pm - (step == 0 ? 68 : (step == 2 ? 132 : 0)), opn = (u.pn - 25) & 3;
        const size_t tb = ((size_t)(opm * 4 + opn) * 32) * 512 + threadIdx.x;
        f32x4* t = (f32x4*)T + tb; f32x4* t2 = (f32x4*)T2 + tb;
        const int row0 = opm * BM + wr * 64 + fr, cb = opn * BM + wc * 32 + 8 * fq;
#pragma unroll
        for (int ai = 0; ai < 2; ++ai)
#pragma unroll
            for (int m = 0; m < 4; ++m)
#pragma unroll
                for (int bj = 0; bj < 2; ++bj) {
                    const int j0 = ((ai * 2 + bj) * 4 + m) * 2;
                    if (step == 0) { t[(size_t)j0 * 512] = acc[ai][bj][m][0]; t[(size_t)(j0 + 1) * 512] = acc[ai][bj][m][1]; }
                    else if (step == 2) { t2[(size_t)j0 * 512] = acc[ai][bj][m][0]; t2[(size_t)(j0 + 1) * 512] = acc[ai][bj][m][1]; }
                    else {
                        f32x4 s0 = acc[ai][bj][m][0], s1 = acc[ai][bj][m][1];
#pragma unroll
                        for (int e = 0; e < 4; ++e) { s0[e] = sigm_f(s0[e]); s1[e] = sigm_f(s1[e]); }
                        if (step == 1) { t[(size_t)j0 * 512] = t[(size_t)j0 * 512] * s0; t[(size_t)(j0 + 1) * 512] = t[(size_t)(j0 + 1) * 512] * s1; }
                        else { const f32x4 y0 = t[(size_t)j0 * 512] + t2[(size_t)j0 * 512] * s0, y1 = t[(size_t)(j0 + 1) * 512] + t2[(size_t)(j0 + 1) * 512] * s1;
                            *(u32x4*)(Y + (size_t)(row0 + ai * HALF + m * 16) * 1024 + cb + bj * HALF) = pack8(y0, y1); }
                    }
                }
    }
};

struct EpiResid {
    static constexpr bool PERM = false, AFTER_DRAIN = false;
    const float* base; float* out; const float* mod; int gidx; float* ss;
    __device__ __forceinline__ void operator()(const f32x4 (&acc)[2][2][4][2], const Unit& u, int wr, int wc, int fr, int fq) const {
        const float* gate = mod + (size_t)(u.pm >> 4) * 6144 + gidx * 1024;
        const int row0 = u.pm * BM + wr * 64 + fr, col0 = u.pn * BM + wc * 32 + 4 * fq;
        f32x4 gv[2][2];
#pragma unroll
        for (int bj = 0; bj < 2; ++bj)
#pragma unroll
            for (int n = 0; n < 2; ++n) gv[bj][n] = *(const f32x4*)(gate + col0 + bj * HALF + n * 16);
#pragma unroll
        for (int ai = 0; ai < 2; ++ai)
#pragma unroll
            for (int m = 0; m < 4; ++m) { const int row = row0 + ai * HALF + m * 16; const size_t off = (size_t)row * 1024 + col0; float s = 0.f;
#pragma unroll
                for (int bj = 0; bj < 2; ++bj)
#pragma unroll
                    for (int n = 0; n < 2; ++n) { const f32x4 xv = *(const f32x4*)(base + off + bj * HALF + n * 16); const f32x4 o = xv + gv[bj][n] * acc[ai][bj][m][n];
                        *(f32x4*)(out + off + bj * HALF + n * 16) = o; s += (o[0] * o[0] + o[1] * o[1]) + (o[2] * o[2] + o[3] * o[3]); }
                s += __shfl_xor(s, 16); s += __shfl_xor(s, 32);
                if (fq == 0) atomicAdd(ss + row, s); }
    }
};

struct EpiSwiglu {
    static constexpr bool PERM = true, AFTER_DRAIN = false;
    bf16_t* Hf;
    __device__ __forceinline__ void operator()(const f32x4 (&acc)[2][2][4][2], const Unit& u, int wr, int wc, int fr, int fq) const {
        const int row0 = u.pm * BM + wr * 64 + fr, cb = u.pn * HALF + wc * 32 + 8 * fq;
#pragma unroll
        for (int ai = 0; ai < 2; ++ai)
#pragma unroll
            for (int m = 0; m < 4; ++m) { f32x4 h0 = acc[ai][0][m][0], h1 = acc[ai][0][m][1];
#pragma unroll
                for (int e = 0; e < 4; ++e) { h0[e] = silu_f(h0[e]) * acc[ai][1][m][0][e]; h1[e] = silu_f(h1[e]) * acc[ai][1][m][1][e]; }
                *(u32x4*)(Hf + (size_t)(row0 + ai * HALF + m * 16) * 2816 + cb) = pack8(h0, h1); }
    }
};
template <class Epi, class Sched, bool ALIGN_EPI = false, bool SP2 = false>
__device__ __forceinline__ void gemm_phase(PG8_LAS unsigned char* lds, const Gemm g, const Sched& S, const Epi& E) {
    const int tid = threadIdx.x, wid = __builtin_amdgcn_readfirstlane(tid >> 6), lane = tid & 63, wr = wid >> 2, wc = wid & 3, fr = lane & 15, fq = lane >> 4;
    const int K = g.K, nt = K / BK;
    unsigned voffA[2], voffB[2];
#pragma unroll
    for (int i = 0; i < 2; ++i) { int R, C; stage_rc(tid * 16 + i * 8192, R, C); const int Rb = Epi::PERM ? ((R & ~31) + perm32(R & 31)) : R;
        voffA[i] = (unsigned)(R * K + C) * 2u; voffB[i] = (unsigned)(Rb * K + C) * 2u; }
    const size_t kstep = (size_t)(BK * 2);
    const size_t hstep = (size_t)HALF * K * 2;
    const size_t tstep = 2 * hstep;
    const unsigned ldsw = (unsigned)wid * 1024u;
    const int aoff = lds_byte(wr * 64 + fr, fq * 8), boff = lds_byte(wc * 32 + fr, fq * 8);
#define PG8_SA(b, h) (((b) * 2 + (h)) * HTB)
#define PG8_SB(b, h) ((4 + (b) * 2 + (h)) * HTB)
#define PG8_STAGE(bufoff, gbase, voff) do { _Pragma("unroll") for (int _i = 0; _i < 2; ++_i) \
        __builtin_amdgcn_global_load_lds((const unsigned*)((const char*)(gbase) + (voff)[_i]), (PG8_LAS unsigned*)(lds + (bufoff) + ldsw + _i * 8192), 16, 0, 0); } while (0)
#define PG8_LDA(dst, b, h) do { _Pragma("unroll") for (int m = 0; m < 4; ++m) _Pragma("unroll") for (int k = 0; k < 2; ++k) dst[m][k] = *(const PG8_LAS bf16x8*)(lds + PG8_SA(b, h) + aoff + m * 2048 + k * 1024); } while (0)
#define PG8_LDB(dst, b, h) do { _Pragma("unroll") for (int n = 0; n < 2; ++n) _Pragma("unroll") for (int k = 0; k < 2; ++k) dst[n][k] = *(const PG8_LAS bf16x8*)(lds + PG8_SB(b, h) + boff + n * 2048 + k * 1024); } while (0)
#define PG8_MMA(ai, bj, At, Bt) do { __builtin_amdgcn_s_setprio(1); _Pragma("unroll") for (int m = 0; m < 4; ++m) _Pragma("unroll") for (int n = 0; n < 2; ++n) _Pragma("unroll") for (int k = 0; k < 2; ++k) \
        acc[ai][bj][m][n] = __builtin_amdgcn_mfma_f32_16x16x32_bf16(Bt[n][k], At[m][k], acc[ai][bj][m][n], 0, 0, 0); __builtin_amdgcn_s_setprio(0); } while (0)
#define PG8_WAIT_V(n) asm volatile("s_waitcnt vmcnt(" #n ")" ::: "memory")
#define PG8_WAIT_L(n) asm volatile("s_waitcnt lgkmcnt(" #n ")" ::: "memory")
#define PG8_BAR __builtin_amdgcn_s_barrier()
#define PG8_SCHED __builtin_amdgcn_sched_barrier(0)
    Unit cur, nxt; int ui = 0;
    if (!S.next(0, cur)) return;
    f32x4 acc[2][2][4][2];
#pragma unroll
    for (int a = 0; a < 2; ++a)
#pragma unroll
        for (int b = 0; b < 2; ++b)
#pragma unroll
            for (int m = 0; m < 4; ++m)
#pragma unroll
                for (int n = 0; n < 2; ++n) acc[a][b][m][n] = (f32x4){0.f, 0.f, 0.f, 0.f};
    bf16x8 At[4][2], B0[2][2], B1[2][2];
    const char* cA = (const char*)g.A + (size_t)cur.pm * tstep; const char* cB = (const char*)g.Bt + (size_t)cur.pn * tstep;
    S.a_ready(cur);
    if constexpr (SP2) {
        PG8_STAGE(PG8_SB(0, 0), cB, voffB); PG8_STAGE(PG8_SB(0, 1), cB + hstep, voffB); PG8_STAGE(PG8_SA(0, 0), cA, voffA); PG8_STAGE(PG8_SA(0, 1), cA + hstep, voffA);
        if (wr == 1) PG8_BAR;
        PG8_WAIT_V(2); PG8_BAR;
        PG8_STAGE(PG8_SB(1, 0), cB + kstep, voffB); PG8_STAGE(PG8_SA(1, 0), cA + kstep, voffA); PG8_STAGE(PG8_SB(1, 1), cB + hstep + kstep, voffB);
        PG8_WAIT_V(6); PG8_BAR;
    } else {
        PG8_STAGE(PG8_SB(0, 0), cB, voffB); PG8_STAGE(PG8_SA(0, 0), cA, voffA); PG8_STAGE(PG8_SB(0, 1), cB + hstep, voffB); PG8_STAGE(PG8_SA(0, 1), cA + hstep, voffA);
        if (wr == 1) PG8_BAR;
        PG8_WAIT_V(4); PG8_BAR;
        PG8_STAGE(PG8_SB(1, 0), cB + kstep, voffB); PG8_STAGE(PG8_SA(1, 0), cA + kstep, voffA); PG8_STAGE(PG8_SB(1, 1), cB + hstep + kstep, voffB);
        PG8_WAIT_V(6); PG8_BAR;
    }
    for (;;) {
        const bool has_next = S.next(ui + 1, nxt);
        const char* nA = has_next ? (const char*)g.A + (size_t)nxt.pm * tstep : cA; const char* nB = has_next ? (const char*)g.Bt + (size_t)nxt.pn * tstep : cB;
        for (int t = 0; t < nt; t += 2) {
            const bool last = (t == nt - 2);
            const char* a1 = cA + (size_t)(t + 1) * kstep;
            const char* a2 = last ? nA : cA + (size_t)(t + 2) * kstep; const char* b2 = last ? nB : cB + (size_t)(t + 2) * kstep;
            const char* a3 = a2 + kstep; const char* b3 = b2 + kstep;
            if (last && has_next) S.a_ready(nxt);
            if constexpr (SP2) {
            PG8_LDB(B0, 0, 0); PG8_LDB(B1, 0, 1); PG8_SCHED; PG8_LDA(At, 0, 0); PG8_STAGE(PG8_SA(1, 1), a1 + hstep, voffA);
            PG8_WAIT_V(8); PG8_WAIT_L(0); PG8_BAR; PG8_MMA(0, 0, At, B0); PG8_MMA(0, 1, At, B1); PG8_BAR; PG8_SCHED;
            PG8_LDA(At, 0, 1); PG8_STAGE(PG8_SB(0, 0), b2, voffB); PG8_STAGE(PG8_SB(0, 1), b2 + hstep, voffB); PG8_STAGE(PG8_SA(0, 0), a2, voffA);
            PG8_WAIT_V(8); PG8_WAIT_L(0); PG8_BAR; PG8_MMA(1, 0, At, B0); PG8_MMA(1, 1, At, B1); PG8_BAR; PG8_SCHED;
            PG8_LDB(B0, 1, 0); PG8_LDB(B1, 1, 1); PG8_SCHED; PG8_LDA(At, 1, 0); PG8_STAGE(PG8_SA(0, 1), a2 + hstep, voffA);
            PG8_WAIT_V(8); PG8_WAIT_L(0); PG8_BAR; PG8_MMA(0, 0, At, B0); PG8_MMA(0, 1, At, B1); PG8_BAR; PG8_SCHED;
            PG8_LDA(At, 1, 1); PG8_STAGE(PG8_SB(1, 0), b3, voffB); PG8_STAGE(PG8_SB(1, 1), b3 + hstep, voffB); PG8_STAGE(PG8_SA(1, 0), a3, voffA);
            PG8_WAIT_V(8); PG8_WAIT_L(0); PG8_BAR; PG8_MMA(1, 0, At, B0); PG8_MMA(1, 1, At, B1); PG8_BAR; PG8_SCHED;
            } else {
            PG8_LDB(B0, 0, 0); PG8_SCHED; PG8_LDA(At, 0, 0); PG8_STAGE(PG8_SA(1, 1), a1 + hstep, voffA);
            PG8_WAIT_L(8); PG8_BAR; PG8_WAIT_L(0); PG8_MMA(0, 0, At, B0); PG8_BAR; PG8_SCHED;
            PG8_LDB(B1, 0, 1); PG8_STAGE(PG8_SB(0, 0), b2, voffB);
            PG8_BAR; PG8_WAIT_L(0); PG8_MMA(0, 1, At, B1); PG8_BAR;
            PG8_LDA(At, 0, 1); PG8_STAGE(PG8_SA(0, 0), a2, voffA);
            PG8_BAR; PG8_WAIT_L(0); PG8_MMA(1, 0, At, B0); PG8_BAR; PG8_SCHED;
            PG8_STAGE(PG8_SB(0, 1), b2 + hstep, voffB);
            PG8_WAIT_V(6); PG8_BAR; PG8_MMA(1, 1, At, B1); PG8_BAR;
            PG8_LDB(B0, 1, 0); PG8_SCHED; PG8_LDA(At, 1, 0); PG8_STAGE(PG8_SA(0, 1), a2 + hstep, voffA);
            PG8_WAIT_L(8); PG8_BAR; PG8_WAIT_L(0); PG8_MMA(0, 0, At, B0); PG8_BAR; PG8_SCHED;
            PG8_LDB(B1, 1, 1); PG8_STAGE(PG8_SB(1, 0), b3, voffB);
            PG8_BAR; PG8_WAIT_L(0); PG8_MMA(0, 1, At, B1); PG8_BAR;
            PG8_LDA(At, 1, 1); PG8_STAGE(PG8_SA(1, 0), a3, voffA);
            PG8_BAR; PG8_WAIT_L(0); PG8_MMA(1, 0, At, B0); PG8_BAR; PG8_SCHED;
            PG8_STAGE(PG8_SB(1, 1), b3 + hstep, voffB);
            PG8_WAIT_V(6); PG8_BAR; PG8_MMA(1, 1, At, B1); PG8_BAR;
            }
        }
        if constexpr (ALIGN_EPI) { if (wr == 0) PG8_BAR; }
        if constexpr (!Epi::AFTER_DRAIN) { E(acc, cur, wr, wc, fr, fq); S.done(cur); }
        if (!has_next) break;
#pragma unroll
        for (int a = 0; a < 2; ++a)
#pragma unroll
            for (int b = 0; b < 2; ++b)
#pragma unroll
                for (int m = 0; m < 4; ++m)
#pragma unroll
                    for (int n = 0; n < 2; ++n) acc[a][b][m][n] = (f32x4){0.f, 0.f, 0.f, 0.f};
        cur = nxt; cA = nA; cB = nB; ++ui;
        if constexpr (ALIGN_EPI) { if (wr == 1) PG8_BAR; }
    }
    PG8_WAIT_V(0);
    if constexpr (!ALIGN_EPI) { if (wr == 0) PG8_BAR; }
    PG8_BAR;
    if constexpr (Epi::AFTER_DRAIN) { E.fused(acc, cur, wr, wc, fr, fq, lds, wid, lane); S.done(cur); }
#undef PG8_SA
#undef PG8_SB
#undef PG8_STAGE
#undef PG8_LDA
#undef PG8_LDB
#undef PG8_MMA
#undef PG8_WAIT_V
#undef PG8_WAIT_L
#undef PG8_BAR
#undef PG8_SCHED
}
}
constexpr int NWAVES = 8;
constexpr int N_LAUNCHES = MK_N_LAUNCHES;
constexpr int PER_PHASE = 11;
constexpr int D = 1024, NB = 4, SEQ = 4096, CTXL = 256, ML = NB * SEQ, MC = NB * CTXL, MT = ML + MC;
constexpr int NIN = 8240, DFF = 2816;
constexpr float RMS_EPS = 1e-6f, QK_SCALE = 0.08838834764831845f;
constexpr int SC_GQ = 0, SC_GK = 512, SC_GV = 1024, SC_MQ = 2048, SC_MK = 2560, SC_MV = 3072;
constexpr int WT_OG = 17, WT_MRG1 = 25, WT_MRG2 = 29, WT_BR1 = 33, WT_BR2 = 37, WT_OUT = 41, WT_FFN1 = 45, WT_TILES = 67;
constexpr size_t MiB = 1u << 20;
constexpr size_t WS_CTL = 0, CTL_ZERO_BYTES = 1 * MiB;
constexpr size_t WS_WT = 2 * MiB;
constexpr size_t WS_W2T = 36 * MiB;
constexpr size_t WS_XN = 42 * MiB;
constexpr size_t WS_Y1 = 76 * MiB, WS_Y2 = 108 * MiB;
constexpr size_t WS_SIN = 76 * MiB;
constexpr size_t WS_SMALL = 212 * MiB;
constexpr size_t WS_T2 = 140 * MiB;
constexpr size_t WS_Y = 204 * MiB;
constexpr size_t WS_HF = 76 * MiB;
constexpr size_t WS_END = 236 * MiB;
static_assert(WS_XN + (size_t)MT * D * 2 == WS_Y1 && WS_Y1 + (size_t)ML * D * 2 == WS_Y2 && WS_SIN + (size_t)MT * 4096 * 2 <= WS_SMALL && WS_SMALL + (size_t)MT * 64 * 4 <= 256 * MiB, "ws map");
static_assert(WS_Y2 + (size_t)ML * D * 2 <= WS_T2 && WS_T2 + 64 * MiB <= WS_Y && WS_HF + (size_t)ML * DFF * 2 <= WS_Y && WS_WT + (size_t)WT_TILES * 256 * D * 2 <= WS_W2T && WS_W2T + (size_t)D * DFF * 2 <= WS_XN, "ws map 2");
constexpr int CW_TMO = 0, CW_CODE = 1, CW_BAR = 4096;
constexpr size_t CTL_MOD = 65536, CTL_SS1 = 262144, CTL_SS2 = 327680;
constexpr int RING_OFF = 0, RING_BYTES = 131072, EPI_ST_OFF = RING_BYTES, LDSCTL_OFF = EPI_ST_OFF + 4096, MISC_OFF = LDSCTL_OFF + 320, LDS_BYTES = 147456;
static_assert(MISC_OFF + 128 <= LDS_BYTES, "LDS map");

#define GAS __attribute__((address_space(1)))
#define LAS __attribute__((address_space(3)))
typedef unsigned short bf16;
typedef unsigned v4u __attribute__((ext_vector_type(4)));
typedef unsigned v2u __attribute__((ext_vector_type(2)));
typedef float f32x4 __attribute__((ext_vector_type(4)));
typedef short bf16x8 __attribute__((ext_vector_type(8)));
typedef GAS unsigned gu32;
#define RLX_AGENT __ATOMIC_RELAXED, __HIP_MEMORY_SCOPE_AGENT
#define LDS_WAIT() asm volatile("s_waitcnt lgkmcnt(0)" ::: "memory")
#define VM_WAIT() asm volatile("s_waitcnt vmcnt(0)" ::: "memory")
__device__ __forceinline__ unsigned f2bf(float f) { unsigned u = __builtin_bit_cast(unsigned, f); return (u + 0x7fffu + ((u >> 16) & 1u)) >> 16; }
__device__ __forceinline__ unsigned pk2(float lo, float hi) { return pg8::cvt_pk_bf16(lo, hi); }
__device__ __forceinline__ float bf2f(bf16 h) { return __uint_as_float((unsigned)h << 16); }
__device__ __forceinline__ float logsig_f(float z) { return fminf(z, 0.f) - __logf(1.f + __expf(-fabsf(z))); }
#define XB_TMO      128
#define XB_XCNT(j)  (256  + 64 * (j))
#define XB_XSUB(j)  (1280 + 64 * (j))
#define XB_XGEN(j)  (2304 + 64 * (j))
#define XB_TOP      3328
#define XB_TOPGEN   3392
#define XCD_BAR_WORDS 3456
#define XB_SPIN_CAP (1u << 18)

__device__ __forceinline__ unsigned xb_ld(unsigned* p)              { return __hip_atomic_load(p, __ATOMIC_RELAXED, __HIP_MEMORY_SCOPE_AGENT); }
__device__ __forceinline__ unsigned xb_add(unsigned* p, unsigned v) { return __hip_atomic_fetch_add(p, v, __ATOMIC_RELAXED, __HIP_MEMORY_SCOPE_AGENT); }
__device__ __forceinline__ unsigned xb_xcc_id() { return (unsigned)__builtin_amdgcn_s_getreg((3 << 11) | 20) & 0xFu; }
#define XB_SPIN(cond, bar) do { unsigned _sp = 0; while (cond) { __builtin_amdgcn_s_sleep(1); \
    if ((++_sp & 255u) == 0u) { if (xb_ld(&(bar)[XB_TMO])) break; if (_sp > XB_SPIN_CAP) { atomicAdd(&(bar)[XB_TMO], 1u); break; } } } } while (0)

struct XcdBarrier {
    unsigned* bar; unsigned x;
    volatile LAS unsigned* st;
};

__device__ __forceinline__ XcdBarrier xcd_barrier_post(unsigned* bar, volatile LAS unsigned* st) {
    XcdBarrier b; b.bar = bar; b.x = xb_xcc_id(); b.st = st;
    if (threadIdx.x == 0) (void)xb_add(&bar[XB_XCNT(b.x)], 1u);
    return b;
}
__device__ __forceinline__ void xcd_barrier_complete(unsigned* bar, unsigned x, unsigned& nloc, unsigned& nx) {
    const unsigned G = gridDim.x * gridDim.y * gridDim.z;
    unsigned sum, cnt, mine, sp = 0u;
    for (;;) {
        sum = 0u; cnt = 0u; mine = 0u;
#pragma unroll
        for (unsigned j = 0; j < 16; ++j) { const unsigned c = xb_ld(&bar[XB_XCNT(j)]); sum += c; cnt += (c > 0u) ? 1u : 0u; mine = (j == x) ? c : mine; }
        if (sum == G) break;
        __builtin_amdgcn_s_sleep(1);
        if ((++sp & 255u) == 0u) { if (xb_ld(&bar[XB_TMO])) break; if (sp > XB_SPIN_CAP) { atomicAdd(&bar[XB_TMO], 1u); break; } }
    }
    nloc = mine > 0u ? mine : 1u; nx = cnt > 0u ? cnt : 1u;
}

__device__ __forceinline__ void xcd_barrier(const XcdBarrier& b) {
    asm volatile("s_waitcnt vmcnt(0)" ::: "memory");
    __syncthreads();
    if (threadIdx.x == 0) {
        unsigned* bar = b.bar;
        __builtin_amdgcn_s_waitcnt(0);
        unsigned nloc = b.st[0], nx = b.st[1];
        if (nloc == 0u) { xcd_barrier_complete(bar, b.x, nloc, nx); b.st[0] = nloc; b.st[1] = nx; }
        const unsigned old = xb_add(&bar[XB_XSUB(b.x)], 1u);
        const unsigned gen = old / nloc;
        if (old + 1u == (gen + 1u) * nloc) {
            __builtin_amdgcn_fence(__ATOMIC_RELEASE, "agent");
            asm volatile("s_waitcnt vmcnt(0)" ::: "memory");
            const unsigned og = xb_add(&bar[XB_TOP], 1u);
            const unsigned tg = og / nx;
            if (og + 1u == (tg + 1u) * nx) xb_add(&bar[XB_TOPGEN], 1u);
            else XB_SPIN(xb_ld(&bar[XB_TOPGEN]) == tg, bar);
            __builtin_amdgcn_fence(__ATOMIC_ACQUIRE, "agent");
            xb_add(&bar[XB_XGEN(b.x)], 1u);
            asm volatile("s_waitcnt vmcnt(0)" ::: "memory");
        } else {
            XB_SPIN(xb_ld(&bar[XB_XGEN(b.x)]) == gen, bar);
            __builtin_amdgcn_fence(__ATOMIC_ACQUIRE, "agent");
            asm volatile("s_waitcnt vmcnt(0)" ::: "memory");
        }
    }
    __syncthreads();
}
struct Frame {
    LAS unsigned char* lds;
    volatile LAS unsigned* MISC;
    gu32* ctl;
    int tid, lane, wave;
    int vcu, G;
    const float *x, *c, *ctx, *cctx, *w_ada, *b_ada, *norm1_g, *w_in, *w_up, *b_dec, *gla_g, *conv_w, *conv_b, *b_gate, *mlstm_g, *w_br1, *w_br2, *w_out, *norm2_g, *w_f1, *w_f2, *final_g;
    float* out;
    bf16 *WT, *W2T, *XN, *Y1, *Y2, *SIN, *Y, *HF;
    float *SMALL, *T2, *MOD, *SS1, *SS2;
};
__device__ __forceinline__ float wave_sum(float v) {
#pragma unroll
    for (int o = 1; o < 64; o <<= 1) v += __shfl_xor(v, o);
    return v;
}
__device__ __forceinline__ int map_col(int which, int off, int n) {
    if (which == 1) return off + n;
    if (which == 2) { const int isb = n >= DFF, j = isb ? n - DFF : n; return off + 256 * (j >> 7) + (isb ? 128 : 0) + (j & 127); }
    if (n < 2048) return n;
    if (n < 3072) return WT_OG * 256 + (n - 2048);
    if (n < 3104) return 4096 + (n - 3072);
    if (n < 4128) return 2048 + (n - 3104);
    if (n < 5152) return 3072 + (n - 4128);
    if (n < 6176) return (WT_OG + 4) * 256 + (n - 5152);
    if (n < 6192) return 4096 + 32 + (n - 6176);
    if (n < 7216) return WT_MRG1 * 256 + (n - 6192);
    return WT_MRG2 * 256 + (n - 7216);
}
__device__ __forceinline__ void p0_transpose_item(const float* W, int K, int N, bf16* WTb, int which, int off, LAS float* scr, int item, int lane) {
    const int nblk = (N + 31) / 32, kb = item / nblk, nb = item % nblk, k0 = 64 * kb, n0 = 32 * nb;
    const bool okc = n0 + (lane & 31) < N;
#pragma unroll 8
    for (int i = 0; i < 32; ++i) { const int kk = 2 * i + (lane >> 5); scr[kk * 33 + (lane & 31)] = okc ? W[(size_t)(k0 + kk) * N + n0 + (lane & 31)] : 0.f; }
    LDS_WAIT(); asm volatile("" ::: "memory");
    const int c8 = lane & 7;
#pragma unroll
    for (int j = 0; j < 4; ++j) { const int n = (lane >> 3) + 8 * j; const LAS float* s = scr + (8 * c8) * 33 + n;
        v4u o; o.x = pk2(s[0 * 33], s[1 * 33]); o.y = pk2(s[2 * 33], s[3 * 33]); o.z = pk2(s[4 * 33], s[5 * 33]); o.w = pk2(s[6 * 33], s[7 * 33]);
        if (n0 + n < N) *(GAS v4u*)(WTb + (size_t)map_col(which, off, n0 + n) * K + k0 + 8 * c8) = o; }
    LDS_WAIT(); asm volatile("" ::: "memory");
}
__device__ __forceinline__ void p0_prologue(Frame& F) {
    LAS float* scr = (LAS float*)(F.lds + RING_OFF + F.wave * 16384);
    const int gw = F.vcu * NWAVES + F.wave, NGW = F.G * NWAVES;
    constexpr int I_IN = 16 * 258, I_BR = 16 * 32, I_F1 = 16 * 176, I_F2 = 44 * 32, I_MOD = 96 * 8;
    constexpr int NITEMS = I_IN + 3 * I_BR + I_F1 + I_F2 + I_MOD;
    for (int it = gw; it < NITEMS; it += NGW) {
        int r = it;
        if (r < I_MOD) {
            const int ncb = r >> 3, kb = r & 7, n = ncb * 64 + F.lane, kbase = kb * 128;
            float sA[5], sB[5], acc[5];
#pragma unroll
            for (int q = 0; q < 5; ++q) { const float* src = q < 4 ? F.c + q * D : F.cctx; const float a = src[kbase + F.lane], b2 = src[kbase + 64 + F.lane];
                sA[q] = a / (1.f + __expf(-a)); sB[q] = b2 / (1.f + __expf(-b2)); acc[q] = 0.f; }
            const float* wp = F.w_ada + (size_t)kbase * 6144 + n;
#pragma unroll 4
            for (int kk = 0; kk < 64; ++kk) { const float wv = wp[(size_t)kk * 6144];
#pragma unroll
                for (int q = 0; q < 5; ++q) acc[q] += __shfl(sA[q], kk) * wv; }
#pragma unroll 4
            for (int kk = 0; kk < 64; ++kk) { const float wv = wp[(size_t)(64 + kk) * 6144];
#pragma unroll
                for (int q = 0; q < 5; ++q) acc[q] += __shfl(sB[q], kk) * wv; }
            const float bias = kb == 0 ? F.b_ada[n] : 0.f;
#pragma unroll
            for (int q = 0; q < 5; ++q) atomicAdd(F.MOD + q * 6144 + n, acc[q] + bias);
            continue; }
        r -= I_MOD;
        if (r < I_IN) { p0_transpose_item(F.w_in, D, NIN, F.WT, 0, 0, scr, r, F.lane); continue; } r -= I_IN;
        if (r < I_BR) { p0_transpose_item(F.w_br1, D, D, F.WT, 1, WT_BR1 * 256, scr, r, F.lane); continue; } r -= I_BR;
        if (r < I_BR) { p0_transpose_item(F.w_br2, D, D, F.WT, 1, WT_BR2 * 256, scr, r, F.lane); continue; } r -= I_BR;
        if (r < I_BR) { p0_transpose_item(F.w_out, D, D, F.WT, 1, WT_OUT * 256, scr, r, F.lane); continue; } r -= I_BR;
        if (r < I_F1) { p0_transpose_item(F.w_f1, D, 2 * DFF, F.WT, 2, WT_FFN1 * 256, scr, r, F.lane); continue; } r -= I_F1;
        p0_transpose_item(F.w_f2, DFF, D, F.W2T, 1, 0, scr, r, F.lane);
    }
    { GAS v4u* z = (GAS v4u*)(F.WT + (size_t)(4096 + 48) * D); const int n16 = 208 * 2048 / 16;
      for (int i = gw * 64 + F.lane; i < n16; i += NGW * 64) z[i] = (v4u){0u, 0u, 0u, 0u}; }
}
__device__ __forceinline__ void norm_mod_row(Frame& F, const float* xrow, float ssq_or_neg, const float* g, const float* shift, const float* scale, bf16* orow) {
    const GAS f32x4* xr = (const GAS f32x4*)xrow + F.lane;
    f32x4 v[4]; float s = 0.f;
#pragma unroll
    for (int j = 0; j < 4; ++j) { v[j] = xr[64 * j]; s += (v[j].x * v[j].x + v[j].y * v[j].y) + (v[j].z * v[j].z + v[j].w * v[j].w); }
    const float tot = ssq_or_neg >= 0.f ? ssq_or_neg : wave_sum(s);
    const float rstd = 1.f / sqrtf(tot * (1.f / D) + RMS_EPS);
    GAS unsigned long long* o8 = (GAS unsigned long long*)orow + F.lane;
#pragma unroll
    for (int j = 0; j < 4; ++j) { const f32x4 gv = ((const GAS f32x4*)g)[F.lane + 64 * j], sh = ((const GAS f32x4*)shift)[F.lane + 64 * j], sc = ((const GAS f32x4*)scale)[F.lane + 64 * j];
        const f32x4 y = (v[j] * rstd * gv) * (1.f + sc) + sh;
        o8[64 * j] = (unsigned long long)pk2(y.x, y.y) | ((unsigned long long)pk2(y.z, y.w) << 32); }
}
constexpr int SL_AQ = 0, SL_AK = 17408, SL_KT = 34816, SL_PM = 53248, SL_VT = 62464, SL_ST = 69376, SL_WUT = 95488, SL_LR = 115968, SL_F = 121088;
constexpr int ST_AQ = 272, ST_KT = 144, ST_W = 80, ST_DIR = 48 * 272;
#define MMA16(a, b, c) __builtin_amdgcn_mfma_f32_16x16x32_bf16((a), (b), (c), 0, 0, 0)
__device__ __forceinline__ bf16x8 ldf(LAS unsigned char* base, int row, int stride, int kb) { return *(const LAS bf16x8*)(base + row * stride + kb); }
__device__ __forceinline__ unsigned long long pack4(const f32x4& v) { return (unsigned long long)pk2(v[0], v[1]) | ((unsigned long long)pk2(v[2], v[3]) << 32); }
__device__ __forceinline__ void st_lds16(LAS unsigned char* p, float v) { *(LAS unsigned short*)p = (unsigned short)f2bf(v); }
__device__ __forceinline__ void out4(bf16* p, f32x4 v, bool rmw) {
    if (rmw) { const unsigned long long o = __hip_atomic_load((unsigned long long*)p, RLX_AGENT); const unsigned lo = (unsigned)o, hi = (unsigned)(o >> 32);
        v[0] += __uint_as_float(lo << 16); v[1] += __uint_as_float(lo & 0xffff0000u); v[2] += __uint_as_float(hi << 16); v[3] += __uint_as_float(hi & 0xffff0000u); }
    *(unsigned long long*)p = pack4(v);
}
__device__ __forceinline__ void stage_v(LAS unsigned char* L, const bf16* vbase  , long tokstride, int tid) {
    const int tok = tid >> 3, dvq = (tid & 7) * 4;
    const v2u w = *(const v2u*)(vbase + (size_t)tok * tokstride + dvq);
    LAS unsigned char* p = L + SL_VT + dvq * ST_KT + tok * 2;
    *(LAS unsigned short*)(p) = (unsigned short)(w.x & 0xffffu); *(LAS unsigned short*)(p + ST_KT) = (unsigned short)(w.x >> 16);
    *(LAS unsigned short*)(p + 2 * ST_KT) = (unsigned short)(w.y & 0xffffu); *(LAS unsigned short*)(p + 3 * ST_KT) = (unsigned short)(w.y >> 16);
}
__device__ __forceinline__ void scores2(LAS unsigned char* L, int w, int l15, int quad, f32x4 (&acc)[2]) {
    const int lt = w >> 1;
#pragma unroll
    for (int mi = 0; mi < 2; ++mi) { const int mt = (w & 1) * 2 + mi; f32x4 a4 = {0.f, 0.f, 0.f, 0.f};
#pragma unroll
        for (int ks = 0; ks < 4; ++ks) a4 = MMA16(ldf(L + SL_AK, mt * 16 + l15, ST_AQ, ks * 64 + quad * 16), ldf(L + SL_AQ, lt * 16 + l15, ST_AQ, ks * 64 + quad * 16), a4);
        acc[mi] = a4; }
}

__device__ __forceinline__ void gla_substep(LAS unsigned char* L, const bf16* __restrict__ SIN, const float* __restrict__ SMALL, bf16* __restrict__ OUT, const float* __restrict__ bdec_h  ,
                                            const int dir, const int rowbase, const bool lat, const bool rmw, const int ocol  , const int h, f32x4 (&S)[2], const int tid, const int w, const int lane) {
    const int l15 = lane & 15, quad = lane >> 4;
    if (tid < 256) { const int tok = tid >> 2, r4 = (tid & 3) * 4; const f32x4 v = *(const f32x4*)(SMALL + (size_t)(rowbase + tok) * 64 + dir * 16 + r4);
        *(LAS unsigned long long*)(L + SL_LR + tok * ST_W + r4 * 2) = pack4(v); }
    stage_v(L, SIN + (size_t)rowbase * 4096 + SC_GV + ocol, 4096, tid);
    __syncthreads();
    {
        const int ch = 16 * w + l15; const float bd = bdec_h[ch];
        float g[4][4], p[4][4]; float carry = 0.f;
        const bf16x8 wfr = ldf(L + SL_WUT + dir * 10240, ch, ST_W, quad * 16);
#pragma unroll
        for (int tt = 0; tt < 4; ++tt) {
            f32x4 z = {0.f, 0.f, 0.f, 0.f};
            z = MMA16(ldf(L + SL_LR, tt * 16 + l15, ST_W, quad * 16), wfr, z);
            float run = 0.f;
#pragma unroll
            for (int r = 0; r < 4; ++r) { g[tt][r] = logsig_f(z[r] + bd) * (1.f / 16.f); run += g[tt][r]; p[tt][r] = run; }
            float x = run, y = __shfl_up(x, 16); if (quad >= 1) x += y; y = __shfl_up(x, 32); if (quad >= 2) x += y;
            const float excl = x - run + carry;
#pragma unroll
            for (int r = 0; r < 4; ++r) p[tt][r] += excl;
            carry += __shfl(x, 48 + l15);
        }
        const float T = carry;
        if (quad == 0) *(LAS float*)(L + SL_F + ch * 4) = __expf(T);
        const bf16* qp = SIN + (size_t)rowbase * 4096 + SC_GQ + 128 * h + ch;
#pragma unroll
        for (int tt = 0; tt < 4; ++tt) { f32x4 ke;
#pragma unroll
            for (int r = 0; r < 4; ++r) { const int tok = tt * 16 + quad * 4 + r; const float bcum = dir == 0 ? p[tt][r] : T - p[tt][r] + g[tt][r];
                const float qv = bf2f(qp[(size_t)tok * 4096]), kv = bf2f(qp[(size_t)tok * 4096 + (SC_GK - SC_GQ)]);
                st_lds16(L + SL_AQ + tok * ST_AQ + ch * 2, qv * QK_SCALE * __expf(bcum));
                st_lds16(L + SL_AK + tok * ST_AQ + ch * 2, kv * __expf(-bcum));
                ke[r] = kv * __expf(T - bcum); }
            *(LAS unsigned long long*)(L + SL_KT + ch * ST_KT + (tt * 16 + quad * 4) * 2) = pack4(ke); }
    }
    __syncthreads();
    if (lat) {
        f32x4 sc[2]; scores2(L, w, l15, quad, sc);
        const int l = (w >> 1) * 16 + l15;
#pragma unroll
        for (int mi = 0; mi < 2; ++mi) { const int m0 = ((w & 1) * 2 + mi) * 16 + quad * 4; f32x4 v = sc[mi];
#pragma unroll
            for (int r = 0; r < 4; ++r) { const bool keep = dir == 0 ? (m0 + r <= l) : (m0 + r >= l); v[r] = keep ? v[r] : 0.f; }
            *(LAS unsigned long long*)(L + SL_PM + l * ST_KT + m0 * 2) = pack4(v); }
        __syncthreads();
    }
    if (lat) {
        const int dvt = w & 1, tt = w >> 1; f32x4 a4 = {0.f, 0.f, 0.f, 0.f};
#pragma unroll
        for (int ks = 0; ks < 2; ++ks) a4 = MMA16(ldf(L + SL_VT, dvt * 16 + l15, ST_KT, ks * 64 + quad * 16), ldf(L + SL_PM, tt * 16 + l15, ST_KT, ks * 64 + quad * 16), a4);
#pragma unroll
        for (int ks = 0; ks < 4; ++ks) a4 = MMA16(ldf(L + SL_ST + dir * ST_DIR, dvt * 16 + l15, ST_AQ, ks * 64 + quad * 16), ldf(L + SL_AQ, tt * 16 + l15, ST_AQ, ks * 64 + quad * 16), a4);
        out4(OUT + (size_t)(rowbase + tt * 16 + l15) * 1024 + ocol + dvt * 16 + quad * 4, a4, rmw);
    }
    {
        const f32x4 dec = *(const LAS f32x4*)(L + SL_F + (16 * w + quad * 4) * 4);
#pragma unroll
        for (int dvt = 0; dvt < 2; ++dvt) { f32x4 a4 = S[dvt] * dec;
#pragma unroll
            for (int ks = 0; ks < 2; ++ks) a4 = MMA16(ldf(L + SL_KT, 16 * w + l15, ST_KT, ks * 64 + quad * 16), ldf(L + SL_VT, dvt * 16 + l15, ST_KT, ks * 64 + quad * 16), a4);
            S[dvt] = a4; }
    }
    VM_WAIT(); __syncthreads();
#pragma unroll
    for (int dvt = 0; dvt < 2; ++dvt) *(LAS unsigned long long*)(L + SL_ST + dir * ST_DIR + (dvt * 16 + l15) * ST_AQ + (16 * w + quad * 4) * 2) = pack4(S[dvt]);
}
__device__ __forceinline__ void scan_gla(Frame& F, const int b, const int h, const int slice) {
    LAS unsigned char* L = F.lds; const int tid = F.tid, w = F.wave, lane = F.lane;
#pragma unroll 4
    for (int i = 0; i < 16; ++i) { const int idx = tid * 16 + i, dir = idx >> 12, ch = (idx >> 5) & 127, k = idx & 31;
        const float v = k < 16 ? F.w_up[(size_t)(dir * 16 + k) * 512 + 128 * h + ch] : 0.f; st_lds16(L + SL_WUT + dir * 10240 + ch * ST_W + k * 2, v); }
    for (int i = tid; i < 5120 / 4; i += 512) ((LAS unsigned*)(L + SL_LR))[i] = 0u;
    for (int i = tid; i < 2 * ST_DIR / 4; i += 512) ((LAS unsigned*)(L + SL_ST))[i] = 0u;
    f32x4 Sf[2], Sb[2];
#pragma unroll
    for (int i = 0; i < 2; ++i) { Sf[i] = (f32x4){0.f, 0.f, 0.f, 0.f}; Sb[i] = (f32x4){0.f, 0.f, 0.f, 0.f}; }
    __syncthreads();
    const int ocol = 256 * h + 32 * slice; bf16* OUT = (bf16*)F.out;
    for (int step = 0; step < 68; ++step) {
        { const bool lat = step >= 4; const int chunk = lat ? step - 4 : step; const int rowbase = lat ? b * SEQ + chunk * 64 : ML + b * CTXL + chunk * 64;
          gla_substep(L, F.SIN, F.SMALL, OUT, F.b_dec + 128 * h, 0, rowbase, lat, lat && chunk >= 32, ocol, h, Sf, tid, w, lane); }
        { const bool lat = step >= 4; const int chunk = lat ? 67 - step : 3 - step; const int rowbase = lat ? b * SEQ + chunk * 64 : ML + b * CTXL + chunk * 64;
          gla_substep(L, F.SIN, F.SMALL, OUT, F.b_dec + 512 + 128 * h, 1, rowbase, lat, lat && chunk <= 31, ocol, h, Sb, tid, w, lane); }
    }
    __syncthreads();
}

__device__ __forceinline__ void mlstm_substep(LAS unsigned char* L, const bf16* __restrict__ SIN, const float* __restrict__ SMALL, bf16* __restrict__ OUT, const float* __restrict__ b_gate,
                                              const int dir, const int b, const int chunk, const bool lat, const bool rmw, const int ocol, const int h, const float (&cw)[8], f32x4 (&C)[3], float& mrun,
                                              const int tid, const int w, const int lane) {
    const int l15 = lane & 15, quad = lane >> 4;
    const int plen = lat ? SEQ : CTXL;
#define MROW(p) (lat ? (b * SEQ + ((p) & 63) * 64 + ((p) >> 6)) : (ML + b * CTXL + (p)))
    const long tokstride = lat ? 64 * 4096 : 4096;
    const int row0 = lat ? b * SEQ + chunk : ML + b * CTXL + chunk * 64;
    if (w == 0) {
        const int gi = dir ? 2 : 0; const size_t row = (size_t)row0 + (size_t)lane * (lat ? 64 : 1);
        const float li = SMALL[row * 64 + 32 + 4 * gi + h] + b_gate[gi * 4 + h];
        const float lf = logsig_f(SMALL[row * 64 + 32 + 4 * (gi + 1) + h] + b_gate[(gi + 1) * 4 + h]);
        float x = lf;
#pragma unroll
        for (int o = 1; o < 64; o <<= 1) { const float y = __shfl_up(x, o); if (lane >= o) x += y; }
        const float total = __shfl(x, 63);
        const float bv = dir == 0 ? x : total - x + lf;
        const float av = li - bv;
        float xm = av;
        if (dir == 0) {
#pragma unroll
            for (int o = 1; o < 64; o <<= 1) { const float y = __shfl_up(xm, o); if (lane >= o) xm = fmaxf(xm, y); }
        } else {
#pragma unroll
            for (int o = 1; o < 64; o <<= 1) { const float y = __shfl_down(xm, o); if (lane + o < 64) xm = fmaxf(xm, y); }
        }
        const float Mall = __shfl(xm, dir == 0 ? 63 : 0);
        const float m = mrun;
        const float mq = bv + fmaxf(m, xm);
        const float mnew = total + fmaxf(m, Mall);
        LAS float* Fp = (LAS float*)(L + SL_F);
        Fp[lane] = bv - mq;
        Fp[64 + lane] = av;
        Fp[128 + lane] = __expf(-mq);
        Fp[192 + lane] = __expf(bv + m - mq);
        Fp[256 + lane] = __expf(total + av - mnew);
        if (lane == 0) Fp[320] = __expf(total + m - mnew);
        mrun = mnew;
    }
    stage_v(L, SIN + (size_t)row0 * 4096 + SC_MV + ocol, tokstride, tid);
    float kk[16];
    {
        const int ch = tid & 127, tg = tid >> 7; const int p0 = chunk * 64 + tg * 16;
        const bf16* qcol = SIN + SC_MQ + 128 * h + ch;
        float rq[18], rk[18];
#pragma unroll
        for (int i = 0; i < 18; ++i) { const int p = p0 - 1 + i; const bool ok = p >= 0 && p < plen; const size_t ro = ok ? (size_t)MROW(p) * 4096 : 0;
            rq[i] = ok ? bf2f(qcol[ro]) : 0.f; rk[i] = ok ? bf2f(qcol[ro + (SC_MK - SC_MQ)]) : 0.f; }
#pragma unroll
        for (int i = 0; i < 16; ++i) { const int tok = tg * 16 + i;
            const float aq = cw[3] + cw[0] * rq[i] + cw[1] * rq[i + 1] + cw[2] * rq[i + 2], ak = cw[7] + cw[4] * rk[i] + cw[5] * rk[i + 1] + cw[6] * rk[i + 2];
            const float qv = aq / (1.f + __expf(-aq)); kk[i] = ak / (1.f + __expf(-ak)) * QK_SCALE;
            st_lds16(L + SL_AQ + tok * ST_AQ + ch * 2, qv); st_lds16(L + SL_AK + tok * ST_AQ + ch * 2, kk[i]); }
    }
    __syncthreads();
    {
        const int ch = tid & 127, tg = tid >> 7; const LAS float* Fp = (const LAS float*)(L + SL_F);
#pragma unroll
        for (int q4 = 0; q4 < 4; ++q4) { const f32x4 wk = *(const LAS f32x4*)(Fp + 256 + tg * 16 + q4 * 4); f32x4 v = {kk[q4 * 4] * wk[0], kk[q4 * 4 + 1] * wk[1], kk[q4 * 4 + 2] * wk[2], kk[q4 * 4 + 3] * wk[3]};
            *(LAS unsigned long long*)(L + SL_KT + ch * ST_KT + (tg * 16 + q4 * 4) * 2) = pack4(v); }
        if (lat) {
            f32x4 sc[2]; scores2(L, w, l15, quad, sc);
            const int l = (w >> 1) * 16 + l15; const float rowt = Fp[l];
#pragma unroll
            for (int mi = 0; mi < 2; ++mi) { const int m0 = ((w & 1) * 2 + mi) * 16 + quad * 4; f32x4 v = sc[mi]; const f32x4 av = *(const LAS f32x4*)(Fp + 64 + m0);
#pragma unroll
                for (int r = 0; r < 4; ++r) { const bool keep = dir == 0 ? (m0 + r <= l) : (m0 + r >= l); v[r] = keep ? v[r] * __expf(rowt + av[r]) : 0.f; }
                *(LAS unsigned long long*)(L + SL_PM + l * ST_KT + m0 * 2) = pack4(v); }
        }
    }
    __syncthreads();
    {
        const LAS float* Fp = (const LAS float*)(L + SL_F);
        if (lat) {
            const int dvo = w & 1, tt = w >> 1; f32x4 n1 = {0.f, 0.f, 0.f, 0.f}, n2 = n1, d1 = n1, d2 = n1;
#pragma unroll
            for (int ks = 0; ks < 2; ++ks) { const bf16x8 pm = ldf(L + SL_PM, tt * 16 + l15, ST_KT, ks * 64 + quad * 16);
                n1 = MMA16(ldf(L + SL_VT, dvo * 16 + l15, ST_KT, ks * 64 + quad * 16), pm, n1); d1 = MMA16(ldf(L + SL_VT, 32 + l15, ST_KT, ks * 64 + quad * 16), pm, d1); }
#pragma unroll
            for (int ks = 0; ks < 4; ++ks) { const bf16x8 aq = ldf(L + SL_AQ, tt * 16 + l15, ST_AQ, ks * 64 + quad * 16);
                n2 = MMA16(ldf(L + SL_ST + dir * ST_DIR, dvo * 16 + l15, ST_AQ, ks * 64 + quad * 16), aq, n2); d2 = MMA16(ldf(L + SL_ST + dir * ST_DIR, 32 + l15, ST_AQ, ks * 64 + quad * 16), aq, d2); }
            const int tok = tt * 16 + l15; const float wi = Fp[192 + tok], flo = Fp[128 + tok];
            const float denl = d1[0] + wi * d2[0]; const float den = __shfl(denl, l15);
            const float inv = 1.f / fmaxf(fabsf(den), flo);
            f32x4 hv = (n1 + n2 * wi) * inv;
            out4(OUT + (size_t)(row0 + (size_t)tok * (lat ? 64 : 1)) * 1024 + ocol + dvo * 16 + quad * 4, hv, rmw);
        }
        const float decay = Fp[320];
#pragma unroll
        for (int dvt = 0; dvt < 3; ++dvt) { f32x4 a4 = C[dvt] * decay;
#pragma unroll
            for (int ks = 0; ks < 2; ++ks) a4 = MMA16(ldf(L + SL_KT, 16 * w + l15, ST_KT, ks * 64 + quad * 16), ldf(L + SL_VT, dvt * 16 + l15, ST_KT, ks * 64 + quad * 16), a4);
            C[dvt] = a4; }
    }
    VM_WAIT(); __syncthreads();
#pragma unroll
    for (int dvt = 0; dvt < 3; ++dvt) *(LAS unsigned long long*)(L + SL_ST + dir * ST_DIR + (dvt * 16 + l15) * ST_AQ + (16 * w + quad * 4) * 2) = pack4(C[dvt]);
#undef MROW
}
__device__ __forceinline__ void scan_mlstm(Frame& F, const int b, const int h, const int slice) {
    LAS unsigned char* L = F.lds; const int tid = F.tid, w = F.wave, lane = F.lane;
    for (int i = tid; i < 16 * 72; i += 512) { const int r = i / 72; *(LAS unsigned short*)(L + SL_VT + 32 * ST_KT + i * 2) = r == 0 ? (unsigned short)0x3F80 : (unsigned short)0; }
    for (int i = tid; i < 2 * ST_DIR / 4; i += 512) ((LAS unsigned*)(L + SL_ST))[i] = 0u;
    float cw[8];
    { const int ch = tid & 127, cq = 128 * h + ch, ck = 512 + 128 * h + ch;
      cw[0] = F.conv_w[cq]; cw[1] = F.conv_w[1024 + cq]; cw[2] = F.conv_w[2048 + cq]; cw[3] = F.conv_b[cq];
      cw[4] = F.conv_w[ck]; cw[5] = F.conv_w[1024 + ck]; cw[6] = F.conv_w[2048 + ck]; cw[7] = F.conv_b[ck]; }
    f32x4 Cf[3], Cb[3];
#pragma unroll
    for (int i = 0; i < 3; ++i) { Cf[i] = (f32x4){0.f, 0.f, 0.f, 0.f}; Cb[i] = (f32x4){0.f, 0.f, 0.f, 0.f}; }
    float mf = 0.f, mb = 0.f;
    __syncthreads();
    const int ocol = 256 * h + 32 * slice; bf16* OUT = (bf16*)F.out + (size_t)ML * D;
    for (int step = 0; step < 68; ++step) {
        { const bool lat = step >= 4; const int chunk = lat ? step - 4 : step;
          mlstm_substep(L, F.SIN, F.SMALL, OUT, F.b_gate, 0, b, chunk, lat, lat && chunk >= 32, ocol, h, cw, Cf, mf, tid, w, lane); }
        { const bool lat = step >= 4; const int chunk = lat ? 67 - step : 3 - step;
          mlstm_substep(L, F.SIN, F.SMALL, OUT, F.b_gate, 1, b, chunk, lat, lat && chunk <= 31, ocol, h, cw, Cb, mb, tid, w, lane); }
    }
    __syncthreads();
}
struct MergeOrder {
    int pm, pn; bool valid;
    __device__ __forceinline__ bool next(int i, pg8::Unit& u) const {
        if (!valid || i >= 4) return false;
        u.pm = pm + (i == 0 ? 68 : (i == 2 ? 132 : 0));
        u.pn = pn + (i == 0 ? WT_BR1 : (i == 1 ? WT_MRG1 : (i == 2 ? WT_BR2 : WT_MRG2)));
        return true;
    }
    __device__ __forceinline__ void a_ready(const pg8::Unit&) const {}
    __device__ __forceinline__ void done(const pg8::Unit&) const {}
};

struct Args { const float* in[22]; float* out; unsigned char* ws; int ph_lo, ph_hi, li, pad; };
__global__ void __launch_bounds__(NWAVES * 64, 2) mk_fwd(Args args) {
    extern __shared__ __attribute__((aligned(16))) unsigned char lds[];
    Frame F;
    F.lds = (LAS unsigned char*)lds;
    F.MISC = (volatile LAS unsigned*)(F.lds + MISC_OFF);
    F.tid = threadIdx.x; F.lane = F.tid & 63; F.wave = __builtin_amdgcn_readfirstlane(F.tid >> 6);
    F.G = gridDim.x; { const int bx = blockIdx.x; F.vcu = (F.G % 8 == 0) ? (bx % 8) * (F.G / 8) + bx / 8 : bx; }
    unsigned char* ws = args.ws;
    F.ctl = (gu32*)(ws + WS_CTL);
    F.x = args.in[0]; F.c = args.in[1]; F.ctx = args.in[2]; F.cctx = args.in[3]; F.w_ada = args.in[4]; F.b_ada = args.in[5]; F.norm1_g = args.in[6]; F.w_in = args.in[7];
    F.w_up = args.in[8]; F.b_dec = args.in[9]; F.gla_g = args.in[10]; F.conv_w = args.in[11]; F.conv_b = args.in[12]; F.b_gate = args.in[13]; F.mlstm_g = args.in[14];
    F.w_br1 = args.in[15]; F.w_br2 = args.in[16]; F.w_out = args.in[17]; F.norm2_g = args.in[18]; F.w_f1 = args.in[19]; F.w_f2 = args.in[20]; F.final_g = args.in[21];
    F.out = args.out;
    F.WT = (bf16*)(ws + WS_WT); F.W2T = (bf16*)(ws + WS_W2T); F.XN = (bf16*)(ws + WS_XN); F.Y1 = (bf16*)(ws + WS_Y1); F.Y2 = (bf16*)(ws + WS_Y2); F.SIN = (bf16*)(ws + WS_SIN);
    F.Y = (bf16*)(ws + WS_Y); F.HF = (bf16*)(ws + WS_HF); F.SMALL = (float*)(ws + WS_SMALL); F.T2 = (float*)(ws + WS_T2);
    F.MOD = (float*)(ws + WS_CTL + CTL_MOD); F.SS1 = (float*)(ws + WS_CTL + CTL_SS1); F.SS2 = (float*)(ws + WS_CTL + CTL_SS2);
    for (int u = F.tid; u < (LDS_BYTES - LDSCTL_OFF) / 4; u += NWAVES * 64) ((LAS unsigned*)(F.lds + LDSCTL_OFF))[u] = 0u;
    __syncthreads();
    XcdBarrier bar; bar.bar = (unsigned*)(F.ctl + CW_BAR); bar.x = 0; bar.st = nullptr;
    if (N_LAUNCHES != PER_PHASE) bar = xcd_barrier_post((unsigned*)(F.ctl + CW_BAR), F.MISC + 8);
#define GRID_BAR(seam) do { if (N_LAUNCHES == PER_PHASE) { if (F.tid == 0) __hip_atomic_store(F.ctl + CW_TMO, 0xBADBA0u | (unsigned)(seam), RLX_AGENT); } else { xcd_barrier(bar); } } while (0)
    const int lo = args.ph_lo, hi = args.ph_hi;
#define IN(k) (lo <= (k) && (k) < hi)
#define BOTH(k) (IN(k) && IN((k) + 1))
    const int gw = F.vcu * NWAVES + F.wave, NGW = F.G * NWAVES;

    if (IN(0)) { p0_prologue(F); if (BOTH(0)) GRID_BAR(0); }

    if (IN(1)) {
        for (int m = gw; m < MT; m += NGW) {
            const float* src = m < ML ? F.x + (size_t)m * D : F.ctx + (size_t)(m - ML) * D;
            const float* mod = F.MOD + (size_t)(m < ML ? (m >> 12) : 4) * 6144;
            norm_mod_row(F, src, -1.f, F.norm1_g, mod, mod + D, F.XN + (size_t)m * D);
        }
        if (BOTH(1)) GRID_BAR(1);
    }

    if (IN(2)) {
        pg8::Gemm g{F.XN, F.WT, MT, 17 * 256, D}; pg8::StaticOrder S; S.init(MT, 17 * 256, F.G, (int)blockIdx.x);
        pg8::EpiScanIn E{F.SIN, F.SMALL};
        pg8::gemm_phase<pg8::EpiScanIn, pg8::StaticOrder, true, true>(F.lds + RING_OFF, g, S, E);
        if (BOTH(2)) GRID_BAR(2);
    }

    if (IN(3)) {
        for (int u = F.vcu; u < 256; u += F.G) {
            const int mixer = u >> 7, bh = (u >> 3) & 15, b = bh >> 2, h = bh & 3, slice = u & 7;
            if (mixer == 0) scan_gla(F, b, h, slice); else scan_mlstm(F, b, h, slice);
        }
        if (BOTH(3)) GRID_BAR(3);
    }

    if (IN(4)) {
        pg8::Gemm g{F.XN, F.WT + (size_t)WT_OG * 256 * D, ML, 2048, D}; pg8::StaticOrder S; S.init(ML, 2048, F.G, (int)blockIdx.x);
        pg8::EpiOutGate E{(const bf16*)F.out, (const bf16*)F.out + (size_t)ML * D, F.gla_g, F.mlstm_g, F.Y1, F.Y2, (LAS float*)(F.lds + EPI_ST_OFF)};
        pg8::gemm_phase<pg8::EpiOutGate, pg8::StaticOrder, true, true>(F.lds + RING_OFF, g, S, E);
        if (BOTH(4)) GRID_BAR(4);
    }

    if (IN(5)) {
        pg8::StaticOrder SO; SO.init(ML, D, F.G, (int)blockIdx.x);
        pg8::Gemm g{F.XN, F.WT, MT + 2 * ML, WT_TILES * 256, D};
        pg8::EpiMerge E{F.out, F.T2, F.Y};
        for (int r = 0;; ++r) { pg8::Unit t; MergeOrder S; S.valid = SO.next(r, t); if (!S.valid) break; S.pm = t.pm; S.pn = t.pn;
            pg8::gemm_phase<pg8::EpiMerge, MergeOrder, true, true>(F.lds + RING_OFF, g, S, E); }
        if (BOTH(5)) GRID_BAR(5);
    }

    if (IN(6)) {
        pg8::Gemm g{F.Y, F.WT + (size_t)WT_OUT * 256 * D, ML, D, D}; pg8::StaticOrder S; S.init(ML, D, F.G, (int)blockIdx.x);
        pg8::EpiResid E{F.x, F.out, F.MOD, 2, F.SS1};
        pg8::gemm_phase<pg8::EpiResid, pg8::StaticOrder, true, true>(F.lds + RING_OFF, g, S, E);
        if (BOTH(6)) GRID_BAR(6);
    }

    if (IN(7)) {
        for (int m = gw; m < ML; m += NGW) {
            const float* mod = F.MOD + (size_t)(m >> 12) * 6144;
            const float ss = __hip_atomic_load(F.SS1 + m, RLX_AGENT);
            norm_mod_row(F, F.out + (size_t)m * D, ss, F.norm2_g, mod + 3 * D, mod + 4 * D, F.XN + (size_t)m * D);
        }
        if (BOTH(7)) GRID_BAR(7);
    }

    if (IN(8)) {
        pg8::Gemm g{F.XN, F.WT + (size_t)WT_FFN1 * 256 * D, ML, 2 * DFF, D}; pg8::StaticOrder S; S.init(ML, 2 * DFF, F.G, (int)blockIdx.x);
        pg8::EpiSwiglu E{F.HF};
        pg8::gemm_phase<pg8::EpiSwiglu, pg8::StaticOrder, true, true>(F.lds + RING_OFF, g, S, E);
        if (BOTH(8)) GRID_BAR(8);
    }

    if (IN(9)) {
        pg8::Gemm g{F.HF, F.W2T, ML, D, DFF}; pg8::StaticOrder S; S.init(ML, D, F.G, (int)blockIdx.x);
        pg8::EpiResid E{F.out, F.out, F.MOD, 5, F.SS2};
        pg8::gemm_phase<pg8::EpiResid, pg8::StaticOrder, true, true>(F.lds + RING_OFF, g, S, E);
        if (BOTH(9)) GRID_BAR(9);
    }

    if (IN(10)) {
        for (int m = gw; m < ML; m += NGW) {
            const float ss = __hip_atomic_load(F.SS2 + m, RLX_AGENT);
            const float rstd = 1.f / sqrtf(ss * (1.f / D) + RMS_EPS);
            GAS f32x4* xr = (GAS f32x4*)(F.out + (size_t)m * D) + F.lane;
#pragma unroll
            for (int j = 0; j < 4; ++j) { const f32x4 gv = ((const GAS f32x4*)F.final_g)[F.lane + 64 * j]; xr[64 * j] = xr[64 * j] * rstd * gv; }
        }
    }
#undef IN
#undef BOTH
}

extern "C" void kernel_launch(void* const* d_in, const int* in_sizes, int n_in, void* d_out, int out_size, void* d_ws, size_t ws_size, hipStream_t stream) {
    static int grid = 0;
    if (grid == 0) {
        if (n_in != 22 || in_sizes[0] != ML * D || out_size != ML * D || ws_size < WS_END) { fprintf(stderr, "kernel_launch: unexpected shapes (n_in %d, in0 %d, out %d, ws %zu)\n", n_in, n_in > 0 ? in_sizes[0] : -1, out_size, ws_size); grid = -1; return; }
        int dev = 0, cus = 0;
        if (hipGetDevice(&dev) != hipSuccess || hipDeviceGetAttribute(&cus, hipDeviceAttributeMultiprocessorCount, dev) != hipSuccess) { grid = -1; return; }
        if (hipFuncSetAttribute((const void*)mk_fwd, hipFuncAttributeMaxDynamicSharedMemorySize, LDS_BYTES) != hipSuccess) { fprintf(stderr, "kernel_launch: hipFuncSetAttribute failed\n"); grid = -1; return; }
        int per_cu = 0;
        if (hipOccupancyMaxActiveBlocksPerMultiprocessor(&per_cu, (const void*)mk_fwd, NWAVES * 64, LDS_BYTES) != hipSuccess || per_cu < 1) fprintf(stderr, "kernel_launch: occupancy query reports %d\n", per_cu);
        (void)hipGetLastError();
        grid = cus;
    }
    if (grid < 0) return;
    if (hipMemsetAsync((char*)d_ws + WS_CTL, 0, CTL_ZERO_BYTES, stream) != hipSuccess) return;
    Args a{};
    for (int i = 0; i < 22; ++i) a.in[i] = (const float*)d_in[i];
    a.out = (float*)d_out; a.ws = (unsigned char*)d_ws;
    for (int li = 0; li < N_LAUNCHES; ++li) {
        a.ph_lo = (N_LAUNCHES == PER_PHASE) ? li : 0; a.ph_hi = (N_LAUNCHES == PER_PHASE) ? li + 1 : PER_PHASE; a.li = li;
        hipLaunchKernelGGL(mk_fwd, dim3(grid), dim3(NWAVES * 64), LDS_BYTES, stream, a);
    }
}
```

```cpp
#include <hip/hip_runtime.h>
#include <cstdio>
#include <cstdint>
#ifndef MK_N_LAUNCHES
#define MK_N_LAUNCHES 1
#endif
#ifndef MK_DUP
#define MK_DUP 0
#endif
namespace pg8 {
#define PG8_LAS __attribute__((address_space(3)))
typedef unsigned short bf16_t;
typedef short bf16x8 __attribute__((ext_vector_type(8)));
typedef float f32x4 __attribute__((ext_vector_type(4)));
typedef unsigned u32x4 __attribute__((ext_vector_type(4)));
constexpr int BM = 256, BK = 64, HALF = 128, HTB = HALF * BK * 2  , STAGE_BYTES = 8 * HTB, NXCD = 8, WGM = 8;

__host__ __device__ __forceinline__ int lds_byte(int r, int c) { const int st = (r >> 4) * 2 + (c >> 5), rr = r & 15, cc = c & 31, ob = rr * 64 + cc * 2; return st * 1024 + (ob ^ (((ob >> 9) & 1) << 5)); }
__host__ __device__ __forceinline__ void stage_rc(int b, int& R, int& C) { const int st = b / 1024, sb = b % 1024, swz = sb ^ (((sb >> 9) & 1) << 5); R = (st >> 1) * 16 + swz / 64; C = (st & 1) * 32 + (swz % 64) / 2; }
__host__ __device__ __forceinline__ int perm32(int rho) { const int n = rho >> 4, i = rho & 15; return 8 * (i >> 2) + 4 * n + (i & 3); }

struct Unit { int pm, pn; };
struct Gemm { const bf16_t* A; const bf16_t* Bt; int M, N, K; };

struct StaticOrder {
    int nM, nN, nwg, G, c;
    __host__ __device__ void init(int M, int N, int G_, int c_) { nM = M / BM; nN = N / BM; nwg = nM * nN; G = G_; c = c_; }
    __host__ __device__ bool next(int i, Unit& u) const {
        const long L = (long)i * G + c; if (L >= nwg) return false;
        int wgid = (int)L; { const int q = nwg / NXCD, r = nwg % NXCD, xcd = wgid % NXCD, off = wgid / NXCD; wgid = (xcd < r ? xcd * (q + 1) : r * (q + 1) + (xcd - r) * q) + off; }
        const int nig = WGM * nN, gid = wgid / nig, fm = gid * WGM, gsz = (nM - fm) < WGM ? (nM - fm) : WGM;
        u.pm = fm + ((wgid % nig) % gsz); u.pn = (wgid % nig) / gsz; return true;
    }
    __device__ __forceinline__ void a_ready(const Unit&) const {}
    __device__ __forceinline__ void done(const Unit&) const {}
};

typedef float f32x2c __attribute__((ext_vector_type(2))); typedef __bf16 bf16x2c __attribute__((ext_vector_type(2)));
__device__ __forceinline__ unsigned cvt_pk_bf16(float lo, float hi) { const f32x2c v = {lo, hi}; const bf16x2c b = __builtin_convertvector(v, bf16x2c); return __builtin_bit_cast(unsigned, b); }
typedef float f32x2 __attribute__((ext_vector_type(2)));
__device__ __forceinline__ float sigm_f(float x) { return __builtin_amdgcn_rcpf(1.f + __expf(-x)); }
__device__ __forceinline__ float silu_f(float x) { return x * sigm_f(x); }
__device__ __forceinline__ float bf_lo(unsigned w) { return __uint_as_float(w << 16); }
__device__ __forceinline__ float bf_hi(unsigned w) { return __uint_as_float(w & 0xffff0000u); }
__device__ __forceinline__ u32x4 pack8(const f32x4& a, const f32x4& b) { u32x4 w; w.x = cvt_pk_bf16(a[0], a[1]); w.y = cvt_pk_bf16(a[2], a[3]); w.z = cvt_pk_bf16(b[0], b[1]); w.w = cvt_pk_bf16(b[2], b[3]); return w; }

struct EpiScanIn {
    static constexpr bool PERM = true, AFTER_DRAIN = false;
    bf16_t* SIN; float* SMALL;
    __device__ __forceinline__ void operator()(const f32x4 (&acc)[2][2][4][2], const Unit& u, int wr, int wc, int fr, int fq) const {
        const int row0 = u.pm * BM + wr * 64 + fr;
        if (u.pn < 16) {
#pragma unroll
            for (int ai = 0; ai < 2; ++ai)
#pragma unroll
                for (int m = 0; m < 4; ++m) { bf16_t* rowp = SIN + (size_t)(row0 + ai * HALF + m * 16) * 4096 + u.pn * BM + wc * 32 + 8 * fq;
#pragma unroll
                    for (int bj = 0; bj < 2; ++bj) *(u32x4*)(rowp + bj * HALF) = pack8(acc[ai][bj][m][0], acc[ai][bj][m][1]); }
        } else if (wc < 2) {
#pragma unroll
            for (int ai = 0; ai < 2; ++ai)
#pragma unroll
                for (int m = 0; m < 4; ++m) { float* p = SMALL + (size_t)(row0 + ai * HALF + m * 16) * 64 + wc * 32 + 8 * fq;
                    *(f32x4*)p = acc[ai][0][m][0]; *(f32x4*)(p + 4) = acc[ai][0][m][1]; }
        }
    }
};

struct EpiOutGate {
    static constexpr bool PERM = true, AFTER_DRAIN = false;
    const bf16_t* OHo; const bf16_t* OHh; const float* gg; const float* mg; bf16_t* Y1; bf16_t* Y2; PG8_LAS float* st;
    __device__ __forceinline__ void operator()(const f32x4 (&acc)[2][2][4][2], const Unit& u, int wr, int wc, int fr, int fq) const {
        const bool isg = u.pn < 4; const int head = u.pn & 3;
        const bf16_t* src = (isg ? OHo : OHh) + head * 256; const float* gain = (isg ? gg : mg) + head * 256; bf16_t* dst = (isg ? Y1 : Y2) + head * 256;
        const int row0 = u.pm * BM + wr * 64 + fr, cb = wc * 32 + 8 * fq;
#pragma unroll
        for (int ai = 0; ai < 2; ++ai)
#pragma unroll
            for (int m = 0; m < 4; ++m) { float s = 0.f; const bf16_t* rp = src + (size_t)(row0 + ai * HALF + m * 16) * 1024 + cb;
#pragma unroll
                for (int bj = 0; bj < 2; ++bj) { const u32x4 w = *(const u32x4*)(rp + bj * HALF);
                    float a; a = bf_lo(w.x); s += a * a; a = bf_hi(w.x); s += a * a; a = bf_lo(w.y); s += a * a; a = bf_hi(w.y); s += a * a;
                    a = bf_lo(w.z); s += a * a; a = bf_hi(w.z); s += a * a; a = bf_lo(w.w); s += a * a; a = bf_hi(w.w); s += a * a; }
                s += __shfl_xor(s, 16); s += __shfl_xor(s, 32);
                if (fq == 0) st[(ai * HALF + wr * 64 + m * 16 + fr) * 4 + wc] = s; }
        asm volatile("s_waitcnt lgkmcnt(0)" ::: "memory"); __builtin_amdgcn_s_barrier(); asm volatile("" ::: "memory");
        f32x4 g8[2][2];
#pragma unroll
        for (int bj = 0; bj < 2; ++bj) { g8[bj][0] = *(const f32x4*)(gain + cb + bj * HALF); g8[bj][1] = *(const f32x4*)(gain + cb + bj * HALF + 4); }
#pragma unroll
        for (int ai = 0; ai < 2; ++ai)
#pragma unroll
            for (int m = 0; m < 4; ++m) { const int rl = ai * HALF + wr * 64 + m * 16 + fr; const f32x4 t = *(const PG8_LAS f32x4*)(st + rl * 4);
                const float rstd = __builtin_amdgcn_rsqf(((t[0] + t[1]) + (t[2] + t[3])) * (1.f / 256.f) + 1e-6f);
                const bf16_t* rp = src + (size_t)(row0 + ai * HALF + m * 16) * 1024 + cb; bf16_t* dp = dst + (size_t)(row0 + ai * HALF + m * 16) * 1024 + cb;
#pragma unroll
                for (int bj = 0; bj < 2; ++bj) { const u32x4 w = *(const u32x4*)(rp + bj * HALF);
                    f32x4 o0 = {bf_lo(w.x), bf_hi(w.x), bf_lo(w.y), bf_hi(w.y)}, o1 = {bf_lo(w.z), bf_hi(w.z), bf_lo(w.w), bf_hi(w.w)};
                    f32x4 a0 = acc[ai][bj][m][0], a1 = acc[ai][bj][m][1];
#pragma unroll
                    for (int e = 0; e < 4; ++e) { a0[e] = isg ? silu_f(a0[e]) : sigm_f(a0[e]); a1[e] = isg ? silu_f(a1[e]) : sigm_f(a1[e]); }
                    o0 = o0 * rstd * g8[bj][0] * a0; o1 = o1 * rstd * g8[bj][1] * a1;
                    *(u32x4*)(dp + bj * HALF) = pack8(o0, o1); } }
        asm volatile("s_waitcnt lgkmcnt(0)" ::: "memory"); __builtin_amdgcn_s_barrier(); asm volatile("" ::: "memory");
    }
};

struct EpiMerge {
    static constexpr bool PERM = true, AFTER_DRAIN = false;
    float* T; float* T2; bf16_t* Y;
    __device__ __forceinline__ void operator()(const f32x4 (&acc)[2][2][4][2], const Unit& u, int wr, int wc, int fr, int fq) const {
        const int step = u.pn >= 37 ? 2 : (u.pn >= 33 ? 0 : (u.pn >= 29 ? 3 : 1));
        const int opm = u.pm - (step == 0 ? 68 : (step == 2 ? 132 : 0)), opn = (u.pn - 25) & 3;
        const size_t tb = ((size_t)(opm * 4 + opn) * 32) * 512 + threadIdx.x;
        f32x4* t = (f32x4*)T + tb; f32x4* t2 = (f32x4*)T2 + tb;
        const int row0 = opm * BM + wr * 64 + fr, cb = opn * BM + wc * 32 + 8 * fq;
#pragma unroll
        for (int ai = 0; ai < 2; ++ai)
#pragma unroll
            for (int m = 0; m < 4; ++m)
#pragma unroll
                for (int bj = 0; bj < 2; ++bj) {
                    const int j0 = ((ai * 2 + bj) * 4 + m) * 2;
                    if (step == 0) { t[(size_t)j0 * 512] = acc[ai][bj][m][0]; t[(size_t)(j0 + 1) * 512] = acc[ai][bj][m][1]; }
                    else if (step == 2) { t2[(size_t)j0 * 512] = acc[ai][bj][m][0]; t2[(size_t)(j0 + 1) * 512] = acc[ai][bj][m][1]; }
                    else {
                        f32x4 s0 = acc[ai][bj][m][0], s1 = acc[ai][bj][m][1];
#pragma unroll
                        for (int e = 0; e < 4; ++e) { s0[e] = sigm_f(s0[e]); s1[e] = sigm_f(s1[e]); }
                        if (step == 1) { t[(size_t)j0 * 512] = t[(size_t)j0 * 512] * s0; t[(size_t)(j0 + 1) * 512] = t[(size_t)(j0 + 1) * 512] * s1; }
                        else { const f32x4 y0 = t[(size_t)j0 * 512] + t2[(size_t)j0 * 512] * s0, y1 = t[(size_t)(j0 + 1) * 512] + t2[(size_t)(j0 + 1) * 512] * s1;
                            *(u32x4*)(Y + (size_t)(row0 + ai * HALF + m * 16) * 1024 + cb + bj * HALF) = pack8(y0, y1); }
                    }
                }
    }
};

struct EpiResid {
    static constexpr bool PERM = false, AFTER_DRAIN = false;
    const float* base; float* out; const float* mod; int gidx; float* ss;
    __device__ __forceinline__ void operator()(const f32x4 (&acc)[2][2][4][2], const Unit& u, int wr, int wc, int fr, int fq) const {
        const float* gate = mod + (size_t)(u.pm >> 4) * 6144 + gidx * 1024;
        const int row0 = u.pm * BM + wr * 64 + fr, col0 = u.pn * BM + wc * 32 + 4 * fq;
        f32x4 gv[2][2];
#pragma unroll
        for (int bj = 0; bj < 2; ++bj)
#pragma unroll
            for (int n = 0; n < 2; ++n) gv[bj][n] = *(const f32x4*)(gate + col0 + bj * HALF + n * 16);
#pragma unroll
        for (int ai = 0; ai < 2; ++ai)
#pragma unroll
            for (int m = 0; m < 4; ++m) { const int row = row0 + ai * HALF + m * 16; const size_t off = (size_t)row * 1024 + col0; float s = 0.f;
#pragma unroll
                for (int bj = 0; bj < 2; ++bj)
#pragma unroll
                    for (int n = 0; n < 2; ++n) { const f32x4 xv = *(const f32x4*)(base + off + bj * HALF + n * 16); const f32x4 o = xv + gv[bj][n] * acc[ai][bj][m][n];
                        *(f32x4*)(out + off + bj * HALF + n * 16) = o; s += (o[0] * o[0] + o[1] * o[1]) + (o[2] * o[2] + o[3] * o[3]); }
                s += __shfl_xor(s, 16); s += __shfl_xor(s, 32);
                if (fq == 0) atomicAdd(ss + row, s); }
    }
};

struct EpiSwiglu {
    static constexpr bool PERM = true, AFTER_DRAIN = false;
    bf16_t* Hf;
    __device__ __forceinline__ void operator()(const f32x4 (&acc)[2][2][4][2], const Unit& u, int wr, int wc, int fr, int fq) const {
        const int row0 = u.pm * BM + wr * 64 + fr, cb = u.pn * HALF + wc * 32 + 8 * fq;
#pragma unroll
        for (int ai = 0; ai < 2; ++ai)
#pragma unroll
            for (int m = 0; m < 4; ++m) { f32x4 h0 = acc[ai][0][m][0], h1 = acc[ai][0][m][1];
#pragma unroll
                for (int e = 0; e < 4; ++e) { h0[e] = silu_f(h0[e]) * acc[ai][1][m][0][e]; h1[e] = silu_f(h1[e]) * acc[ai][1][m][1][e]; }
                *(u32x4*)(Hf + (size_t)(row0 + ai * HALF + m * 16) * 2816 + cb) = pack8(h0, h1); }
    }
};
template <class Epi, class Sched, bool ALIGN_EPI = false, bool SP2 = false>
__device__ __forceinline__ void gemm_phase(PG8_LAS unsigned char* lds, const Gemm g, const Sched& S, const Epi& E) {
    const int tid = threadIdx.x, wid = __builtin_amdgcn_readfirstlane(tid >> 6), lane = tid & 63, wr = wid >> 2, wc = wid & 3, fr = lane & 15, fq = lane >> 4;
    const int K = g.K, nt = K / BK;
    unsigned voffA[2], voffB[2];
#pragma unroll
    for (int i = 0; i < 2; ++i) { int R, C; stage_rc(tid * 16 + i * 8192, R, C); const int Rb = Epi::PERM ? ((R & ~31) + perm32(R & 31)) : R;
        voffA[i] = (unsigned)(R * K + C) * 2u; voffB[i] = (unsigned)(Rb * K + C) * 2u; }
    const size_t kstep = (size_t)(BK * 2);
    const size_t hstep = (size_t)HALF * K * 2;
    const size_t tstep = 2 * hstep;
    const unsigned ldsw = (unsigned)wid * 1024u;
    const int aoff = lds_byte(wr * 64 + fr, fq * 8), boff = lds_byte(wc * 32 + fr, fq * 8);
#define PG8_SA(b, h) (((b) * 2 + (h)) * HTB)
#define PG8_SB(b, h) ((4 + (b) * 2 + (h)) * HTB)
#define PG8_STAGE(bufoff, gbase, voff) do { _Pragma("unroll") for (int _i = 0; _i < 2; ++_i) \
        __builtin_amdgcn_global_load_lds((const unsigned*)((const char*)(gbase) + (voff)[_i]), (PG8_LAS unsigned*)(lds + (bufoff) + ldsw + _i * 8192), 16, 0, 0); } while (0)
#define PG8_LDA(dst, b, h) do { _Pragma("unroll") for (int m = 0; m < 4; ++m) _Pragma("unroll") for (int k = 0; k < 2; ++k) dst[m][k] = *(const PG8_LAS bf16x8*)(lds + PG8_SA(b, h) + aoff + m * 2048 + k * 1024); } while (0)
#define PG8_LDB(dst, b, h) do { _Pragma("unroll") for (int n = 0; n < 2; ++n) _Pragma("unroll") for (int k = 0; k < 2; ++k) dst[n][k] = *(const PG8_LAS bf16x8*)(lds + PG8_SB(b, h) + boff + n * 2048 + k * 1024); } while (0)
#define PG8_MMA(ai, bj, At, Bt) do { __builtin_amdgcn_s_setprio(1); _Pragma("unroll") for (int m = 0; m < 4; ++m) _Pragma("unroll") for (int n = 0; n < 2; ++n) _Pragma("unroll") for (int k = 0; k < 2; ++k) \
        acc[ai][bj][m][n] = __builtin_amdgcn_mfma_f32_16x16x32_bf16(Bt[n][k], At[m][k], acc[ai][bj][m][n], 0, 0, 0); __builtin_amdgcn_s_setprio(0); } while (0)
#define PG8_WAIT_V(n) asm volatile("s_waitcnt vmcnt(" #n ")" ::: "memory")
#define PG8_WAIT_L(n) asm volatile("s_waitcnt lgkmcnt(" #n ")" ::: "memory")
#define PG8_BAR __builtin_amdgcn_s_barrier()
#define PG8_SCHED __builtin_amdgcn_sched_barrier(0)
    Unit cur, nxt; int ui = 0;
    if (!S.next(0, cur)) return;
    f32x4 acc[2][2][4][2];
#pragma unroll
    for (int a = 0; a < 2; ++a)
#pragma unroll
        for (int b = 0; b < 2; ++b)
#pragma unroll
            for (int m = 0; m < 4; ++m)
#pragma unroll
                for (int n = 0; n < 2; ++n) acc[a][b][m][n] = (f32x4){0.f, 0.f, 0.f, 0.f};
    bf16x8 At[4][2], B0[2][2], B1[2][2];
    const char* cA = (const char*)g.A + (size_t)cur.pm * tstep; const char* cB = (const char*)g.Bt + (size_t)cur.pn * tstep;
    S.a_ready(cur);
    if constexpr (SP2) {
        PG8_STAGE(PG8_SB(0, 0), cB, voffB); PG8_STAGE(PG8_SB(0, 1), cB + hstep, voffB); PG8_STAGE(PG8_SA(0, 0), cA, voffA); PG8_STAGE(PG8_SA(0, 1), cA + hstep, voffA);
        if (wr == 1) PG8_BAR;
        PG8_WAIT_V(2); PG8_BAR;
        PG8_STAGE(PG8_SB(1, 0), cB + kstep, voffB); PG8_STAGE(PG8_SA(1, 0), cA + kstep, voffA); PG8_STAGE(PG8_SB(1, 1), cB + hstep + kstep, voffB);
        PG8_WAIT_V(6); PG8_BAR;
    } else {
        PG8_STAGE(PG8_SB(0, 0), cB, voffB); PG8_STAGE(PG8_SA(0, 0), cA, voffA); PG8_STAGE(PG8_SB(0, 1), cB + hstep, voffB); PG8_STAGE(PG8_SA(0, 1), cA + hstep, voffA);
        if (wr == 1) PG8_BAR;
        PG8_WAIT_V(4); PG8_BAR;
        PG8_STAGE(PG8_SB(1, 0), cB + kstep, voffB); PG8_STAGE(PG8_SA(1, 0), cA + kstep, voffA); PG8_STAGE(PG8_SB(1, 1), cB + hstep + kstep, voffB);
        PG8_WAIT_V(6); PG8_BAR;
    }
    for (;;) {
        const bool has_next = S.next(ui + 1, nxt);
        const char* nA = has_next ? (const char*)g.A + (size_t)nxt.pm * tstep : cA; const char* nB = has_next ? (const char*)g.Bt + (size_t)nxt.pn * tstep : cB;
        for (int t = 0; t < nt; t += 2) {
            const bool last = (t == nt - 2);
            const char* a1 = cA + (size_t)(t + 1) * kstep;
            const char* a2 = last ? nA : cA + (size_t)(t + 2) * kstep; const char* b2 = last ? nB : cB + (size_t)(t + 2) * kstep;
            const char* a3 = a2 + kstep; const char* b3 = b2 + kstep;
            if (last && has_next) S.a_ready(nxt);
            if constexpr (SP2) {
            PG8_LDB(B0, 0, 0); PG8_LDB(B1, 0, 1); PG8_SCHED; PG8_LDA(At, 0, 0); PG8_STAGE(PG8_SA(1, 1), a1 + hstep, voffA);
            PG8_WAIT_V(8); PG8_WAIT_L(0); PG8_BAR; PG8_MMA(0, 0, At, B0); PG8_MMA(0, 1, At, B1); PG8_BAR; PG8_SCHED;
            PG8_LDA(At, 0, 1); PG8_STAGE(PG8_SB(0, 0), b2, voffB); PG8_STAGE(PG8_SB(0, 1), b2 + hstep, voffB); PG8_STAGE(PG8_SA(0, 0), a2, voffA);
            PG8_WAIT_V(8); PG8_WAIT_L(0); PG8_BAR; PG8_MMA(1, 0, At, B0); PG8_MMA(1, 1, At, B1); PG8_BAR; PG8_SCHED;
            PG8_LDB(B0, 1, 0); PG8_LDB(B1, 1, 1); PG8_SCHED; PG8_LDA(At, 1, 0); PG8_STAGE(PG8_SA(0, 1), a2 + hstep, voffA);
            PG8_WAIT_V(8); PG8_WAIT_L(0); PG8_BAR; PG8_MMA(0, 0, At, B0); PG8_MMA(0, 1, At, B1); PG8_BAR; PG8_SCHED;
            PG8_LDA(At, 1, 1); PG8_STAGE(PG8_SB(1, 0), b3, voffB); PG8_STAGE(PG8_SB(1, 1), b3 + hstep, voffB); PG8_STAGE(PG8_SA(1, 0), a3, voffA);
            PG8_WAIT_V(8); PG8_WAIT_L(0); PG8_BAR; PG8_MMA(1, 0, At, B0); PG8_MMA(1, 1, At, B1); PG8_BAR; PG8_SCHED;
            } else {
            PG8_LDB(B0, 0, 0); PG8_SCHED; PG8_LDA(At, 0, 0); PG8_STAGE(PG8_SA(1, 1), a1 + hstep, voffA);
            PG8_WAIT_L(8); PG8_BAR; PG8_WAIT_L(0); PG8_MMA(0, 0, At, B0); PG8_BAR; PG8_SCHED;
            PG8_LDB(B1, 0, 1); PG8_STAGE(PG8_SB(0, 0), b2, voffB);
            PG8_BAR; PG8_WAIT_L(0); PG8_MMA(0, 1, At, B1); PG8_BAR;
            PG8_LDA(At, 0, 1); PG8_STAGE(PG8_SA(0, 0), a2, voffA);
            PG8_BAR; PG8_WAIT_L(0); PG8_MMA(1, 0, At, B0); PG8_BAR; PG8_SCHED;
            PG8_STAGE(PG8_SB(0, 1), b2 + hstep, voffB);
            PG8_WAIT_V(6); PG8_BAR; PG8_MMA(1, 1, At, B1); PG8_BAR;
            PG8_LDB(B0, 1, 0); PG8_SCHED; PG8_LDA(At, 1, 0); PG8_STAGE(PG8_SA(0, 1), a2 + hstep, voffA);
            PG8_WAIT_L(8); PG8_BAR; PG8_WAIT_L(0); PG8_MMA(0, 0, At, B0); PG8_BAR; PG8_SCHED;
            PG8_LDB(B1, 1, 1); PG8_STAGE(PG8_SB(1, 0), b3, voffB);
            PG8_BAR; PG8_WAIT_L(0); PG8_MMA(0, 1, At, B1); PG8_BAR;
            PG8_LDA(At, 1, 1); PG8_STAGE(PG8_SA(1, 0), a3, voffA);
            PG8_BAR; PG8_WAIT_L(0); PG8_MMA(1, 0, At, B0); PG8_BAR; PG8_SCHED;
            PG8_STAGE(PG8_SB(1, 1), b3 + hstep, voffB);
            PG8_WAIT_V(6); PG8_BAR; PG8_MMA(1, 1, At, B1); PG8_BAR;
            }
        }
        if constexpr (ALIGN_EPI) { if (wr == 0) PG8_BAR; }
        if constexpr (!Epi::AFTER_DRAIN) { E(acc, cur, wr, wc, fr, fq); S.done(cur); }
        if (!has_next) break;
#pragma unroll
        for (int a = 0; a < 2; ++a)
#pragma unroll
            for (int b = 0; b < 2; ++b)
#pragma unroll
                for (int m = 0; m < 4; ++m)
#pragma unroll
                    for (int n = 0; n < 2; ++n) acc[a][b][m][n] = (f32x4){0.f, 0.f, 0.f, 0.f};
        cur = nxt; cA = nA; cB = nB; ++ui;
        if constexpr (ALIGN_EPI) { if (wr == 1) PG8_BAR; }
    }
    PG8_WAIT_V(0);
    if constexpr (!ALIGN_EPI) { if (wr == 0) PG8_BAR; }
    PG8_BAR;
    if constexpr (Epi::AFTER_DRAIN) { E.fused(acc, cur, wr, wc, fr, fq, lds, wid, lane); S.done(cur); }
#undef PG8_SA
#undef PG8_SB
#undef PG8_STAGE
#undef PG8_LDA
#undef PG8_LDB
#undef PG8_MMA
#undef PG8_WAIT_V
#undef PG8_WAIT_L
#undef PG8_BAR
#undef PG8_SCHED
}
}
constexpr int NWAVES = 8;
constexpr int N_LAUNCHES = MK_N_LAUNCHES;
constexpr int PER_PHASE = 11;
constexpr int D = 1024, NB = 4, SEQ = 4096, CTXL = 256, ML = NB * SEQ, MC = NB * CTXL, MT = ML + MC;
constexpr int NIN = 8240, DFF = 2816;
constexpr float RMS_EPS = 1e-6f, QK_SCALE = 0.08838834764831845f;
constexpr int SC_GQ = 0, SC_GK = 512, SC_GV = 1024, SC_MQ = 2048, SC_MK = 2560, SC_MV = 3072;
constexpr int WT_OG = 17, WT_MRG1 = 25, WT_MRG2 = 29, WT_BR1 = 33, WT_BR2 = 37, WT_OUT = 41, WT_FFN1 = 45, WT_TILES = 67;
constexpr size_t MiB = 1u << 20;
constexpr size_t WS_CTL = 0, CTL_ZERO_BYTES = 1 * MiB;
constexpr size_t WS_WT = 2 * MiB;
constexpr size_t WS_W2T = 36 * MiB;
constexpr size_t WS_XN = 42 * MiB;
constexpr size_t WS_Y1 = 76 * MiB, WS_Y2 = 108 * MiB;
constexpr size_t WS_SIN = 76 * MiB;
constexpr size_t WS_SMALL = 212 * MiB;
constexpr size_t WS_T2 = 140 * MiB;
constexpr size_t WS_Y = 204 * MiB;
constexpr size_t WS_HF = 76 * MiB;
constexpr size_t WS_END = 236 * MiB;
static_assert(WS_XN + (size_t)MT * D * 2 == WS_Y1 && WS_Y1 + (size_t)ML * D * 2 == WS_Y2 && WS_SIN + (size_t)MT * 4096 * 2 <= WS_SMALL && WS_SMALL + (size_t)MT * 64 * 4 <= 256 * MiB, "ws map");
static_assert(WS_Y2 + (size_t)ML * D * 2 <= WS_T2 && WS_T2 + 64 * MiB <= WS_Y && WS_HF + (size_t)ML * DFF * 2 <= WS_Y && WS_WT + (size_t)WT_TILES * 256 * D * 2 <= WS_W2T && WS_W2T + (size_t)D * DFF * 2 <= WS_XN, "ws map 2");
constexpr int CW_TMO = 0, CW_CODE = 1, CW_BAR = 4096;
constexpr size_t CTL_MOD = 65536, CTL_SS1 = 262144, CTL_SS2 = 327680;
constexpr int RING_OFF = 0, RING_BYTES = 131072, EPI_ST_OFF = RING_BYTES, LDSCTL_OFF = 139264, MISC_OFF = LDSCTL_OFF + 320, LDS_BYTES = 147456;
static_assert(MISC_OFF + 128 <= LDS_BYTES, "LDS map");

#define GAS __attribute__((address_space(1)))
#define LAS __attribute__((address_space(3)))
typedef unsigned short bf16;
typedef unsigned v4u __attribute__((ext_vector_type(4)));
typedef unsigned v2u __attribute__((ext_vector_type(2)));
typedef float f32x4 __attribute__((ext_vector_type(4)));
typedef short bf16x8 __attribute__((ext_vector_type(8)));
typedef GAS unsigned gu32;
#define RLX_AGENT __ATOMIC_RELAXED, __HIP_MEMORY_SCOPE_AGENT
#define LDS_WAIT() asm volatile("s_waitcnt lgkmcnt(0)" ::: "memory")
#define VM_WAIT() asm volatile("s_waitcnt vmcnt(0)" ::: "memory")
__device__ __forceinline__ unsigned f2bf(float f) { unsigned u = __builtin_bit_cast(unsigned, f); return (u + 0x7fffu + ((u >> 16) & 1u)) >> 16; }
__device__ __forceinline__ unsigned pk2(float lo, float hi) { return pg8::cvt_pk_bf16(lo, hi); }
__device__ __forceinline__ float bf2f(bf16 h) { return __uint_as_float((unsigned)h << 16); }
using pg8::bf_lo; using pg8::bf_hi;
__device__ __forceinline__ float logsig_f(float z) { return fminf(z, 0.f) - __logf(1.f + __expf(-fabsf(z))); }
#define XB_TMO      128
#define XB_XCNT(j)  (256  + 64 * (j))
#define XB_XSUB(j)  (1280 + 64 * (j))
#define XB_XGEN(j)  (2304 + 64 * (j))
#define XB_TOP      3328
#define XB_TOPGEN   3392
#define XCD_BAR_WORDS 3456
#define XB_SPIN_CAP (1u << 18)

__device__ __forceinline__ unsigned xb_ld(unsigned* p)              { return __hip_atomic_load(p, __ATOMIC_RELAXED, __HIP_MEMORY_SCOPE_AGENT); }
__device__ __forceinline__ unsigned xb_add(unsigned* p, unsigned v) { return __hip_atomic_fetch_add(p, v, __ATOMIC_RELAXED, __HIP_MEMORY_SCOPE_AGENT); }
__device__ __forceinline__ unsigned xb_xcc_id() { return (unsigned)__builtin_amdgcn_s_getreg((3 << 11) | 20) & 0xFu; }
#define XB_SPIN(cond, bar) do { unsigned _sp = 0; while (cond) { __builtin_amdgcn_s_sleep(1); \
    if ((++_sp & 255u) == 0u) { if (xb_ld(&(bar)[XB_TMO])) break; if (_sp > XB_SPIN_CAP) { atomicAdd(&(bar)[XB_TMO], 1u); break; } } } } while (0)

struct XcdBarrier {
    unsigned* bar; unsigned x;
    volatile LAS unsigned* st;
};

__device__ __forceinline__ XcdBarrier xcd_barrier_post(unsigned* bar, volatile LAS unsigned* st) {
    XcdBarrier b; b.bar = bar; b.x = xb_xcc_id(); b.st = st;
    if (threadIdx.x == 0) (void)xb_add(&bar[XB_XCNT(b.x)], 1u);
    return b;
}
__device__ __forceinline__ void xcd_barrier_complete(unsigned* bar, unsigned x, unsigned& nloc, unsigned& nx) {
    const unsigned G = gridDim.x * gridDim.y * gridDim.z;
    unsigned sum, cnt, mine, sp = 0u;
    for (;;) {
        sum = 0u; cnt = 0u; mine = 0u;
#pragma unroll
        for (unsigned j = 0; j < 16; ++j) { const unsigned c = xb_ld(&bar[XB_XCNT(j)]); sum += c; cnt += (c > 0u) ? 1u : 0u; mine = (j == x) ? c : mine; }
        if (sum == G) break;
        __builtin_amdgcn_s_sleep(1);
        if ((++sp & 255u) == 0u) { if (xb_ld(&bar[XB_TMO])) break; if (sp > XB_SPIN_CAP) { atomicAdd(&bar[XB_TMO], 1u); break; } }
    }
    nloc = mine > 0u ? mine : 1u; nx = cnt > 0u ? cnt : 1u;
}

__device__ __forceinline__ void xcd_barrier(const XcdBarrier& b) {
    asm volatile("s_waitcnt vmcnt(0)" ::: "memory");
    __syncthreads();
    if (threadIdx.x == 0) {
        unsigned* bar = b.bar;
        __builtin_amdgcn_s_waitcnt(0);
        unsigned nloc = b.st[0], nx = b.st[1];
        if (nloc == 0u) { xcd_barrier_complete(bar, b.x, nloc, nx); b.st[0] = nloc; b.st[1] = nx; }
        const unsigned old = xb_add(&bar[XB_XSUB(b.x)], 1u);
        const unsigned gen = old / nloc;
        if (old + 1u == (gen + 1u) * nloc) {
            __builtin_amdgcn_fence(__ATOMIC_RELEASE, "agent");
            asm volatile("s_waitcnt vmcnt(0)" ::: "memory");
            const unsigned og = xb_add(&bar[XB_TOP], 1u);
            const unsigned tg = og / nx;
            if (og + 1u == (tg + 1u) * nx) xb_add(&bar[XB_TOPGEN], 1u);
            else XB_SPIN(xb_ld(&bar[XB_TOPGEN]) == tg, bar);
            __builtin_amdgcn_fence(__ATOMIC_ACQUIRE, "agent");
            xb_add(&bar[XB_XGEN(b.x)], 1u);
            asm volatile("s_waitcnt vmcnt(0)" ::: "memory");
        } else {
            XB_SPIN(xb_ld(&bar[XB_XGEN(b.x)]) == gen, bar);
            __builtin_amdgcn_fence(__ATOMIC_ACQUIRE, "agent");
            asm volatile("s_waitcnt vmcnt(0)" ::: "memory");
        }
    }
    __syncthreads();
}
struct Frame {
    LAS unsigned char* lds;
    volatile LAS unsigned* MISC;
    gu32* ctl;
    int tid, lane, wave;
    int vcu, G;
    const float *x, *c, *ctx, *cctx, *w_ada, *b_ada, *norm1_g, *w_in, *w_up, *b_dec, *gla_g, *conv_w, *conv_b, *b_gate, *mlstm_g, *w_br1, *w_br2, *w_out, *norm2_g, *w_f1, *w_f2, *final_g;
    float* out;
    bf16 *WT, *W2T, *XN, *Y1, *Y2, *SIN, *Y, *HF;
    float *SMALL, *T2, *MOD, *SS1, *SS2;
};
__device__ __forceinline__ float wave_sum(float v) {
#pragma unroll
    for (int o = 1; o < 64; o <<= 1) v += __shfl_xor(v, o);
    return v;
}
__device__ __forceinline__ int map_col(int which, int off, int n) {
    if (which == 1) return off + n;
    if (which == 2) { const int isb = n >= DFF, j = isb ? n - DFF : n; return off + 256 * (j >> 7) + (isb ? 128 : 0) + (j & 127); }
    if (n < 2048) return n;
    if (n < 3072) return WT_OG * 256 + (n - 2048);
    if (n < 3104) return 4096 + (n - 3072);
    if (n < 4128) return 2048 + (n - 3104);
    if (n < 5152) return 3072 + (n - 4128);
    if (n < 6176) return (WT_OG + 4) * 256 + (n - 5152);
    if (n < 6192) return 4096 + 32 + (n - 6176);
    if (n < 7216) return WT_MRG1 * 256 + (n - 6192);
    return WT_MRG2 * 256 + (n - 7216);
}
__device__ __forceinline__ void p0_transpose_item(const float* W, int K, int N, bf16* WTb, int which, int off, LAS float* scr, int item, int lane) {
    const int nblk = (N + 31) / 32, kb = item / nblk, nb = item % nblk, k0 = 64 * kb, n0 = 32 * nb;
    const bool okc = n0 + (lane & 31) < N;
#pragma unroll 8
    for (int i = 0; i < 32; ++i) { const int kk = 2 * i + (lane >> 5); scr[kk * 33 + (lane & 31)] = okc ? W[(size_t)(k0 + kk) * N + n0 + (lane & 31)] : 0.f; }
    LDS_WAIT(); asm volatile("" ::: "memory");
    const int c8 = lane & 7;
#pragma unroll
    for (int j = 0; j < 4; ++j) { const int n = (lane >> 3) + 8 * j; const LAS float* s = scr + (8 * c8) * 33 + n;
        v4u o; o.x = pk2(s[0 * 33], s[1 * 33]); o.y = pk2(s[2 * 33], s[3 * 33]); o.z = pk2(s[4 * 33], s[5 * 33]); o.w = pk2(s[6 * 33], s[7 * 33]);
        if (n0 + n < N) *(GAS v4u*)(WTb + (size_t)map_col(which, off, n0 + n) * K + k0 + 8 * c8) = o; }
    LDS_WAIT(); asm volatile("" ::: "memory");
}
__device__ __forceinline__ void p0_prologue(Frame& F) {
    LAS float* scr = (LAS float*)(F.lds + RING_OFF + F.wave * 16384);
    const int gw = F.vcu * NWAVES + F.wave, NGW = F.G * NWAVES;
    constexpr int I_IN = 16 * 258, I_BR = 16 * 32, I_F1 = 16 * 176, I_F2 = 44 * 32, I_MOD = 96 * 8;
    constexpr int NITEMS = I_IN + 3 * I_BR + I_F1 + I_F2 + I_MOD;
    for (int it = gw; it < NITEMS; it += NGW) {
        int r = it;
        if (r < I_MOD) {
            const int ncb = r >> 3, kb = r & 7, n = ncb * 64 + F.lane, kbase = kb * 128;
            float sA[5], sB[5], acc[5];
#pragma unroll
            for (int q = 0; q < 5; ++q) { const float* src = q < 4 ? F.c + q * D : F.cctx; const float a = src[kbase + F.lane], b2 = src[kbase + 64 + F.lane];
                sA[q] = a / (1.f + __expf(-a)); sB[q] = b2 / (1.f + __expf(-b2)); acc[q] = 0.f; }
            const float* wp = F.w_ada + (size_t)kbase * 6144 + n;
#pragma unroll 4
            for (int kk = 0; kk < 64; ++kk) { const float wv = wp[(size_t)kk * 6144];
#pragma unroll
                for (int q = 0; q < 5; ++q) acc[q] += __shfl(sA[q], kk) * wv; }
#pragma unroll 4
            for (int kk = 0; kk < 64; ++kk) { const float wv = wp[(size_t)(64 + kk) * 6144];
#pragma unroll
                for (int q = 0; q < 5; ++q) acc[q] += __shfl(sB[q], kk) * wv; }
            const float bias = kb == 0 ? F.b_ada[n] : 0.f;
#pragma unroll
            for (int q = 0; q < 5; ++q) atomicAdd(F.MOD + q * 6144 + n, acc[q] + bias);
            continue; }
        r -= I_MOD;
        if (r < I_IN) { p0_transpose_item(F.w_in, D, NIN, F.WT, 0, 0, scr, r, F.lane); continue; } r -= I_IN;
        if (r < I_BR) { p0_transpose_item(F.w_br1, D, D, F.WT, 1, WT_BR1 * 256, scr, r, F.lane); continue; } r -= I_BR;
        if (r < I_BR) { p0_transpose_item(F.w_br2, D, D, F.WT, 1, WT_BR2 * 256, scr, r, F.lane); continue; } r -= I_BR;
        if (r < I_BR) { p0_transpose_item(F.w_out, D, D, F.WT, 1, WT_OUT * 256, scr, r, F.lane); continue; } r -= I_BR;
        if (r < I_F1) { p0_transpose_item(F.w_f1, D, 2 * DFF, F.WT, 2, WT_FFN1 * 256, scr, r, F.lane); continue; } r -= I_F1;
        p0_transpose_item(F.w_f2, DFF, D, F.W2T, 1, 0, scr, r, F.lane);
    }
    { GAS v4u* z = (GAS v4u*)(F.WT + (size_t)(4096 + 48) * D); const int n16 = 208 * 2048 / 16;
      for (int i = gw * 64 + F.lane; i < n16; i += NGW * 64) z[i] = (v4u){0u, 0u, 0u, 0u}; }
}
__device__ __forceinline__ void norm_mod_row(Frame& F, const float* xrow, float ssq_or_neg, const float* g, const float* shift, const float* scale, bf16* orow) {
    const GAS f32x4* xr = (const GAS f32x4*)xrow + F.lane;
    f32x4 v[4]; float s = 0.f;
#pragma unroll
    for (int j = 0; j < 4; ++j) { v[j] = xr[64 * j]; s += (v[j].x * v[j].x + v[j].y * v[j].y) + (v[j].z * v[j].z + v[j].w * v[j].w); }
    const float tot = ssq_or_neg >= 0.f ? ssq_or_neg : wave_sum(s);
    const float rstd = 1.f / sqrtf(tot * (1.f / D) + RMS_EPS);
    GAS unsigned long long* o8 = (GAS unsigned long long*)orow + F.lane;
#pragma unroll
    for (int j = 0; j < 4; ++j) { const f32x4 gv = ((const GAS f32x4*)g)[F.lane + 64 * j], sh = ((const GAS f32x4*)shift)[F.lane + 64 * j], sc = ((const GAS f32x4*)scale)[F.lane + 64 * j];
        const f32x4 y = (v[j] * rstd * gv) * (1.f + sc) + sh;
        o8[64 * j] = (unsigned long long)pk2(y.x, y.y) | ((unsigned long long)pk2(y.z, y.w) << 32); }
}
constexpr int SL_AQ = 0, SL_AK = 17408, SL_KT = 34816, SL_PM = 53248, SL_VT = 62464, SL_ST = 69376, SL_WUT = 95488, SL_LR = 115968, SL_FG = 121088;
constexpr int SL_RQ = 95488, SL_RK = 113440, SL_FM = 131392;
constexpr int ST_AQ = 272, ST_KT = 144, ST_W = 80, ST_DIR = 48 * 272;
static_assert(SL_FM + 4096 <= LDSCTL_OFF, "scan LDS map");
#define MMA16(a, b, c) __builtin_amdgcn_mfma_f32_16x16x32_bf16((a), (b), (c), 0, 0, 0)
#define SBAR() do { asm volatile("s_waitcnt lgkmcnt(0)" ::: "memory"); __builtin_amdgcn_s_barrier(); asm volatile("" ::: "memory"); } while (0)
__device__ __forceinline__ bf16x8 ldf(LAS unsigned char* base, int row, int stride, int kb) { return *(const LAS bf16x8*)(base + row * stride + kb); }
__device__ __forceinline__ unsigned long long pack4(const f32x4& v) { return (unsigned long long)pk2(v[0], v[1]) | ((unsigned long long)pk2(v[2], v[3]) << 32); }
__device__ __forceinline__ void st_lds16(LAS unsigned char* p, float v) { *(LAS unsigned short*)p = (unsigned short)f2bf(v); }
__device__ __forceinline__ float ld_lds16(const LAS unsigned char* p) { return __uint_as_float((unsigned)(*(const LAS unsigned short*)p) << 16); }
__device__ __forceinline__ float fexp(float x) { return __builtin_amdgcn_exp2f(x * 1.4426950408889634f); }
__device__ __forceinline__ void out4(bf16* p, f32x4 v, bool rmw, unsigned long long o) {
    if (rmw) { const unsigned lo = (unsigned)o, hi = (unsigned)(o >> 32);
        v[0] += __uint_as_float(lo << 16); v[1] += __uint_as_float(lo & 0xffff0000u); v[2] += __uint_as_float(hi << 16); v[3] += __uint_as_float(hi & 0xffff0000u); }
    *(unsigned long long*)p = pack4(v);
}
__device__ __forceinline__ void stage_v(LAS unsigned char* L, const v2u w, int tid) {
    const int tok = tid >> 3, dvq = (tid & 7) * 4;
    LAS unsigned char* p = L + SL_VT + dvq * ST_KT + tok * 2;
    *(LAS unsigned short*)(p) = (unsigned short)(w.x & 0xffffu); *(LAS unsigned short*)(p + ST_KT) = (unsigned short)(w.x >> 16);
    *(LAS unsigned short*)(p + 2 * ST_KT) = (unsigned short)(w.y & 0xffffu); *(LAS unsigned short*)(p + 3 * ST_KT) = (unsigned short)(w.y >> 16);
}
__device__ __forceinline__ void scores2(LAS unsigned char* L, int w, int l15, int quad, f32x4 (&acc)[2]) {
    const int lt = w >> 1;
#pragma unroll
    for (int mi = 0; mi < 2; ++mi) { const int mt = (w & 1) * 2 + mi; f32x4 a4 = {0.f, 0.f, 0.f, 0.f};
#pragma unroll
        for (int ks = 0; ks < 4; ++ks) a4 = MMA16(ldf(L + SL_AK, mt * 16 + l15, ST_AQ, ks * 64 + quad * 16), ldf(L + SL_AQ, lt * 16 + l15, ST_AQ, ks * 64 + quad * 16), a4);
        acc[mi] = a4; }
}

struct GlaPF { v4u q0, q1, k0, k1; v2u v; f32x4 lr; };
__device__ __forceinline__ void gla_issue(GlaPF& pf, const bf16* __restrict__ SIN, const float* __restrict__ SMALL, const int rowbase, const int dir, const int h, const int ocol, const int tid) {
    const int tok0 = tid >> 4, c16 = tid & 15;
    const bf16* qp = SIN + (size_t)(rowbase + tok0) * 4096 + SC_GQ + 128 * h + c16 * 8;
    pf.q0 = *(const v4u*)qp; pf.q1 = *(const v4u*)(qp + (size_t)32 * 4096); pf.k0 = *(const v4u*)(qp + 512); pf.k1 = *(const v4u*)(qp + (size_t)32 * 4096 + 512);
    pf.v = *(const v2u*)(SIN + (size_t)(rowbase + (tid >> 3)) * 4096 + SC_GV + ocol + (tid & 7) * 4);
    pf.lr = *(const f32x4*)(SMALL + (size_t)(rowbase + ((tid & 255) >> 2)) * 64 + dir * 16 + (tid & 3) * 4);
}
__device__ __forceinline__ void gla_substep(LAS unsigned char* L, const bf16* __restrict__ SIN, const float* __restrict__ SMALL, bf16* __restrict__ OUT, const float bd  ,
                                            const int dir, const int rowbase, const bool lat, const bool rmw, const int ocol, const int h, f32x4 (&S)[2], GlaPF& pf,
                                            const int nrowbase, const int ndir, const int tid, const int w, const int lane) {
    const int l15 = lane & 15, quad = lane >> 4;
#ifdef MK_X1
    gla_issue(pf, SIN, SMALL, rowbase, dir, h, ocol, tid);
#endif
    { const int tok0 = tid >> 4, c16 = tid & 15;
      *(LAS v4u*)(L + SL_AQ + tok0 * ST_AQ + c16 * 16) = pf.q0; *(LAS v4u*)(L + SL_AQ + (tok0 + 32) * ST_AQ + c16 * 16) = pf.q1;
      *(LAS v4u*)(L + SL_AK + tok0 * ST_AQ + c16 * 16) = pf.k0; *(LAS v4u*)(L + SL_AK + (tok0 + 32) * ST_AQ + c16 * 16) = pf.k1;
      stage_v(L, pf.v, tid);
      if (tid < 256) *(LAS unsigned long long*)(L + SL_LR + (tid >> 2) * ST_W + (tid & 3) * 8) = pack4(pf.lr); }
    bf16* const optr = OUT + (size_t)(rowbase + (w >> 1) * 16 + l15) * 1024 + ocol + (w & 1) * 16 + quad * 4;
    unsigned long long oldv = 0ull;
#ifndef MK_X1
    gla_issue(pf, SIN, SMALL, nrowbase, ndir, h, ocol, tid);
#endif
    SBAR();
    {
        const int ch = 16 * w + l15;
        float g[4][4], p[4][4]; float carry = 0.f;
        const bf16x8 wfr = ldf(L + SL_WUT + dir * 10240, ch, ST_W, quad * 16);
#pragma unroll
        for (int tt = 0; tt < 4; ++tt) {
            f32x4 z = {0.f, 0.f, 0.f, 0.f};
            z = MMA16(ldf(L + SL_LR, tt * 16 + l15, ST_W, quad * 16), wfr, z);
            float run = 0.f;
#pragma unroll
            for (int r = 0; r < 4; ++r) { g[tt][r] = logsig_f(z[r] + bd) * (1.f / 16.f); run += g[tt][r]; p[tt][r] = run; }
            float x = run, y = __shfl_up(x, 16); if (quad >= 1) x += y; y = __shfl_up(x, 32); if (quad >= 2) x += y;
            const float excl = x - run + carry;
#pragma unroll
            for (int r = 0; r < 4; ++r) p[tt][r] += excl;
            carry += __shfl(x, 48 + l15);
        }
        const float T = carry, eT = fexp(T);
        if (quad == 0) *(LAS float*)(L + SL_FG + ch * 4) = eT;
#pragma unroll
        for (int tt = 0; tt < 4; ++tt) { f32x4 ke;
#pragma unroll
            for (int r = 0; r < 4; ++r) { const int tok = tt * 16 + quad * 4 + r; const float bcum = dir == 0 ? p[tt][r] : T - p[tt][r] + g[tt][r];
                LAS unsigned char* aq = L + SL_AQ + tok * ST_AQ + ch * 2; LAS unsigned char* ak = L + SL_AK + tok * ST_AQ + ch * 2;
#ifdef MK_X2
                const bf16* qp_ = SIN + (size_t)(rowbase + tok) * 4096 + SC_GQ + 128 * h + ch;
                const float qv = bf2f(qp_[0]), kv = bf2f(qp_[512]);
#else
                const float qv = ld_lds16(aq), kv = ld_lds16(ak);
#endif
                const float e1 = fexp(bcum), e2 = __builtin_amdgcn_rcpf(e1);
                st_lds16(aq, qv * QK_SCALE * e1); st_lds16(ak, kv * e2);
                ke[r] = kv * (eT * e2); }
            *(LAS unsigned long long*)(L + SL_KT + ch * ST_KT + (tt * 16 + quad * 4) * 2) = pack4(ke); }
    }
    SBAR();
    if (lat) {
        f32x4 sc[2]; scores2(L, w, l15, quad, sc);
        const int l = (w >> 1) * 16 + l15;
#pragma unroll
        for (int mi = 0; mi < 2; ++mi) { const int m0 = ((w & 1) * 2 + mi) * 16 + quad * 4; f32x4 v = sc[mi];
#pragma unroll
            for (int r = 0; r < 4; ++r) { const bool keep = dir == 0 ? (m0 + r <= l) : (m0 + r >= l); v[r] = keep ? v[r] : 0.f; }
            *(LAS unsigned long long*)(L + SL_PM + l * ST_KT + m0 * 2) = pack4(v); }
        SBAR();
    }
    if (lat) {
        const int dvt = w & 1, tt = w >> 1; f32x4 a4 = {0.f, 0.f, 0.f, 0.f};
#pragma unroll
        for (int ks = 0; ks < 2; ++ks) a4 = MMA16(ldf(L + SL_VT, dvt * 16 + l15, ST_KT, ks * 64 + quad * 16), ldf(L + SL_PM, tt * 16 + l15, ST_KT, ks * 64 + quad * 16), a4);
#pragma unroll
        for (int ks = 0; ks < 4; ++ks) a4 = MMA16(ldf(L + SL_ST + dir * ST_DIR, dvt * 16 + l15, ST_AQ, ks * 64 + quad * 16), ldf(L + SL_AQ, tt * 16 + l15, ST_AQ, ks * 64 + quad * 16), a4);
        if (rmw) oldv = __hip_atomic_load((unsigned long long*)optr, RLX_AGENT);
        out4(optr, a4, rmw, oldv);
    }
    {
        const f32x4 dec = *(const LAS f32x4*)(L + SL_FG + (16 * w + quad * 4) * 4);
#pragma unroll
        for (int dvt = 0; dvt < 2; ++dvt) { f32x4 a4 = S[dvt] * dec;
#pragma unroll
            for (int ks = 0; ks < 2; ++ks) a4 = MMA16(ldf(L + SL_KT, 16 * w + l15, ST_KT, ks * 64 + quad * 16), ldf(L + SL_VT, dvt * 16 + l15, ST_KT, ks * 64 + quad * 16), a4);
            S[dvt] = a4; }
    }
#ifdef MK_X3
    VM_WAIT();
#endif
    SBAR();
#pragma unroll
    for (int dvt = 0; dvt < 2; ++dvt) *(LAS unsigned long long*)(L + SL_ST + dir * ST_DIR + (dvt * 16 + l15) * ST_AQ + (16 * w + quad * 4) * 2) = pack4(S[dvt]);
}
__device__ __forceinline__ int gla_rowbase(int b, int step, int dir) {
    const bool lat = step >= 4; const int chunk = lat ? (dir ? 67 - step : step - 4) : (dir ? 3 - step : step);
    return lat ? b * SEQ + chunk * 64 : ML + b * CTXL + chunk * 64;
}
__device__ __forceinline__ void scan_gla(Frame& F, const int b, const int h, const int slice) {
    LAS unsigned char* L = F.lds; const int tid = F.tid, w = F.wave, lane = F.lane;
#pragma unroll 4
    for (int i = 0; i < 16; ++i) { const int idx = tid * 16 + i, dir = idx >> 12, ch = (idx >> 5) & 127, k = idx & 31;
        const float v = k < 16 ? F.w_up[(size_t)(dir * 16 + k) * 512 + 128 * h + ch] : 0.f; st_lds16(L + SL_WUT + dir * 10240 + ch * ST_W + k * 2, v); }
    for (int i = tid; i < 5120 / 4; i += 512) ((LAS unsigned*)(L + SL_LR))[i] = 0u;
    for (int i = tid; i < 2 * ST_DIR / 4; i += 512) ((LAS unsigned*)(L + SL_ST))[i] = 0u;
    f32x4 Sf[2], Sb[2];
#pragma unroll
    for (int i = 0; i < 2; ++i) { Sf[i] = (f32x4){0.f, 0.f, 0.f, 0.f}; Sb[i] = (f32x4){0.f, 0.f, 0.f, 0.f}; }
    const int ocol = 256 * h + 32 * slice; bf16* OUT = (bf16*)F.out;
    const float bd0 = F.b_dec[128 * h + 16 * w + (lane & 15)], bd1 = F.b_dec[512 + 128 * h + 16 * w + (lane & 15)];
    GlaPF pf; gla_issue(pf, F.SIN, F.SMALL, gla_rowbase(b, 0, 0), 0, h, ocol, tid);
    SBAR();
    for (int step = 0; step < 68; ++step) {
        const bool lat = step >= 4;
        { const int chunk = lat ? step - 4 : step;
          gla_substep(L, F.SIN, F.SMALL, OUT, bd0, 0, gla_rowbase(b, step, 0), lat, lat && chunk >= 32, ocol, h, Sf, pf, gla_rowbase(b, step, 1), 1, tid, w, lane); }
        { const int chunk = lat ? 67 - step : 3 - step; const int ns = step < 67 ? step + 1 : 67;
          gla_substep(L, F.SIN, F.SMALL, OUT, bd1, 1, gla_rowbase(b, step, 1), lat, lat && chunk <= 31, ocol, h, Sb, pf, gla_rowbase(b, ns, 0), 0, tid, w, lane); }
        if (step == 35) { VM_WAIT(); SBAR(); }
    }
    VM_WAIT(); SBAR();
}

struct MlPF { v4u q[3], k[3]; v2u v; float gi, gf; };
__device__ __forceinline__ int ml_row(int b, bool lat, int p) { return lat ? (b * SEQ + (p & 63) * 64 + (p >> 6)) : (ML + b * CTXL + p); }
__device__ __forceinline__ void ml_issue(MlPF& pf, const bf16* __restrict__ SIN, const float* __restrict__ SMALL, const int b, const int chunk, const bool lat, const int dir, const int h, const int ocol, const int tid, const int lane) {
    const int plen = lat ? SEQ : CTXL, p0 = chunk * 64;
#pragma unroll
    for (int j = 0; j < 3; ++j) { const int piece = tid + 512 * j, i = piece >> 4, c16 = piece & 15, p = p0 - 1 + i;
        const bool ok = piece < 66 * 16 && p >= 0 && p < plen;
        const bf16* qp = SIN + (size_t)ml_row(b, lat, ok ? p : p0) * 4096 + SC_MQ + 128 * h + c16 * 8;
        pf.q[j] = ok ? *(const v4u*)qp : (v4u){0u, 0u, 0u, 0u}; pf.k[j] = ok ? *(const v4u*)(qp + 512) : (v4u){0u, 0u, 0u, 0u}; }
    pf.v = *(const v2u*)(SIN + (size_t)ml_row(b, lat, p0 + (tid >> 3)) * 4096 + SC_MV + ocol + (tid & 7) * 4);
    const int gi = dir ? 2 : 0; const size_t row = (size_t)ml_row(b, lat, p0 + lane);
    pf.gi = SMALL[row * 64 + 32 + 4 * gi + h]; pf.gf = SMALL[row * 64 + 32 + 4 * (gi + 1) + h];
}
__device__ __forceinline__ void mlstm_substep(LAS unsigned char* L, const bf16* __restrict__ SIN, const float* __restrict__ SMALL, bf16* __restrict__ OUT, const float bgi, const float bgf,
                                              const int dir, const int b, const int chunk, const bool lat, const bool rmw, const int ocol, const int h, const float (&cw)[16], f32x4 (&C)[3], float& mrun, MlPF& pf,
                                              const int nchunk, const bool nlat, const int ndir, const int tid, const int w, const int lane) {
    const int l15 = lane & 15, quad = lane >> 4;
    const int row0 = lat ? b * SEQ + chunk : ML + b * CTXL + chunk * 64;
    LAS float* Fp = (LAS float*)(L + SL_FM);
#pragma unroll
    for (int j = 0; j < 3; ++j) { const int piece = tid + 512 * j, i = piece >> 4, c16 = piece & 15;
        if (piece < 66 * 16) { *(LAS v4u*)(L + SL_RQ + i * ST_AQ + c16 * 16) = pf.q[j]; *(LAS v4u*)(L + SL_RK + i * ST_AQ + c16 * 16) = pf.k[j]; } }
    stage_v(L, pf.v, tid);
    if (w == 0) {
        const float li = pf.gi + bgi, lf = logsig_f(pf.gf + bgf);
        float x = lf;
#pragma unroll
        for (int o = 1; o < 64; o <<= 1) { const float y = __shfl_up(x, o); if (lane >= o) x += y; }
        const float total = __shfl(x, 63);
        const float bv = dir == 0 ? x : total - x + lf;
        const float av = li - bv;
        float xm = av;
        if (dir == 0) {
#pragma unroll
            for (int o = 1; o < 64; o <<= 1) { const float y = __shfl_up(xm, o); if (lane >= o) xm = fmaxf(xm, y); }
        } else {
#pragma unroll
            for (int o = 1; o < 64; o <<= 1) { const float y = __shfl_down(xm, o); if (lane + o < 64) xm = fmaxf(xm, y); }
        }
        const float Mall = __shfl(xm, dir == 0 ? 63 : 0);
        const float m = mrun;
        const float mq = bv + fmaxf(m, xm);
        const float mnew = total + fmaxf(m, Mall);
        Fp[lane] = bv - mq;
        Fp[64 + lane] = av;
        Fp[128 + lane] = fexp(-mq);
        Fp[192 + lane] = fexp(bv + m - mq);
        Fp[256 + lane] = fexp(total + av - mnew);
        if (lane == 0) Fp[320] = fexp(total + m - mnew);
        mrun = mnew;
    }
    bf16* const optr = OUT + (size_t)(row0 + (size_t)((w >> 1) * 16 + l15) * (lat ? 64 : 1)) * 1024 + ocol + (w & 1) * 16 + quad * 4;
    unsigned long long oldv = 0ull;
    ml_issue(pf, SIN, SMALL, b, nchunk, nlat, ndir, h, ocol, tid, lane);
    SBAR();
    {
        const int cp = tid & 63, tg8 = tid >> 6;
        float kk0[8], kk1[8];
        unsigned rq[10], rk[10];
#pragma unroll
        for (int i = 0; i < 10; ++i) { rq[i] = *(const LAS unsigned*)(L + SL_RQ + (tg8 * 8 + i) * ST_AQ + cp * 4); rk[i] = *(const LAS unsigned*)(L + SL_RK + (tg8 * 8 + i) * ST_AQ + cp * 4); }
#pragma unroll
        for (int i = 0; i < 8; ++i) { const int tok = tg8 * 8 + i;
            const float aq0 = cw[3] + cw[0] * bf_lo(rq[i]) + cw[1] * bf_lo(rq[i + 1]) + cw[2] * bf_lo(rq[i + 2]);
            const float aq1 = cw[7] + cw[4] * bf_hi(rq[i]) + cw[5] * bf_hi(rq[i + 1]) + cw[6] * bf_hi(rq[i + 2]);
            const float ak0 = cw[11] + cw[8] * bf_lo(rk[i]) + cw[9] * bf_lo(rk[i + 1]) + cw[10] * bf_lo(rk[i + 2]);
            const float ak1 = cw[15] + cw[12] * bf_hi(rk[i]) + cw[13] * bf_hi(rk[i + 1]) + cw[14] * bf_hi(rk[i + 2]);
            const float q0 = aq0 * __builtin_amdgcn_rcpf(1.f + fexp(-aq0)), q1 = aq1 * __builtin_amdgcn_rcpf(1.f + fexp(-aq1));
            kk0[i] = ak0 * __builtin_amdgcn_rcpf(1.f + fexp(-ak0)) * QK_SCALE; kk1[i] = ak1 * __builtin_amdgcn_rcpf(1.f + fexp(-ak1)) * QK_SCALE;
            *(LAS unsigned*)(L + SL_AQ + tok * ST_AQ + cp * 4) = pk2(q0, q1); *(LAS unsigned*)(L + SL_AK + tok * ST_AQ + cp * 4) = pk2(kk0[i], kk1[i]); }
        const f32x4 wk0 = *(const LAS f32x4*)(Fp + 256 + tg8 * 8), wk1 = *(const LAS f32x4*)(Fp + 256 + tg8 * 8 + 4);
        v4u o0, o1;
        o0.x = pk2(kk0[0] * wk0[0], kk0[1] * wk0[1]); o0.y = pk2(kk0[2] * wk0[2], kk0[3] * wk0[3]); o0.z = pk2(kk0[4] * wk1[0], kk0[5] * wk1[1]); o0.w = pk2(kk0[6] * wk1[2], kk0[7] * wk1[3]);
        o1.x = pk2(kk1[0] * wk0[0], kk1[1] * wk0[1]); o1.y = pk2(kk1[2] * wk0[2], kk1[3] * wk0[3]); o1.z = pk2(kk1[4] * wk1[0], kk1[5] * wk1[1]); o1.w = pk2(kk1[6] * wk1[2], kk1[7] * wk1[3]);
        *(LAS v4u*)(L + SL_KT + (2 * cp) * ST_KT + tg8 * 16) = o0; *(LAS v4u*)(L + SL_KT + (2 * cp + 1) * ST_KT + tg8 * 16) = o1;
    }
    SBAR();
    if (lat) {
        f32x4 sc[2]; scores2(L, w, l15, quad, sc);
        const int l = (w >> 1) * 16 + l15; const float rowt = Fp[l];
#pragma unroll
        for (int mi = 0; mi < 2; ++mi) { const int m0 = ((w & 1) * 2 + mi) * 16 + quad * 4; f32x4 v = sc[mi]; const f32x4 av = *(const LAS f32x4*)(Fp + 64 + m0);
#pragma unroll
            for (int r = 0; r < 4; ++r) { const bool keep = dir == 0 ? (m0 + r <= l) : (m0 + r >= l); v[r] = keep ? v[r] * fexp(rowt + av[r]) : 0.f; }
            *(LAS unsigned long long*)(L + SL_PM + l * ST_KT + m0 * 2) = pack4(v); }
        SBAR();
    }
    {
        if (lat) {
            const int dvo = w & 1, tt = w >> 1; f32x4 n1 = {0.f, 0.f, 0.f, 0.f}, n2 = n1, d1 = n1, d2 = n1;
#pragma unroll
            for (int ks = 0; ks < 2; ++ks) { const bf16x8 pm = ldf(L + SL_PM, tt * 16 + l15, ST_KT, ks * 64 + quad * 16);
                n1 = MMA16(ldf(L + SL_VT, dvo * 16 + l15, ST_KT, ks * 64 + quad * 16), pm, n1); d1 = MMA16(ldf(L + SL_VT, 32 + l15, ST_KT, ks * 64 + quad * 16), pm, d1); }
#pragma unroll
            for (int ks = 0; ks < 4; ++ks) { const bf16x8 aq = ldf(L + SL_AQ, tt * 16 + l15, ST_AQ, ks * 64 + quad * 16);
                n2 = MMA16(ldf(L + SL_ST + dir * ST_DIR, dvo * 16 + l15, ST_AQ, ks * 64 + quad * 16), aq, n2); d2 = MMA16(ldf(L + SL_ST + dir * ST_DIR, 32 + l15, ST_AQ, ks * 64 + quad * 16), aq, d2); }
            const int tok = tt * 16 + l15; const float wi = Fp[192 + tok], flo = Fp[128 + tok];
            const float denl = d1[0] + wi * d2[0]; const float den = __shfl(denl, l15);
            const float inv = __builtin_amdgcn_rcpf(fmaxf(fabsf(den), flo));
            f32x4 hv = (n1 + n2 * wi) * inv;
            if (rmw) oldv = __hip_atomic_load((unsigned long long*)optr, RLX_AGENT);
            out4(optr, hv, rmw, oldv);
        }
        const float decay = Fp[320];
#pragma unroll
        for (int dvt = 0; dvt < 3; ++dvt) { f32x4 a4 = C[dvt] * decay;
#pragma unroll
            for (int ks = 0; ks < 2; ++ks) a4 = MMA16(ldf(L + SL_KT, 16 * w + l15, ST_KT, ks * 64 + quad * 16), ldf(L + SL_VT, dvt * 16 + l15, ST_KT, ks * 64 + quad * 16), a4);
            C[dvt] = a4; }
    }
    SBAR();
#pragma unroll
    for (int dvt = 0; dvt < 3; ++dvt) *(LAS unsigned long long*)(L + SL_ST + dir * ST_DIR + (dvt * 16 + l15) * ST_AQ + (16 * w + quad * 4) * 2) = pack4(C[dvt]);
}
__device__ __forceinline__ void scan_mlstm(Frame& F, const int b, const int h, const int slice) {
    LAS unsigned char* L = F.lds; const int tid = F.tid, w = F.wave, lane = F.lane;
    for (int i = tid; i < 16 * 72; i += 512) { const int r = i / 72; *(LAS unsigned short*)(L + SL_VT + 32 * ST_KT + i * 2) = r == 0 ? (unsigned short)0x3F80 : (unsigned short)0; }
    for (int i = tid; i < 2 * ST_DIR / 4; i += 512) ((LAS unsigned*)(L + SL_ST))[i] = 0u;
    float cw[16];
    { const int cp = tid & 63;
#pragma unroll
      for (int e = 0; e < 2; ++e) { const int cq = 128 * h + 2 * cp + e, ck = 512 + cq;
        cw[4 * e + 0] = F.conv_w[cq]; cw[4 * e + 1] = F.conv_w[1024 + cq]; cw[4 * e + 2] = F.conv_w[2048 + cq]; cw[4 * e + 3] = F.conv_b[cq];
        cw[8 + 4 * e + 0] = F.conv_w[ck]; cw[8 + 4 * e + 1] = F.conv_w[1024 + ck]; cw[8 + 4 * e + 2] = F.conv_w[2048 + ck]; cw[8 + 4 * e + 3] = F.conv_b[ck]; } }
    f32x4 Cf[3], Cb[3];
#pragma unroll
    for (int i = 0; i < 3; ++i) { Cf[i] = (f32x4){0.f, 0.f, 0.f, 0.f}; Cb[i] = (f32x4){0.f, 0.f, 0.f, 0.f}; }
    float mf = 0.f, mb = 0.f;
    const float bg0i = F.b_gate[0 * 4 + h], bg0f = F.b_gate[1 * 4 + h], bg1i = F.b_gate[2 * 4 + h], bg1f = F.b_gate[3 * 4 + h];
    const int ocol = 256 * h + 32 * slice; bf16* OUT = (bf16*)F.out + (size_t)ML * D;
    MlPF pf; ml_issue(pf, F.SIN, F.SMALL, b, 0, false, 0, h, ocol, tid, lane);
    SBAR();
    for (int step = 0; step < 68; ++step) {
        const bool lat = step >= 4;
        const int cf = lat ? step - 4 : step, cb = lat ? 67 - step : 3 - step;
        const int ns = step < 67 ? step + 1 : 67; const bool nlat = ns >= 4; const int ncf = nlat ? ns - 4 : ns;
        mlstm_substep(L, F.SIN, F.SMALL, OUT, bg0i, bg0f, 0, b, cf, lat, lat && cf >= 32, ocol, h, cw, Cf, mf, pf, cb, lat, 1, tid, w, lane);
        mlstm_substep(L, F.SIN, F.SMALL, OUT, bg1i, bg1f, 1, b, cb, lat, lat && cb <= 31, ocol, h, cw, Cb, mb, pf, ncf, nlat, 0, tid, w, lane);
        if (step == 35) { VM_WAIT(); SBAR(); }
    }
    VM_WAIT(); SBAR();
}
struct MergeOrder {
    int pm, pn; bool valid;
    __device__ __forceinline__ bool next(int i, pg8::Unit& u) const {
        if (!valid || i >= 4) return false;
        u.pm = pm + (i == 0 ? 68 : (i == 2 ? 132 : 0));
        u.pn = pn + (i == 0 ? WT_BR1 : (i == 1 ? WT_MRG1 : (i == 2 ? WT_BR2 : WT_MRG2)));
        return true;
    }
    __device__ __forceinline__ void a_ready(const pg8::Unit&) const {}
    __device__ __forceinline__ void done(const pg8::Unit&) const {}
};

struct Args { const float* in[22]; float* out; unsigned char* ws; int ph_lo, ph_hi, li, pad; };
__global__ void __launch_bounds__(NWAVES * 64, 2) mk_fwd(Args args) {
    extern __shared__ __attribute__((aligned(16))) unsigned char lds[];
    Frame F;
    F.lds = (LAS unsigned char*)lds;
    F.MISC = (volatile LAS unsigned*)(F.lds + MISC_OFF);
    F.tid = threadIdx.x; F.lane = F.tid & 63; F.wave = __builtin_amdgcn_readfirstlane(F.tid >> 6);
    F.G = gridDim.x; { const int bx = blockIdx.x; F.vcu = (F.G % 8 == 0) ? (bx % 8) * (F.G / 8) + bx / 8 : bx; }
    unsigned char* ws = args.ws;
    F.ctl = (gu32*)(ws + WS_CTL);
    F.x = args.in[0]; F.c = args.in[1]; F.ctx = args.in[2]; F.cctx = args.in[3]; F.w_ada = args.in[4]; F.b_ada = args.in[5]; F.norm1_g = args.in[6]; F.w_in = args.in[7];
    F.w_up = args.in[8]; F.b_dec = args.in[9]; F.gla_g = args.in[10]; F.conv_w = args.in[11]; F.conv_b = args.in[12]; F.b_gate = args.in[13]; F.mlstm_g = args.in[14];
    F.w_br1 = args.in[15]; F.w_br2 = args.in[16]; F.w_out = args.in[17]; F.norm2_g = args.in[18]; F.w_f1 = args.in[19]; F.w_f2 = args.in[20]; F.final_g = args.in[21];
    F.out = args.out;
    F.WT = (bf16*)(ws + WS_WT); F.W2T = (bf16*)(ws + WS_W2T); F.XN = (bf16*)(ws + WS_XN); F.Y1 = (bf16*)(ws + WS_Y1); F.Y2 = (bf16*)(ws + WS_Y2); F.SIN = (bf16*)(ws + WS_SIN);
    F.Y = (bf16*)(ws + WS_Y); F.HF = (bf16*)(ws + WS_HF); F.SMALL = (float*)(ws + WS_SMALL); F.T2 = (float*)(ws + WS_T2);
    F.MOD = (float*)(ws + WS_CTL + CTL_MOD); F.SS1 = (float*)(ws + WS_CTL + CTL_SS1); F.SS2 = (float*)(ws + WS_CTL + CTL_SS2);
    for (int u = F.tid; u < (LDS_BYTES - LDSCTL_OFF) / 4; u += NWAVES * 64) ((LAS unsigned*)(F.lds + LDSCTL_OFF))[u] = 0u;
    __syncthreads();
    XcdBarrier bar; bar.bar = (unsigned*)(F.ctl + CW_BAR); bar.x = 0; bar.st = nullptr;
    if (N_LAUNCHES != PER_PHASE) bar = xcd_barrier_post((unsigned*)(F.ctl + CW_BAR), F.MISC + 8);
#define GRID_BAR(seam) do { if (N_LAUNCHES == PER_PHASE) { if (F.tid == 0) __hip_atomic_store(F.ctl + CW_TMO, 0xBADBA0u | (unsigned)(seam), RLX_AGENT); } else { xcd_barrier(bar); } } while (0)
    const int lo = args.ph_lo, hi = args.ph_hi;
#define IN(k) (lo <= (k) && (k) < hi)
#define BOTH(k) (IN(k) && IN((k) + 1))
    const int gw = F.vcu * NWAVES + F.wave, NGW = F.G * NWAVES;

    if (IN(0)) { p0_prologue(F); if (BOTH(0)) GRID_BAR(0); }

    if (IN(1)) for (int rep = 0; rep <= ((MK_DUP >> 1) & 1); ++rep) { if (rep) GRID_BAR(100 + 1);
        for (int m = gw; m < MT; m += NGW) {
            const float* src = m < ML ? F.x + (size_t)m * D : F.ctx + (size_t)(m - ML) * D;
            const float* mod = F.MOD + (size_t)(m < ML ? (m >> 12) : 4) * 6144;
            norm_mod_row(F, src, -1.f, F.norm1_g, mod, mod + D, F.XN + (size_t)m * D);
        }
        if (rep == ((MK_DUP >> 1) & 1) && BOTH(1)) GRID_BAR(1);
    }

    if (IN(2)) for (int rep = 0; rep <= ((MK_DUP >> 2) & 1); ++rep) { if (rep) GRID_BAR(100 + 2);
        pg8::Gemm g{F.XN, F.WT, MT, 17 * 256, D}; pg8::StaticOrder S; S.init(MT, 17 * 256, F.G, (int)blockIdx.x);
        pg8::EpiScanIn E{F.SIN, F.SMALL};
        pg8::gemm_phase<pg8::EpiScanIn, pg8::StaticOrder, true, true>(F.lds + RING_OFF, g, S, E);
        if (rep == ((MK_DUP >> 2) & 1) && BOTH(2)) GRID_BAR(2);
    }

    if (IN(3)) for (int rep = 0; rep <= ((MK_DUP >> 3) & 1); ++rep) { if (rep) GRID_BAR(100 + 3);
        for (int u = F.vcu; u < 256; u += F.G) {
            const int mixer = u >> 7, bh = (u >> 3) & 15, b = bh >> 2, h = bh & 3, slice = u & 7;
            if (mixer == 0) scan_gla(F, b, h, slice);
#ifdef MK_NO_MLSTM
            else if (false) { bf16* O = (bf16*)F.out; for (int i = F.tid; i < SEQ * 4; i += 512) *(unsigned long long*)(O + (size_t)(b * SEQ + (i >> 2)) * 1024 + 256 * h + 32 * slice + (i & 3) * 4 + 0) = 0ull, *(unsigned long long*)(O + (size_t)(b * SEQ + (i >> 2)) * 1024 + 256 * h + 32 * slice + 16 + (i & 3) * 4) = 0ull; }
            else { bf16* O = (bf16*)F.out + (size_t)ML * D; for (int i = F.tid; i < SEQ * 4; i += 512) *(unsigned long long*)(O + (size_t)(b * SEQ + (i >> 2)) * 1024 + 256 * h + 32 * slice + (i & 3) * 4 + 0) = 0ull, *(unsigned long long*)(O + (size_t)(b * SEQ + (i >> 2)) * 1024 + 256 * h + 32 * slice + 16 + (i & 3) * 4) = 0ull; }
#else
            else scan_mlstm(F, b, h, slice);
#endif
        }
        if (rep == ((MK_DUP >> 3) & 1) && BOTH(3)) GRID_BAR(3);
    }

    if (IN(4)) for (int rep = 0; rep <= ((MK_DUP >> 4) & 1); ++rep) { if (rep) GRID_BAR(100 + 4);
        pg8::Gemm g{F.XN, F.WT + (size_t)WT_OG * 256 * D, ML, 2048, D}; pg8::StaticOrder S; S.init(ML, 2048, F.G, (int)blockIdx.x);
        pg8::EpiOutGate E{(const bf16*)F.out, (const bf16*)F.out + (size_t)ML * D, F.gla_g, F.mlstm_g, F.Y1, F.Y2, (LAS float*)(F.lds + EPI_ST_OFF)};
        pg8::gemm_phase<pg8::EpiOutGate, pg8::StaticOrder, true, true>(F.lds + RING_OFF, g, S, E);
        if (rep == ((MK_DUP >> 4) & 1) && BOTH(4)) GRID_BAR(4);
    }

    if (IN(5)) for (int rep = 0; rep <= ((MK_DUP >> 5) & 1); ++rep) { if (rep) GRID_BAR(100 + 5);
        pg8::StaticOrder SO; SO.init(ML, D, F.G, (int)blockIdx.x);
        pg8::Gemm g{F.XN, F.WT, MT + 2 * ML, WT_TILES * 256, D};
        pg8::EpiMerge E{F.out, F.T2, F.Y};
        for (int r = 0;; ++r) { pg8::Unit t; MergeOrder S; S.valid = SO.next(r, t); if (!S.valid) break; S.pm = t.pm; S.pn = t.pn;
            pg8::gemm_phase<pg8::EpiMerge, MergeOrder, true, true>(F.lds + RING_OFF, g, S, E); }
        if (rep == ((MK_DUP >> 5) & 1) && BOTH(5)) GRID_BAR(5);
    }

    if (IN(6)) {
        pg8::Gemm g{F.Y, F.WT + (size_t)WT_OUT * 256 * D, ML, D, D}; pg8::StaticOrder S; S.init(ML, D, F.G, (int)blockIdx.x);
        pg8::EpiResid E{F.x, F.out, F.MOD, 2, F.SS1};
        pg8::gemm_phase<pg8::EpiResid, pg8::StaticOrder, true, true>(F.lds + RING_OFF, g, S, E);
        if (BOTH(6)) GRID_BAR(6);
    }

    if (IN(7)) {
        for (int m = gw; m < ML; m += NGW) {
            const float* mod = F.MOD + (size_t)(m >> 12) * 6144;
            const float ss = __hip_atomic_load(F.SS1 + m, RLX_AGENT);
            norm_mod_row(F, F.out + (size_t)m * D, ss, F.norm2_g, mod + 3 * D, mod + 4 * D, F.XN + (size_t)m * D);
        }
        if (BOTH(7)) GRID_BAR(7);
    }

    if (IN(8)) for (int rep = 0; rep <= ((MK_DUP >> 8) & 1); ++rep) { if (rep) GRID_BAR(100 + 8);
        pg8::Gemm g{F.XN, F.WT + (size_t)WT_FFN1 * 256 * D, ML, 2 * DFF, D}; pg8::StaticOrder S; S.init(ML, 2 * DFF, F.G, (int)blockIdx.x);
        pg8::EpiSwiglu E{F.HF};
        pg8::gemm_phase<pg8::EpiSwiglu, pg8::StaticOrder, true, true>(F.lds + RING_OFF, g, S, E);
        if (rep == ((MK_DUP >> 8) & 1) && BOTH(8)) GRID_BAR(8);
    }

    if (IN(9)) {
        pg8::Gemm g{F.HF, F.W2T, ML, D, DFF}; pg8::StaticOrder S; S.init(ML, D, F.G, (int)blockIdx.x);
        pg8::EpiResid E{F.out, F.out, F.MOD, 5, F.SS2};
        pg8::gemm_phase<pg8::EpiResid, pg8::StaticOrder, true, true>(F.lds + RING_OFF, g, S, E);
        if (BOTH(9)) GRID_BAR(9);
    }

    if (IN(10)) {
        for (int m = gw; m < ML; m += NGW) {
            const float ss = __hip_atomic_load(F.SS2 + m, RLX_AGENT);
            const float rstd = 1.f / sqrtf(ss * (1.f / D) + RMS_EPS);
            GAS f32x4* xr = (GAS f32x4*)(F.out + (size_t)m * D) + F.lane;
#pragma unroll
            for (int j = 0; j < 4; ++j) { const f32x4 gv = ((const GAS f32x4*)F.final_g)[F.lane + 64 * j]; xr[64 * j] = xr[64 * j] * rstd * gv; }
        }
    }
#undef IN
#undef BOTH
}

extern "C" void kernel_launch(void* const* d_in, const int* in_sizes, int n_in, void* d_out, int out_size, void* d_ws, size_t ws_size, hipStream_t stream) {
    static int grid = 0;
    if (grid == 0) {
        if (n_in != 22 || in_sizes[0] != ML * D || out_size != ML * D || ws_size < WS_END) { fprintf(stderr, "kernel_launch: unexpected shapes (n_in %d, in0 %d, out %d, ws %zu)\n", n_in, n_in > 0 ? in_sizes[0] : -1, out_size, ws_size); grid = -1; return; }
        int dev = 0, cus = 0;
        if (hipGetDevice(&dev) != hipSuccess || hipDeviceGetAttribute(&cus, hipDeviceAttributeMultiprocessorCount, dev) != hipSuccess) { grid = -1; return; }
        if (hipFuncSetAttribute((const void*)mk_fwd, hipFuncAttributeMaxDynamicSharedMemorySize, LDS_BYTES) != hipSuccess) { fprintf(stderr, "kernel_launch: hipFuncSetAttribute failed\n"); grid = -1; return; }
        int per_cu = 0;
        if (hipOccupancyMaxActiveBlocksPerMultiprocessor(&per_cu, (const void*)mk_fwd, NWAVES * 64, LDS_BYTES) != hipSuccess || per_cu < 1) fprintf(stderr, "kernel_launch: occupancy query reports %d\n", per_cu);
        (void)hipGetLastError();
        grid = cus;
    }
    if (grid < 0) return;
    if (hipMemsetAsync((char*)d_ws + WS_CTL, 0, CTL_ZERO_BYTES, stream) != hipSuccess) return;
    Args a{};
    for (int i = 0; i < 22; ++i) a.in[i] = (const float*)d_in[i];
    a.out = (float*)d_out; a.ws = (unsigned char*)d_ws;
    for (int li = 0; li < N_LAUNCHES; ++li) {
        a.ph_lo = (N_LAUNCHES == PER_PHASE) ? li : 0; a.ph_hi = (N_LAUNCHES == PER_PHASE) ? li + 1 : PER_PHASE; a.li = li;
        hipLaunchKernelGGL(mk_fwd, dim3(grid), dim3(NWAVES * 64), LDS_BYTES, stream, a);
    }
}
```

```cpp
#include <hip/hip_runtime.h>
#include <cstdio>
#include <cstdint>
#ifndef MK_N_LAUNCHES
#define MK_N_LAUNCHES 1
#endif
#ifndef MK_PROBE
#define MK_PROBE 2
#endif
#ifndef MK_DUPSEL
#define MK_DUPSEL 0
#endif
#ifndef MK_DUP
#define MK_DUP 0
#endif
namespace pg8 {
#define PG8_LAS __attribute__((address_space(3)))
typedef unsigned short bf16_t;
typedef short bf16x8 __attribute__((ext_vector_type(8)));
typedef float f32x4 __attribute__((ext_vector_type(4)));
typedef unsigned u32x4 __attribute__((ext_vector_type(4)));
constexpr int BM = 256, BK = 64, HALF = 128, HTB = HALF * BK * 2  , STAGE_BYTES = 8 * HTB, NXCD = 8, WGM = 8;

__host__ __device__ __forceinline__ int lds_byte(int r, int c) { const int st = (r >> 4) * 2 + (c >> 5), rr = r & 15, cc = c & 31, ob = rr * 64 + cc * 2; return st * 1024 + (ob ^ (((ob >> 9) & 1) << 5)); }
__host__ __device__ __forceinline__ void stage_rc(int b, int& R, int& C) { const int st = b / 1024, sb = b % 1024, swz = sb ^ (((sb >> 9) & 1) << 5); R = (st >> 1) * 16 + swz / 64; C = (st & 1) * 32 + (swz % 64) / 2; }
__host__ __device__ __forceinline__ int perm32(int rho) { const int n = rho >> 4, i = rho & 15; return 8 * (i >> 2) + 4 * n + (i & 3); }

struct Unit { int pm, pn; };
struct Gemm { const bf16_t* A; const bf16_t* Bt; int M, N, K; };

struct StaticOrder {
    int nM, nN, nwg, G, c;
    __host__ __device__ void init(int M, int N, int G_, int c_) { nM = M / BM; nN = N / BM; nwg = nM * nN; G = G_; c = c_; }
    __host__ __device__ bool next(int i, Unit& u) const {
        const long L = (long)i * G + c; if (L >= nwg) return false;
        int wgid = (int)L; { const int q = nwg / NXCD, r = nwg % NXCD, xcd = wgid % NXCD, off = wgid / NXCD; wgid = (xcd < r ? xcd * (q + 1) : r * (q + 1) + (xcd - r) * q) + off; }
        const int nig = WGM * nN, gid = wgid / nig, fm = gid * WGM, gsz = (nM - fm) < WGM ? (nM - fm) : WGM;
        u.pm = fm + ((wgid % nig) % gsz); u.pn = (wgid % nig) / gsz; return true;
    }
    __device__ __forceinline__ void a_ready(const Unit&) const {}
    __device__ __forceinline__ void done(const Unit&) const {}
};

typedef float f32x2c __attribute__((ext_vector_type(2))); typedef __bf16 bf16x2c __attribute__((ext_vector_type(2)));
__device__ __forceinline__ unsigned cvt_pk_bf16(float lo, float hi) { const f32x2c v = {lo, hi}; const bf16x2c b = __builtin_convertvector(v, bf16x2c); return __builtin_bit_cast(unsigned, b); }
typedef float f32x2 __attribute__((ext_vector_type(2)));
__device__ __forceinline__ float sigm_f(float x) { return __builtin_amdgcn_rcpf(1.f + __expf(-x)); }
__device__ __forceinline__ float silu_f(float x) { return x * sigm_f(x); }
__device__ __forceinline__ float bf_lo(unsigned w) { return __uint_as_float(w << 16); }
__device__ __forceinline__ float bf_hi(unsigned w) { return __uint_as_float(w & 0xffff0000u); }
__device__ __forceinline__ u32x4 pack8(const f32x4& a, const f32x4& b) { u32x4 w; w.x = cvt_pk_bf16(a[0], a[1]); w.y = cvt_pk_bf16(a[2], a[3]); w.z = cvt_pk_bf16(b[0], b[1]); w.w = cvt_pk_bf16(b[2], b[3]); return w; }

struct EpiScanIn {
    static constexpr bool PERM = true, AFTER_DRAIN = false;
    bf16_t* SIN; float* SMALL;
    __device__ __forceinline__ void operator()(const f32x4 (&acc)[2][2][4][2], const Unit& u, int wr, int wc, int fr, int fq) const {
        const int row0 = u.pm * BM + wr * 64 + fr;
        if (u.pn < 16) {
#pragma unroll
            for (int ai = 0; ai < 2; ++ai)
#pragma unroll
                for (int m = 0; m < 4; ++m) { bf16_t* rowp = SIN + (size_t)(row0 + ai * HALF + m * 16) * 4096 + u.pn * BM + wc * 32 + 8 * fq;
#pragma unroll
                    for (int bj = 0; bj < 2; ++bj) *(u32x4*)(rowp + bj * HALF) = pack8(acc[ai][bj][m][0], acc[ai][bj][m][1]); }
        } else if (wc < 2) {
#pragma unroll
            for (int ai = 0; ai < 2; ++ai)
#pragma unroll
                for (int m = 0; m < 4; ++m) { float* p = SMALL + (size_t)(row0 + ai * HALF + m * 16) * 64 + wc * 32 + 8 * fq;
                    *(f32x4*)p = acc[ai][0][m][0]; *(f32x4*)(p + 4) = acc[ai][0][m][1]; }
        }
    }
};

struct EpiOutGate {
    static constexpr bool PERM = true, AFTER_DRAIN = false;
    const bf16_t* OHo; const bf16_t* OHh; const float* gg; const float* mg; bf16_t* Y1; bf16_t* Y2; PG8_LAS float* st;
    __device__ __forceinline__ void operator()(const f32x4 (&acc)[2][2][4][2], const Unit& u, int wr, int wc, int fr, int fq) const {
        const bool isg = u.pn < 4; const int head = u.pn & 3;
        const bf16_t* src = (isg ? OHo : OHh) + head * 256; const float* gain = (isg ? gg : mg) + head * 256; bf16_t* dst = (isg ? Y1 : Y2) + head * 256;
        const int row0 = u.pm * BM + wr * 64 + fr, cb = wc * 32 + 8 * fq;
#pragma unroll
        for (int ai = 0; ai < 2; ++ai)
#pragma unroll
            for (int m = 0; m < 4; ++m) { float s = 0.f; const bf16_t* rp = src + (size_t)(row0 + ai * HALF + m * 16) * 1024 + cb;
#pragma unroll
                for (int bj = 0; bj < 2; ++bj) { const u32x4 w = *(const u32x4*)(rp + bj * HALF);
                    float a; a = bf_lo(w.x); s += a * a; a = bf_hi(w.x); s += a * a; a = bf_lo(w.y); s += a * a; a = bf_hi(w.y); s += a * a;
                    a = bf_lo(w.z); s += a * a; a = bf_hi(w.z); s += a * a; a = bf_lo(w.w); s += a * a; a = bf_hi(w.w); s += a * a; }
                s += __shfl_xor(s, 16); s += __shfl_xor(s, 32);
                if (fq == 0) st[(ai * HALF + wr * 64 + m * 16 + fr) * 4 + wc] = s; }
        asm volatile("s_waitcnt lgkmcnt(0)" ::: "memory"); __builtin_amdgcn_s_barrier(); asm volatile("" ::: "memory");
        f32x4 g8[2][2];
#pragma unroll
        for (int bj = 0; bj < 2; ++bj) { g8[bj][0] = *(const f32x4*)(gain + cb + bj * HALF); g8[bj][1] = *(const f32x4*)(gain + cb + bj * HALF + 4); }
#pragma unroll
        for (int ai = 0; ai < 2; ++ai)
#pragma unroll
            for (int m = 0; m < 4; ++m) { const int rl = ai * HALF + wr * 64 + m * 16 + fr; const f32x4 t = *(const PG8_LAS f32x4*)(st + rl * 4);
                const float rstd = __builtin_amdgcn_rsqf(((t[0] + t[1]) + (t[2] + t[3])) * (1.f / 256.f) + 1e-6f);
                const bf16_t* rp = src + (size_t)(row0 + ai * HALF + m * 16) * 1024 + cb; bf16_t* dp = dst + (size_t)(row0 + ai * HALF + m * 16) * 1024 + cb;
#pragma unroll
                for (int bj = 0; bj < 2; ++bj) { const u32x4 w = *(const u32x4*)(rp + bj * HALF);
                    f32x4 o0 = {bf_lo(w.x), bf_hi(w.x), bf_lo(w.y), bf_hi(w.y)}, o1 = {bf_lo(w.z), bf_hi(w.z), bf_lo(w.w), bf_hi(w.w)};
                    f32x4 a0 = acc[ai][bj][m][0], a1 = acc[ai][bj][m][1];
#pragma unroll
                    for (int e = 0; e < 4; ++e) { a0[e] = isg ? silu_f(a0[e]) : sigm_f(a0[e]); a1[e] = isg ? silu_f(a1[e]) : sigm_f(a1[e]); }
                    o0 = o0 * rstd * g8[bj][0] * a0; o1 = o1 * rstd * g8[bj][1] * a1;
                    *(u32x4*)(dp + bj * HALF) = pack8(o0, o1); } }
        asm volatile("s_waitcnt lgkmcnt(0)" ::: "memory"); __builtin_amdgcn_s_barrier(); asm volatile("" ::: "memory");
    }
};

struct EpiMerge {
    static constexpr bool PERM = true, AFTER_DRAIN = false;
    float* T; float* T2; bf16_t* Y;
    __device__ __forceinline__ void operator()(const f32x4 (&acc)[2][2][4][2], const Unit& u, int wr, int wc, int fr, int fq) const {
        const int step = u.pn >= 37 ? 2 : (u.pn >= 33 ? 0 : (u.pn >= 29 ? 3 : 1));
        const int opm = u.pm - (step == 0 ? 68 : (step == 2 ? 132 : 0)), opn = (u.pn - 25) & 3;
        const size_t tb = ((size_t)(opm * 4 + opn) * 32) * 512 + threadIdx.x;
        f32x4* t = (f32x4*)T + tb; f32x4* t2 = (f32x4*)T2 + tb;
        const int row0 = opm * BM + wr * 64 + fr, cb = opn * BM + wc * 32 + 8 * fq;
#pragma unroll
        for (int ai = 0; ai < 2; ++ai)
#pragma unroll
            for (int m = 0; m < 4; ++m)
#pragma unroll
                for (int bj = 0; bj < 2; ++bj) {
                    const int j0 = ((ai * 2 + bj) * 4 + m) * 2;
                    if (step == 0) { t[(size_t)j0 * 512] = acc[ai][bj][m][0]; t[(size_t)(j0 + 1) * 512] = acc[ai][bj][m][1]; }
                    else if (step == 2) { t2[(size_t)j0 * 512] = acc[ai][bj][m][0]; t2[(size_t)(j0 + 1) * 512] = acc[ai][bj][m][1]; }
                    else {
                        f32x4 s0 = acc[ai][bj][m][0], s1 = acc[ai][bj][m][1];
#pragma unroll
                        for (int e = 0; e < 4; ++e) { s0[e] = sigm_f(s0[e]); s1[e] = sigm_f(s1[e]); }
                        if (step == 1) { t[(size_t)j0 * 512] = t[(size_t)j0 * 512] * s0; t[(size_t)(j0 + 1) * 512] = t[(size_t)(j0 + 1) * 512] * s1; }
                        else { const f32x4 y0 = t[(size_t)j0 * 512] + t2[(size_t)j0 * 512] * s0, y1 = t[(size_t)(j0 + 1) * 512] + t2[(size_t)(j0 + 1) * 512] * s1;
                            *(u32x4*)(Y + (size_t)(row0 + ai * HALF + m * 16) * 1024 + cb + bj * HALF) = pack8(y0, y1); }
                    }
                }
    }
};

struct EpiResid {
    static constexpr bool PERM = false, AFTER_DRAIN = false;
    const float* base; float* out; const float* mod; int gidx; float* ss;
    __device__ __forceinline__ void operator()(const f32x4 (&acc)[2][2][4][2], const Unit& u, int wr, int wc, int fr, int fq) const {
        const float* gate = mod + (size_t)(u.pm >> 4) * 6144 + gidx * 1024;
        const int row0 = u.pm * BM + wr * 64 + fr, col0 = u.pn * BM + wc * 32 + 4 * fq;
        f32x4 gv[2][2];
#pragma unroll
        for (int bj = 0; bj < 2; ++bj)
#pragma unroll
            for (int n = 0; n < 2; ++n) gv[bj][n] = *(const f32x4*)(gate + col0 + bj * HALF + n * 16);
#pragma unroll
        for (int ai = 0; ai < 2; ++ai)
#pragma unroll
            for (int m = 0; m < 4; ++m) { const int row = row0 + ai * HALF + m * 16; const size_t off = (size_t)row * 1024 + col0; float s = 0.f;
#pragma unroll
                for (int bj = 0; bj < 2; ++bj)
#pragma unroll
                    for (int n = 0; n < 2; ++n) { const f32x4 xv = *(const f32x4*)(base + off + bj * HALF + n * 16); const f32x4 o = xv + gv[bj][n] * acc[ai][bj][m][n];
                        *(f32x4*)(out + off + bj * HALF + n * 16) = o; s += (o[0] * o[0] + o[1] * o[1]) + (o[2] * o[2] + o[3] * o[3]); }
                s += __shfl_xor(s, 16); s += __shfl_xor(s, 32);
                if (fq == 0) atomicAdd(ss + row, s); }
    }
};

struct EpiSwiglu {
    static constexpr bool PERM = true, AFTER_DRAIN = false;
    bf16_t* Hf;
    __device__ __forceinline__ void operator()(const f32x4 (&acc)[2][2][4][2], const Unit& u, int wr, int wc, int fr, int fq) const {
        const int row0 = u.pm * BM + wr * 64 + fr, cb = u.pn * HALF + wc * 32 + 8 * fq;
#pragma unroll
        for (int ai = 0; ai < 2; ++ai)
#pragma unroll
            for (int m = 0; m < 4; ++m) { f32x4 h0 = acc[ai][0][m][0], h1 = acc[ai][0][m][1];
#pragma unroll
                for (int e = 0; e < 4; ++e) { h0[e] = silu_f(h0[e]) * acc[ai][1][m][0][e]; h1[e] = silu_f(h1[e]) * acc[ai][1][m][1][e]; }
                *(u32x4*)(Hf + (size_t)(row0 + ai * HALF + m * 16) * 2816 + cb) = pack8(h0, h1); }
    }
};
template <class Epi, class Sched, bool ALIGN_EPI = false, bool SP2 = false>
__device__ __forceinline__ void gemm_phase(PG8_LAS unsigned char* lds, const Gemm g, const Sched& S, const Epi& E) {
    const int tid = threadIdx.x, wid = __builtin_amdgcn_readfirstlane(tid >> 6), lane = tid & 63, wr = wid >> 2, wc = wid & 3, fr = lane & 15, fq = lane >> 4;
    const int K = g.K, nt = K / BK;
    unsigned voffA[2], voffB[2];
#pragma unroll
    for (int i = 0; i < 2; ++i) { int R, C; stage_rc(tid * 16 + i * 8192, R, C); const int Rb = Epi::PERM ? ((R & ~31) + perm32(R & 31)) : R;
        voffA[i] = (unsigned)(R * K + C) * 2u; voffB[i] = (unsigned)(Rb * K + C) * 2u; }
    const size_t kstep = (size_t)(BK * 2);
    const size_t hstep = (size_t)HALF * K * 2;
    const size_t tstep = 2 * hstep;
    const unsigned ldsw = (unsigned)wid * 1024u;
    const int aoff = lds_byte(wr * 64 + fr, fq * 8), boff = lds_byte(wc * 32 + fr, fq * 8);
#define PG8_SA(b, h) (((b) * 2 + (h)) * HTB)
#define PG8_SB(b, h) ((4 + (b) * 2 + (h)) * HTB)
#define PG8_STAGE(bufoff, gbase, voff) do { _Pragma("unroll") for (int _i = 0; _i < 2; ++_i) \
        __builtin_amdgcn_global_load_lds((const unsigned*)((const char*)(gbase) + (voff)[_i]), (PG8_LAS unsigned*)(lds + (bufoff) + ldsw + _i * 8192), 16, 0, 0); } while (0)
#define PG8_LDA(dst, b, h) do { _Pragma("unroll") for (int m = 0; m < 4; ++m) _Pragma("unroll") for (int k = 0; k < 2; ++k) dst[m][k] = *(const PG8_LAS bf16x8*)(lds + PG8_SA(b, h) + aoff + m * 2048 + k * 1024); } while (0)
#define PG8_LDB(dst, b, h) do { _Pragma("unroll") for (int n = 0; n < 2; ++n) _Pragma("unroll") for (int k = 0; k < 2; ++k) dst[n][k] = *(const PG8_LAS bf16x8*)(lds + PG8_SB(b, h) + boff + n * 2048 + k * 1024); } while (0)
#define PG8_MMA(ai, bj, At, Bt) do { __builtin_amdgcn_s_setprio(1); _Pragma("unroll") for (int m = 0; m < 4; ++m) _Pragma("unroll") for (int n = 0; n < 2; ++n) _Pragma("unroll") for (int k = 0; k < 2; ++k) \
        acc[ai][bj][m][n] = __builtin_amdgcn_mfma_f32_16x16x32_bf16(Bt[n][k], At[m][k], acc[ai][bj][m][n], 0, 0, 0); __builtin_amdgcn_s_setprio(0); } while (0)
#define PG8_WAIT_V(n) asm volatile("s_waitcnt vmcnt(" #n ")" ::: "memory")
#define PG8_WAIT_L(n) asm volatile("s_waitcnt lgkmcnt(" #n ")" ::: "memory")
#define PG8_BAR __builtin_amdgcn_s_barrier()
#define PG8_SCHED __builtin_amdgcn_sched_barrier(0)
    Unit cur, nxt; int ui = 0;
    if (!S.next(0, cur)) return;
    f32x4 acc[2][2][4][2];
#pragma unroll
    for (int a = 0; a < 2; ++a)
#pragma unroll
        for (int b = 0; b < 2; ++b)
#pragma unroll
            for (int m = 0; m < 4; ++m)
#pragma unroll
                for (int n = 0; n < 2; ++n) acc[a][b][m][n] = (f32x4){0.f, 0.f, 0.f, 0.f};
    bf16x8 At[4][2], B0[2][2], B1[2][2];
    const char* cA = (const char*)g.A + (size_t)cur.pm * tstep; const char* cB = (const char*)g.Bt + (size_t)cur.pn * tstep;
    S.a_ready(cur);
    if constexpr (SP2) {
        PG8_STAGE(PG8_SB(0, 0), cB, voffB); PG8_STAGE(PG8_SB(0, 1), cB + hstep, voffB); PG8_STAGE(PG8_SA(0, 0), cA, voffA); PG8_STAGE(PG8_SA(0, 1), cA + hstep, voffA);
        if (wr == 1) PG8_BAR;
        PG8_WAIT_V(2); PG8_BAR;
        PG8_STAGE(PG8_SB(1, 0), cB + kstep, voffB); PG8_STAGE(PG8_SA(1, 0), cA + kstep, voffA); PG8_STAGE(PG8_SB(1, 1), cB + hstep + kstep, voffB);
        PG8_WAIT_V(6); PG8_BAR;
    } else {
        PG8_STAGE(PG8_SB(0, 0), cB, voffB); PG8_STAGE(PG8_SA(0, 0), cA, voffA); PG8_STAGE(PG8_SB(0, 1), cB + hstep, voffB); PG8_STAGE(PG8_SA(0, 1), cA + hstep, voffA);
        if (wr == 1) PG8_BAR;
        PG8_WAIT_V(4); PG8_BAR;
        PG8_STAGE(PG8_SB(1, 0), cB + kstep, voffB); PG8_STAGE(PG8_SA(1, 0), cA + kstep, voffA); PG8_STAGE(PG8_SB(1, 1), cB + hstep + kstep, voffB);
        PG8_WAIT_V(6); PG8_BAR;
    }
    for (;;) {
        const bool has_next = S.next(ui + 1, nxt);
        const char* nA = has_next ? (const char*)g.A + (size_t)nxt.pm * tstep : cA; const char* nB = has_next ? (const char*)g.Bt + (size_t)nxt.pn * tstep : cB;
        for (int t = 0; t < nt; t += 2) {
            const bool last = (t == nt - 2);
            const char* a1 = cA + (size_t)(t + 1) * kstep;
            const char* a2 = last ? nA : cA + (size_t)(t + 2) * kstep; const char* b2 = last ? nB : cB + (size_t)(t + 2) * kstep;
            const char* a3 = a2 + kstep; const char* b3 = b2 + kstep;
            if (last && has_next) S.a_ready(nxt);
            if constexpr (SP2) {
            PG8_LDB(B0, 0, 0); PG8_LDB(B1, 0, 1); PG8_SCHED; PG8_LDA(At, 0, 0); PG8_STAGE(PG8_SA(1, 1), a1 + hstep, voffA);
            PG8_WAIT_V(8); PG8_WAIT_L(0); PG8_BAR; PG8_MMA(0, 0, At, B0); PG8_MMA(0, 1, At, B1); PG8_BAR; PG8_SCHED;
            PG8_LDA(At, 0, 1); PG8_STAGE(PG8_SB(0, 0), b2, voffB); PG8_STAGE(PG8_SB(0, 1), b2 + hstep, voffB); PG8_STAGE(PG8_SA(0, 0), a2, voffA);
            PG8_WAIT_V(8); PG8_WAIT_L(0); PG8_BAR; PG8_MMA(1, 0, At, B0); PG8_MMA(1, 1, At, B1); PG8_BAR; PG8_SCHED;
            PG8_LDB(B0, 1, 0); PG8_LDB(B1, 1, 1); PG8_SCHED; PG8_LDA(At, 1, 0); PG8_STAGE(PG8_SA(0, 1), a2 + hstep, voffA);
            PG8_WAIT_V(8); PG8_WAIT_L(0); PG8_BAR; PG8_MMA(0, 0, At, B0); PG8_MMA(0, 1, At, B1); PG8_BAR; PG8_SCHED;
            PG8_LDA(At, 1, 1); PG8_STAGE(PG8_SB(1, 0), b3, voffB); PG8_STAGE(PG8_SB(1, 1), b3 + hstep, voffB); PG8_STAGE(PG8_SA(1, 0), a3, voffA);
            PG8_WAIT_V(8); PG8_WAIT_L(0); PG8_BAR; PG8_MMA(1, 0, At, B0); PG8_MMA(1, 1, At, B1); PG8_BAR; PG8_SCHED;
            } else {
            PG8_LDB(B0, 0, 0); PG8_SCHED; PG8_LDA(At, 0, 0); PG8_STAGE(PG8_SA(1, 1), a1 + hstep, voffA);
            PG8_WAIT_L(8); PG8_BAR; PG8_WAIT_L(0); PG8_MMA(0, 0, At, B0); PG8_BAR; PG8_SCHED;
            PG8_LDB(B1, 0, 1); PG8_STAGE(PG8_SB(0, 0), b2, voffB);
            PG8_BAR; PG8_WAIT_L(0); PG8_MMA(0, 1, At, B1); PG8_BAR;
            PG8_LDA(At, 0, 1); PG8_STAGE(PG8_SA(0, 0), a2, voffA);
            PG8_BAR; PG8_WAIT_L(0); PG8_MMA(1, 0, At, B0); PG8_BAR; PG8_SCHED;
            PG8_STAGE(PG8_SB(0, 1), b2 + hstep, voffB);
            PG8_WAIT_V(6); PG8_BAR; PG8_MMA(1, 1, At, B1); PG8_BAR;
            PG8_LDB(B0, 1, 0); PG8_SCHED; PG8_LDA(At, 1, 0); PG8_STAGE(PG8_SA(0, 1), a2 + hstep, voffA);
            PG8_WAIT_L(8); PG8_BAR; PG8_WAIT_L(0); PG8_MMA(0, 0, At, B0); PG8_BAR; PG8_SCHED;
            PG8_LDB(B1, 1, 1); PG8_STAGE(PG8_SB(1, 0), b3, voffB);
            PG8_BAR; PG8_WAIT_L(0); PG8_MMA(0, 1, At, B1); PG8_BAR;
            PG8_LDA(At, 1, 1); PG8_STAGE(PG8_SA(1, 0), a3, voffA);
            PG8_BAR; PG8_WAIT_L(0); PG8_MMA(1, 0, At, B0); PG8_BAR; PG8_SCHED;
            PG8_STAGE(PG8_SB(1, 1), b3 + hstep, voffB);
            PG8_WAIT_V(6); PG8_BAR; PG8_MMA(1, 1, At, B1); PG8_BAR;
            }
        }
        if constexpr (ALIGN_EPI) { if (wr == 0) PG8_BAR; }
        if constexpr (!Epi::AFTER_DRAIN) { E(acc, cur, wr, wc, fr, fq); S.done(cur); }
        if (!has_next) break;
#pragma unroll
        for (int a = 0; a < 2; ++a)
#pragma unroll
            for (int b = 0; b < 2; ++b)
#pragma unroll
                for (int m = 0; m < 4; ++m)
#pragma unroll
                    for (int n = 0; n < 2; ++n) acc[a][b][m][n] = (f32x4){0.f, 0.f, 0.f, 0.f};
        cur = nxt; cA = nA; cB = nB; ++ui;
        if constexpr (ALIGN_EPI) { if (wr == 1) PG8_BAR; }
    }
    PG8_WAIT_V(0);
    if constexpr (!ALIGN_EPI) { if (wr == 0) PG8_BAR; }
    PG8_BAR;
    if constexpr (Epi::AFTER_DRAIN) { E.fused(acc, cur, wr, wc, fr, fq, lds, wid, lane); S.done(cur); }
#undef PG8_SA
#undef PG8_SB
#undef PG8_STAGE
#undef PG8_LDA
#undef PG8_LDB
#undef PG8_MMA
#undef PG8_WAIT_V
#undef PG8_WAIT_L
#undef PG8_BAR
#undef PG8_SCHED
}
}
constexpr int NWAVES = 8;
constexpr int N_LAUNCHES = MK_N_LAUNCHES;
constexpr int PER_PHASE = 11;
constexpr int D = 1024, NB = 4, SEQ = 4096, CTXL = 256, ML = NB * SEQ, MC = NB * CTXL, MT = ML + MC;
constexpr int NIN = 8240, DFF = 2816;
constexpr float RMS_EPS = 1e-6f, QK_SCALE = 0.08838834764831845f;
constexpr int SC_GQ = 0, SC_GK = 512, SC_GV = 1024, SC_MQ = 2048, SC_MK = 2560, SC_MV = 3072;
constexpr int WT_OG = 17, WT_MRG1 = 25, WT_MRG2 = 29, WT_BR1 = 33, WT_BR2 = 37, WT_OUT = 41, WT_FFN1 = 45, WT_TILES = 67;
constexpr size_t MiB = 1u << 20;
constexpr size_t WS_CTL = 0, CTL_ZERO_BYTES = 1 * MiB;
constexpr size_t WS_WT = 2 * MiB;
constexpr size_t WS_W2T = 36 * MiB;
constexpr size_t WS_XN = 42 * MiB;
constexpr size_t WS_Y1 = 76 * MiB, WS_Y2 = 108 * MiB;
constexpr size_t WS_SIN = 76 * MiB;
constexpr size_t WS_SMALL = 212 * MiB;
constexpr size_t WS_EB = 217 * MiB;
constexpr size_t WS_ET = 251 * MiB;
constexpr size_t WS_HALO = 253 * MiB;
constexpr size_t WS_T2 = 140 * MiB;
constexpr size_t WS_Y = 204 * MiB;
constexpr size_t WS_HF = 76 * MiB;
constexpr size_t WS_END = 256 * MiB;
static_assert(WS_XN + (size_t)MT * D * 2 == WS_Y1 && WS_Y1 + (size_t)ML * D * 2 == WS_Y2 && WS_SIN + (size_t)MT * 4096 * 2 <= WS_SMALL && WS_SMALL + (size_t)MT * 64 * 4 <= 256 * MiB, "ws map");
static_assert(WS_Y2 + (size_t)ML * D * 2 <= WS_T2 && WS_T2 + 64 * MiB <= WS_Y && WS_HF + (size_t)ML * DFF * 2 <= WS_Y && WS_WT + (size_t)WT_TILES * 256 * D * 2 <= WS_W2T && WS_W2T + (size_t)D * DFF * 2 <= WS_XN, "ws map 2");
constexpr int CW_TMO = 0, CW_CODE = 1, CW_BAR = 4096;
constexpr size_t CTL_MOD = 65536, CTL_SS1 = 262144, CTL_SS2 = 327680;
constexpr int RING_OFF = 0, RING_BYTES = 131072, EPI_ST_OFF = RING_BYTES, LDSCTL_OFF = 139264, MISC_OFF = LDSCTL_OFF + 320, LDS_BYTES = 147456;
static_assert(MISC_OFF + 128 <= LDS_BYTES, "LDS map");

#define GAS __attribute__((address_space(1)))
#define LAS __attribute__((address_space(3)))
typedef unsigned short bf16;
typedef unsigned v4u __attribute__((ext_vector_type(4)));
typedef unsigned v2u __attribute__((ext_vector_type(2)));
typedef float f32x4 __attribute__((ext_vector_type(4)));
typedef short bf16x8 __attribute__((ext_vector_type(8)));
typedef GAS unsigned gu32;
#define RLX_AGENT __ATOMIC_RELAXED, __HIP_MEMORY_SCOPE_AGENT
#define LDS_WAIT() asm volatile("s_waitcnt lgkmcnt(0)" ::: "memory")
#define VM_WAIT() asm volatile("s_waitcnt vmcnt(0)" ::: "memory")
__device__ __forceinline__ unsigned f2bf(float f) { unsigned u = __builtin_bit_cast(unsigned, f); return (u + 0x7fffu + ((u >> 16) & 1u)) >> 16; }
__device__ __forceinline__ unsigned pk2(float lo, float hi) { return pg8::cvt_pk_bf16(lo, hi); }
__device__ __forceinline__ float bf2f(bf16 h) { return __uint_as_float((unsigned)h << 16); }
using pg8::bf_lo; using pg8::bf_hi;
__device__ __forceinline__ float logsig_f(float z) { return fminf(z, 0.f) - __logf(1.f + __expf(-fabsf(z))); }
#define XB_TMO      128
#define XB_XCNT(j)  (256  + 64 * (j))
#define XB_XSUB(j)  (1280 + 64 * (j))
#define XB_XGEN(j)  (2304 + 64 * (j))
#define XB_TOP      3328
#define XB_TOPGEN   3392
#define XCD_BAR_WORDS 3456
#define XB_SPIN_CAP (1u << 18)

__device__ __forceinline__ unsigned xb_ld(unsigned* p)              { return __hip_atomic_load(p, __ATOMIC_RELAXED, __HIP_MEMORY_SCOPE_AGENT); }
__device__ __forceinline__ unsigned xb_add(unsigned* p, unsigned v) { return __hip_atomic_fetch_add(p, v, __ATOMIC_RELAXED, __HIP_MEMORY_SCOPE_AGENT); }
__device__ __forceinline__ unsigned xb_xcc_id() { return (unsigned)__builtin_amdgcn_s_getreg((3 << 11) | 20) & 0xFu; }
#define XB_SPIN(cond, bar) do { unsigned _sp = 0; while (cond) { __builtin_amdgcn_s_sleep(1); \
    if ((++_sp & 255u) == 0u) { if (xb_ld(&(bar)[XB_TMO])) break; if (_sp > XB_SPIN_CAP) { atomicAdd(&(bar)[XB_TMO], 1u); break; } } } } while (0)

struct XcdBarrier {
    unsigned* bar; unsigned x;
    volatile LAS unsigned* st;
};

__device__ __forceinline__ XcdBarrier xcd_barrier_post(unsigned* bar, volatile LAS unsigned* st) {
    XcdBarrier b; b.bar = bar; b.x = xb_xcc_id(); b.st = st;
    if (threadIdx.x == 0) (void)xb_add(&bar[XB_XCNT(b.x)], 1u);
    return b;
}
__device__ __forceinline__ void xcd_barrier_complete(unsigned* bar, unsigned x, unsigned& nloc, unsigned& nx) {
    const unsigned G = gridDim.x * gridDim.y * gridDim.z;
    unsigned sum, cnt, mine, sp = 0u;
    for (;;) {
        sum = 0u; cnt = 0u; mine = 0u;
#pragma unroll
        for (unsigned j = 0; j < 16; ++j) { const unsigned c = xb_ld(&bar[XB_XCNT(j)]); sum += c; cnt += (c > 0u) ? 1u : 0u; mine = (j == x) ? c : mine; }
        if (sum == G) break;
        __builtin_amdgcn_s_sleep(1);
        if ((++sp & 255u) == 0u) { if (xb_ld(&bar[XB_TMO])) break; if (sp > XB_SPIN_CAP) { atomicAdd(&bar[XB_TMO], 1u); break; } }
    }
    nloc = mine > 0u ? mine : 1u; nx = cnt > 0u ? cnt : 1u;
}

__device__ __forceinline__ void xcd_barrier(const XcdBarrier& b) {
    asm volatile("s_waitcnt vmcnt(0)" ::: "memory");
    __syncthreads();
    if (threadIdx.x == 0) {
        unsigned* bar = b.bar;
        __builtin_amdgcn_s_waitcnt(0);
        unsigned nloc = b.st[0], nx = b.st[1];
        if (nloc == 0u) { xcd_barrier_complete(bar, b.x, nloc, nx); b.st[0] = nloc; b.st[1] = nx; }
        const unsigned old = xb_add(&bar[XB_XSUB(b.x)], 1u);
        const unsigned gen = old / nloc;
        if (old + 1u == (gen + 1u) * nloc) {
            __builtin_amdgcn_fence(__ATOMIC_RELEASE, "agent");
            asm volatile("s_waitcnt vmcnt(0)" ::: "memory");
            const unsigned og = xb_add(&bar[XB_TOP], 1u);
            const unsigned tg = og / nx;
            if (og + 1u == (tg + 1u) * nx) xb_add(&bar[XB_TOPGEN], 1u);
            else XB_SPIN(xb_ld(&bar[XB_TOPGEN]) == tg, bar);
            __builtin_amdgcn_fence(__ATOMIC_ACQUIRE, "agent");
            xb_add(&bar[XB_XGEN(b.x)], 1u);
            asm volatile("s_waitcnt vmcnt(0)" ::: "memory");
        } else {
            XB_SPIN(xb_ld(&bar[XB_XGEN(b.x)]) == gen, bar);
            __builtin_amdgcn_fence(__ATOMIC_ACQUIRE, "agent");
            asm volatile("s_waitcnt vmcnt(0)" ::: "memory");
        }
    }
    __syncthreads();
}
struct Frame {
    LAS unsigned char* lds;
    volatile LAS unsigned* MISC;
    gu32* ctl;
    int tid, lane, wave;
    int vcu, G;
    const float *x, *c, *ctx, *cctx, *w_ada, *b_ada, *norm1_g, *w_in, *w_up, *b_dec, *gla_g, *conv_w, *conv_b, *b_gate, *mlstm_g, *w_br1, *w_br2, *w_out, *norm2_g, *w_f1, *w_f2, *final_g;
    float* out;
    bf16 *WT, *W2T, *XN, *Y1, *Y2, *SIN, *Y, *HF;
    float *SMALL, *T2, *MOD, *SS1, *SS2, *ET; bf16 *EB, *HALO;
};
__device__ __forceinline__ float wave_sum(float v) {
#pragma unroll
    for (int o = 1; o < 64; o <<= 1) v += __shfl_xor(v, o);
    return v;
}
__device__ __forceinline__ int map_col(int which, int off, int n) {
    if (which == 1) return off + n;
    if (which == 2) { const int isb = n >= DFF, j = isb ? n - DFF : n; return off + 256 * (j >> 7) + (isb ? 128 : 0) + (j & 127); }
    if (n < 2048) return n;
    if (n < 3072) return WT_OG * 256 + (n - 2048);
    if (n < 3104) return 4096 + (n - 3072);
    if (n < 4128) return 2048 + (n - 3104);
    if (n < 5152) return 3072 + (n - 4128);
    if (n < 6176) return (WT_OG + 4) * 256 + (n - 5152);
    if (n < 6192) return 4096 + 32 + (n - 6176);
    if (n < 7216) return WT_MRG1 * 256 + (n - 6192);
    return WT_MRG2 * 256 + (n - 7216);
}
__device__ __forceinline__ void p0_transpose_item(const float* W, int K, int N, bf16* WTb, int which, int off, LAS float* scr, int item, int lane) {
    const int nblk = (N + 31) / 32, kb = item / nblk, nb = item % nblk, k0 = 64 * kb, n0 = 32 * nb;
    const bool okc = n0 + (lane & 31) < N;
#pragma unroll 8
    for (int i = 0; i < 32; ++i) { const int kk = 2 * i + (lane >> 5); scr[kk * 33 + (lane & 31)] = okc ? W[(size_t)(k0 + kk) * N + n0 + (lane & 31)] : 0.f; }
    LDS_WAIT(); asm volatile("" ::: "memory");
    const int c8 = lane & 7;
#pragma unroll
    for (int j = 0; j < 4; ++j) { const int n = (lane >> 3) + 8 * j; const LAS float* s = scr + (8 * c8) * 33 + n;
        v4u o; o.x = pk2(s[0 * 33], s[1 * 33]); o.y = pk2(s[2 * 33], s[3 * 33]); o.z = pk2(s[4 * 33], s[5 * 33]); o.w = pk2(s[6 * 33], s[7 * 33]);
        if (n0 + n < N) *(GAS v4u*)(WTb + (size_t)map_col(which, off, n0 + n) * K + k0 + 8 * c8) = o; }
    LDS_WAIT(); asm volatile("" ::: "memory");
}
__device__ __forceinline__ void p0_prologue(Frame& F) {
    LAS float* scr = (LAS float*)(F.lds + RING_OFF + F.wave * 16384);
    const int gw = F.vcu * NWAVES + F.wave, NGW = F.G * NWAVES;
    constexpr int I_IN = 16 * 258, I_BR = 16 * 32, I_F1 = 16 * 176, I_F2 = 44 * 32, I_MOD = 96 * 8;
    constexpr int NITEMS = I_IN + 3 * I_BR + I_F1 + I_F2 + I_MOD;
    for (int it = gw; it < NITEMS; it += NGW) {
        int r = it;
        if (r < I_MOD) {
            const int ncb = r >> 3, kb = r & 7, n = ncb * 64 + F.lane, kbase = kb * 128;
            float sA[5], sB[5], acc[5];
#pragma unroll
            for (int q = 0; q < 5; ++q) { const float* src = q < 4 ? F.c + q * D : F.cctx; const float a = src[kbase + F.lane], b2 = src[kbase + 64 + F.lane];
                sA[q] = a / (1.f + __expf(-a)); sB[q] = b2 / (1.f + __expf(-b2)); acc[q] = 0.f; }
            const float* wp = F.w_ada + (size_t)kbase * 6144 + n;
#pragma unroll 4
            for (int kk = 0; kk < 64; ++kk) { const float wv = wp[(size_t)kk * 6144];
#pragma unroll
                for (int q = 0; q < 5; ++q) acc[q] += __shfl(sA[q], kk) * wv; }
#pragma unroll 4
            for (int kk = 0; kk < 64; ++kk) { const float wv = wp[(size_t)(64 + kk) * 6144];
#pragma unroll
                for (int q = 0; q < 5; ++q) acc[q] += __shfl(sB[q], kk) * wv; }
            const float bias = kb == 0 ? F.b_ada[n] : 0.f;
#pragma unroll
            for (int q = 0; q < 5; ++q) atomicAdd(F.MOD + q * 6144 + n, acc[q] + bias);
            continue; }
        r -= I_MOD;
        if (r < I_IN) { p0_transpose_item(F.w_in, D, NIN, F.WT, 0, 0, scr, r, F.lane); continue; } r -= I_IN;
        if (r < I_BR) { p0_transpose_item(F.w_br1, D, D, F.WT, 1, WT_BR1 * 256, scr, r, F.lane); continue; } r -= I_BR;
        if (r < I_BR) { p0_transpose_item(F.w_br2, D, D, F.WT, 1, WT_BR2 * 256, scr, r, F.lane); continue; } r -= I_BR;
        if (r < I_BR) { p0_transpose_item(F.w_out, D, D, F.WT, 1, WT_OUT * 256, scr, r, F.lane); continue; } r -= I_BR;
        if (r < I_F1) { p0_transpose_item(F.w_f1, D, 2 * DFF, F.WT, 2, WT_FFN1 * 256, scr, r, F.lane); continue; } r -= I_F1;
        p0_transpose_item(F.w_f2, DFF, D, F.W2T, 1, 0, scr, r, F.lane);
    }
    { GAS v4u* z = (GAS v4u*)(F.WT + (size_t)(4096 + 48) * D); const int n16 = 208 * 2048 / 16;
      for (int i = gw * 64 + F.lane; i < n16; i += NGW * 64) z[i] = (v4u){0u, 0u, 0u, 0u}; }
}
__device__ __forceinline__ void norm_mod_row(Frame& F, const float* xrow, float ssq_or_neg, const float* g, const float* shift, const float* scale, bf16* orow) {
    const GAS f32x4* xr = (const GAS f32x4*)xrow + F.lane;
    f32x4 v[4]; float s = 0.f;
#pragma unroll
    for (int j = 0; j < 4; ++j) { v[j] = xr[64 * j]; s += (v[j].x * v[j].x + v[j].y * v[j].y) + (v[j].z * v[j].z + v[j].w * v[j].w); }
    const float tot = ssq_or_neg >= 0.f ? ssq_or_neg : wave_sum(s);
    const float rstd = 1.f / sqrtf(tot * (1.f / D) + RMS_EPS);
    GAS unsigned long long* o8 = (GAS unsigned long long*)orow + F.lane;
#pragma unroll
    for (int j = 0; j < 4; ++j) { const f32x4 gv = ((const GAS f32x4*)g)[F.lane + 64 * j], sh = ((const GAS f32x4*)shift)[F.lane + 64 * j], sc = ((const GAS f32x4*)scale)[F.lane + 64 * j];
        const f32x4 y = (v[j] * rstd * gv) * (1.f + sc) + sh;
        o8[64 * j] = (unsigned long long)pk2(y.x, y.y) | ((unsigned long long)pk2(y.z, y.w) << 32); }
}
constexpr int SL_AQ = 0, SL_AK = 17408, SL_KT = 34816, SL_PM = 53248, SL_VT = 62464, SL_ST = 69376, SL_VW = 95488, SL_F = 102400;
constexpr int ST_AQ = 272, ST_KT = 144, ST_DIR = 48 * 272;
static_assert(SL_F + 4096 <= RING_BYTES, "scan LDS map");
#define MMA16(a, b, c) __builtin_amdgcn_mfma_f32_16x16x32_bf16((a), (b), (c), 0, 0, 0)
#define SBAR() do { asm volatile("s_waitcnt lgkmcnt(0)" ::: "memory"); __builtin_amdgcn_s_barrier(); asm volatile("" ::: "memory"); } while (0)
__device__ __forceinline__ bf16x8 ldf(LAS unsigned char* base, int row, int stride, int kb) { return *(const LAS bf16x8*)(base + row * stride + kb); }
__device__ __forceinline__ unsigned long long pack4(const f32x4& v) { return (unsigned long long)pk2(v[0], v[1]) | ((unsigned long long)pk2(v[2], v[3]) << 32); }
__device__ __forceinline__ void st_lds16(LAS unsigned char* p, float v) { *(LAS unsigned short*)p = (unsigned short)f2bf(v); }
__device__ __forceinline__ float fexp(float x) { return __builtin_amdgcn_exp2f(x * 1.4426950408889634f); }
__device__ __forceinline__ void out4(bf16* p, f32x4 v, bool rmw, unsigned long long o) {
    if (rmw) { const unsigned lo = (unsigned)o, hi = (unsigned)(o >> 32);
        v[0] += __uint_as_float(lo << 16); v[1] += __uint_as_float(lo & 0xffff0000u); v[2] += __uint_as_float(hi << 16); v[3] += __uint_as_float(hi & 0xffff0000u); }
    *(unsigned long long*)p = pack4(v);
}
__device__ __forceinline__ void stage_v(LAS unsigned char* L, const v2u w, int tid) {
    const int tok = tid >> 3, dvq = (tid & 7) * 4;
    LAS unsigned char* p = L + SL_VT + dvq * ST_KT + tok * 2;
    *(LAS unsigned short*)(p) = (unsigned short)(w.x & 0xffffu); *(LAS unsigned short*)(p + ST_KT) = (unsigned short)(w.x >> 16);
    *(LAS unsigned short*)(p + 2 * ST_KT) = (unsigned short)(w.y & 0xffffu); *(LAS unsigned short*)(p + 3 * ST_KT) = (unsigned short)(w.y >> 16);
}
__device__ __forceinline__ void scores2(LAS unsigned char* L, int w, int l15, int quad, f32x4 (&acc)[2]) {
    const int lt = w >> 1; bf16x8 fa[2][4], fb[4];
#pragma unroll
    for (int ks = 0; ks < 4; ++ks) { fb[ks] = ldf(L + SL_AQ, lt * 16 + l15, ST_AQ, ks * 64 + quad * 16);
#pragma unroll
        for (int mi = 0; mi < 2; ++mi) fa[mi][ks] = ldf(L + SL_AK, ((w & 1) * 2 + mi) * 16 + l15, ST_AQ, ks * 64 + quad * 16); }
    __builtin_amdgcn_sched_barrier(0);
#pragma unroll
    for (int mi = 0; mi < 2; ++mi) { f32x4 a4 = {0.f, 0.f, 0.f, 0.f};
#pragma unroll
        for (int ks = 0; ks < 4; ++ks) a4 = MMA16(fa[mi][ks], fb[ks], a4);
        acc[mi] = a4; }
}
typedef short v4i16_t __attribute__((ext_vector_type(4)));
__device__ __forceinline__ bf16x8 ldkt(LAS unsigned char* L, int ch0, int ks, int l15, int quad) {
    LAS unsigned char* p = L + SL_AK + (ks * 32 + quad * 8 + (l15 >> 2)) * ST_AQ + (ch0 + 4 * (l15 & 3)) * 2;
    const v4i16_t lo = __builtin_amdgcn_ds_read_tr16_b64_v4i16((LAS v4i16_t*)p), hi = __builtin_amdgcn_ds_read_tr16_b64_v4i16((LAS v4i16_t*)(p + 4 * ST_AQ));
    bf16x8 r; r[0] = lo[0]; r[1] = lo[1]; r[2] = lo[2]; r[3] = lo[3]; r[4] = hi[0]; r[5] = hi[1]; r[6] = hi[2]; r[7] = hi[3]; return r;
}

__device__ __forceinline__ void pre_gla_item(Frame& F, const int item) {
    LAS unsigned char* L = F.lds; const int tid = F.tid, w = F.wave, lane = F.lane, l15 = lane & 15, quad = lane >> 4;
    const int bh = item / 68, cg = item % 68, b = bh >> 2, h = bh & 3;
    const int rowbase = cg < 4 ? ML + b * CTXL + cg * 64 : b * SEQ + (cg - 4) * 64;
    const int ch = 16 * w + l15;
#pragma unroll
    for (int dir = 0; dir < 2; ++dir) {
        bf16x8 wfr;
        { float wv[8];
#pragma unroll
          for (int j = 0; j < 8; ++j) wv[j] = quad < 2 ? F.w_up[(size_t)(dir * 16 + quad * 8 + j) * 512 + 128 * h + ch] : 0.f;
          v4u t; t.x = pk2(wv[0], wv[1]); t.y = pk2(wv[2], wv[3]); t.z = pk2(wv[4], wv[5]); t.w = pk2(wv[6], wv[7]); wfr = __builtin_bit_cast(bf16x8, t); }
        const float bd = F.b_dec[dir * 512 + 128 * h + ch];
        float g[4][4], p[4][4]; float carry = 0.f;
#pragma unroll
        for (int tt = 0; tt < 4; ++tt) {
            bf16x8 afr;
            { const float* sp = F.SMALL + (size_t)(rowbase + tt * 16 + l15) * 64 + dir * 16 + (quad & 1) * 8;
              const f32x4 a0 = *(const f32x4*)sp, a1 = *(const f32x4*)(sp + 4);
              v4u t; t.x = pk2(a0[0], a0[1]); t.y = pk2(a0[2], a0[3]); t.z = pk2(a1[0], a1[1]); t.w = pk2(a1[2], a1[3]);
              if (quad >= 2) t = (v4u){0u, 0u, 0u, 0u};
              afr = __builtin_bit_cast(bf16x8, t); }
            f32x4 z = {0.f, 0.f, 0.f, 0.f};
            z = MMA16(afr, wfr, z);
            float run = 0.f;
#pragma unroll
            for (int r = 0; r < 4; ++r) { g[tt][r] = logsig_f(z[r] + bd) * (1.f / 16.f); run += g[tt][r]; p[tt][r] = run; }
            float x = run, y = __shfl_up(x, 16); if (quad >= 1) x += y; y = __shfl_up(x, 32); if (quad >= 2) x += y;
            const float excl = x - run + carry;
#pragma unroll
            for (int r = 0; r < 4; ++r) p[tt][r] += excl;
            carry += __shfl(x, 48 + l15);
        }
        const float T = carry;
        if (quad == 0) F.ET[(size_t)(dir * 272 + (rowbase >> 6)) * 512 + 128 * h + ch] = fexp(T);
#pragma unroll
        for (int tt = 0; tt < 4; ++tt)
#pragma unroll
            for (int r = 0; r < 4; ++r) { const int tok = tt * 16 + quad * 4 + r; const float bcum = dir == 0 ? p[tt][r] : T - p[tt][r] + g[tt][r];
                st_lds16(L + dir * 17408 + tok * ST_AQ + ch * 2, fexp(bcum)); }
    }
    SBAR();
    { const int tok0 = tid >> 4, c16 = tid & 15;
#pragma unroll
      for (int dir = 0; dir < 2; ++dir)
#pragma unroll
        for (int hh = 0; hh < 2; ++hh) { const int tok = tok0 + 32 * hh;
            *(v4u*)(F.EB + ((size_t)dir * MT + rowbase + tok) * 512 + 128 * h + c16 * 8) = *(const LAS v4u*)(L + dir * 17408 + tok * ST_AQ + c16 * 16); } }
    SBAR();
}
__device__ __forceinline__ int mlc_row(int b, int cm, int r) { return cm < 4 ? ML + b * CTXL + cm * 64 + r : b * SEQ + r * 64 + (cm - 4); }
__device__ __forceinline__ void pre_halo_item(Frame& F, const int item) {
    const int ci = item >> 1, which = item & 1, b = ci / 68, cm = ci % 68;
    const v4u* src = (const v4u*)(F.SIN + (size_t)mlc_row(b, cm, which ? 63 : 0) * 4096 + SC_MQ);
    v4u* dst = (v4u*)(F.HALO + (size_t)item * 1024);
    dst[F.lane] = src[F.lane]; dst[F.lane + 64] = src[F.lane + 64];
}
__device__ __forceinline__ void pre_conv_item(Frame& F, const int ci) {
    const int b = ci / 68, cm = ci % 68, ch0 = 2 * F.tid;
    const bool first = (cm == 0 || cm == 4), last = (cm == 3 || cm == 67);
    float cw[8];
#pragma unroll
    for (int e = 0; e < 2; ++e) { cw[4 * e] = F.conv_w[ch0 + e]; cw[4 * e + 1] = F.conv_w[1024 + ch0 + e]; cw[4 * e + 2] = F.conv_w[2048 + ch0 + e]; cw[4 * e + 3] = F.conv_b[ch0 + e]; }
    const float sc = ch0 >= 512 ? QK_SCALE : 1.f;
    bf16* base = F.SIN + SC_MQ + ch0;
    unsigned prev = first ? 0u : *(const unsigned*)(F.HALO + (size_t)((ci - 1) * 2 + 1) * 1024 + ch0);
    unsigned cur = *(const unsigned*)(base + (size_t)mlc_row(b, cm, 0) * 4096);
    const unsigned tail = last ? 0u : *(const unsigned*)(F.HALO + (size_t)((ci + 1) * 2 + 0) * 1024 + ch0);
#pragma unroll
    for (int bq = 0; bq < 4; ++bq) {
        unsigned nx[16];
#pragma unroll
        for (int i = 0; i < 16; ++i) { const int pp = bq * 16 + i + 1; nx[i] = pp < 64 ? *(const unsigned*)(base + (size_t)mlc_row(b, cm, pp < 64 ? pp : 63) * 4096) : tail; }
#pragma unroll
        for (int i = 0; i < 16; ++i) {
            const float a0 = cw[3] + cw[0] * bf_lo(prev) + cw[1] * bf_lo(cur) + cw[2] * bf_lo(nx[i]);
            const float a1 = cw[7] + cw[4] * bf_hi(prev) + cw[5] * bf_hi(cur) + cw[6] * bf_hi(nx[i]);
            *(unsigned*)(base + (size_t)mlc_row(b, cm, bq * 16 + i) * 4096) = pk2(a0 * __builtin_amdgcn_rcpf(1.f + fexp(-a0)) * sc, a1 * __builtin_amdgcn_rcpf(1.f + fexp(-a1)) * sc);
            prev = cur; cur = nx[i]; }
    }
}

struct GlaPF { v4u q0, q1, k0, k1, e0, e1; v2u v; float et; };
__device__ __forceinline__ void gla_issue(GlaPF& pf, const bf16* SIN, const bf16* __restrict__ EB, const float* __restrict__ ET, const int rowbase, const int dir, const int h, const int ocol, const int tid) {
    const int tok0 = tid >> 4, c16 = tid & 15;
    const bf16* qp = SIN + (size_t)(rowbase + tok0) * 4096 + SC_GQ + 128 * h + c16 * 8;
    pf.q0 = *(const v4u*)qp; pf.q1 = *(const v4u*)(qp + (size_t)32 * 4096); pf.k0 = *(const v4u*)(qp + 512); pf.k1 = *(const v4u*)(qp + (size_t)32 * 4096 + 512);
    const bf16* ep = EB + ((size_t)dir * MT + rowbase + tok0) * 512 + 128 * h + c16 * 8;
    pf.e0 = *(const v4u*)ep; pf.e1 = *(const v4u*)(ep + 32 * 512);
    pf.v = *(const v2u*)(SIN + (size_t)(rowbase + (tid >> 3)) * 4096 + SC_GV + ocol + (tid & 7) * 4);
    pf.et = ET[(size_t)(dir * 272 + (rowbase >> 6)) * 512 + 128 * h + (tid & 127)];
}
__device__ __forceinline__ void gla_piece(LAS unsigned char* L, const v4u q, const v4u k, const v4u e, const int tok, const int c16) {
    v4u qo, ko;
#pragma unroll
    for (int j = 0; j < 4; ++j) {
        const float e0 = bf_lo(e[j]), e1 = bf_hi(e[j]); const float r0 = __builtin_amdgcn_rcpf(e0), r1 = __builtin_amdgcn_rcpf(e1);
        qo[j] = pk2(bf_lo(q[j]) * QK_SCALE * e0, bf_hi(q[j]) * QK_SCALE * e1);
        ko[j] = pk2(bf_lo(k[j]) * r0, bf_hi(k[j]) * r1);
    }
    *(LAS v4u*)(L + SL_AQ + tok * ST_AQ + c16 * 16) = qo; *(LAS v4u*)(L + SL_AK + tok * ST_AQ + c16 * 16) = ko;
}
__device__ __forceinline__ void gla_substep(LAS unsigned char* L, const bf16* SIN, const bf16* __restrict__ EB, const float* __restrict__ ET, bf16* OUT,
                                            const int dir, const int rowbase, const bool lat, const bool rmw, const int ocol, const int h, f32x4 (&S)[2], GlaPF& pf,
                                            const int nrowbase, const int ndir, const int tid, const int w, const int lane, const bool xp) {
    const int l15 = lane & 15, quad = lane >> 4;
    { const int tok0 = tid >> 4, c16 = tid & 15;
      gla_piece(L, pf.q0, pf.k0, pf.e0, tok0, c16); gla_piece(L, pf.q1, pf.k1, pf.e1, tok0 + 32, c16);
      stage_v(L, pf.v, tid);
      if (tid < 128) *(LAS float*)(L + SL_F + tid * 4) = pf.et; }
    bf16* const optr = OUT + (size_t)(rowbase + (w >> 1) * 16 + l15) * 1024 + ocol + (w & 1) * 16 + quad * 4;
    if (!(xp && MK_PROBE == 2)) gla_issue(pf, SIN, EB, ET, nrowbase, ndir, h, ocol, tid);
    SBAR();
    if (lat) {
        f32x4 sc[2]; scores2(L, w, l15, quad, sc);
        const int l = (w >> 1) * 16 + l15;
#pragma unroll
        for (int mi = 0; mi < 2; ++mi) { const int m0 = ((w & 1) * 2 + mi) * 16 + quad * 4; f32x4 v = sc[mi];
#pragma unroll
            for (int r = 0; r < 4; ++r) { const bool keep = dir == 0 ? (m0 + r <= l) : (m0 + r >= l); v[r] = keep ? v[r] : 0.f; }
            *(LAS unsigned long long*)(L + SL_PM + l * ST_KT + m0 * 2) = pack4(v); }
        SBAR();
    }
    {
        bf16x8 kf[2], vf[2][2];
#pragma unroll
        for (int ks = 0; ks < 2; ++ks) { kf[ks] = ldkt(L, 16 * w, ks, l15, quad);
#pragma unroll
            for (int dvt = 0; dvt < 2; ++dvt) vf[dvt][ks] = ldf(L + SL_VT, dvt * 16 + l15, ST_KT, ks * 64 + quad * 16); }
        const f32x4 dec = *(const LAS f32x4*)(L + SL_F + (16 * w + quad * 4) * 4);
        if (lat) {
            const int dvt = w & 1, tt = w >> 1; bf16x8 pa[2], pb[2], sa[4], sb[4];
#pragma unroll
            for (int ks = 0; ks < 2; ++ks) { pa[ks] = ldf(L + SL_VT, dvt * 16 + l15, ST_KT, ks * 64 + quad * 16); pb[ks] = ldf(L + SL_PM, tt * 16 + l15, ST_KT, ks * 64 + quad * 16); }
#pragma unroll
            for (int ks = 0; ks < 4; ++ks) { sa[ks] = ldf(L + SL_ST + dir * ST_DIR, dvt * 16 + l15, ST_AQ, ks * 64 + quad * 16); sb[ks] = ldf(L + SL_AQ, tt * 16 + l15, ST_AQ, ks * 64 + quad * 16); }
            __builtin_amdgcn_sched_barrier(0);
            f32x4 a4 = {0.f, 0.f, 0.f, 0.f};
#pragma unroll
            for (int ks = 0; ks < 2; ++ks) a4 = MMA16(pa[ks], pb[ks], a4);
#pragma unroll
            for (int ks = 0; ks < 4; ++ks) a4 = MMA16(sa[ks], sb[ks], a4);
            unsigned long long oldv = 0ull;
            if (rmw && !(xp && MK_PROBE == 1)) oldv = __hip_atomic_load((unsigned long long*)optr, RLX_AGENT);
            out4(optr, a4, rmw, oldv);
        }
#pragma unroll
        for (int dvt = 0; dvt < 2; ++dvt) { f32x4 a4 = S[dvt];
#pragma unroll
            for (int ks = 0; ks < 2; ++ks) a4 = MMA16(kf[ks], vf[dvt][ks], a4);
            S[dvt] = a4 * dec; }
    }
    SBAR();
#pragma unroll
    for (int dvt = 0; dvt < 2; ++dvt) *(LAS unsigned long long*)(L + SL_ST + dir * ST_DIR + (dvt * 16 + l15) * ST_AQ + (16 * w + quad * 4) * 2) = pack4(S[dvt]);
}
__device__ __forceinline__ int gla_rowbase(int b, int step, int dir) {
    const bool lat = step >= 4; const int chunk = lat ? (dir ? 67 - step : step - 4) : (dir ? 3 - step : step);
    return lat ? b * SEQ + chunk * 64 : ML + b * CTXL + chunk * 64;
}
__device__ __forceinline__ void scan_gla(Frame& F, const int b, const int h, const int slice, const bool xp) {
    LAS unsigned char* L = F.lds; const int tid = F.tid, w = F.wave, lane = F.lane;
    for (int i = tid; i < 2 * ST_DIR / 4; i += 512) ((LAS unsigned*)(L + SL_ST))[i] = 0u;
    f32x4 Sf[2], Sb[2];
#pragma unroll
    for (int i = 0; i < 2; ++i) { Sf[i] = (f32x4){0.f, 0.f, 0.f, 0.f}; Sb[i] = (f32x4){0.f, 0.f, 0.f, 0.f}; }
    const int ocol = 256 * h + 32 * slice; bf16* OUT = (bf16*)F.out;
    GlaPF pf; gla_issue(pf, F.SIN, F.EB, F.ET, gla_rowbase(b, 0, 0), 0, h, ocol, tid);
    SBAR();
    for (int step = 0; step < 68; ++step) {
        const bool lat = step >= 4;
        { const int chunk = lat ? step - 4 : step;
          gla_substep(L, F.SIN, F.EB, F.ET, OUT, 0, gla_rowbase(b, step, 0), lat, lat && chunk >= 32, ocol, h, Sf, pf, gla_rowbase(b, step, 1), 1, tid, w, lane, xp); }
        { const int chunk = lat ? 67 - step : 3 - step; const int ns = step < 67 ? step + 1 : 67;
          gla_substep(L, F.SIN, F.EB, F.ET, OUT, 1, gla_rowbase(b, step, 1), lat, lat && chunk <= 31, ocol, h, Sb, pf, gla_rowbase(b, ns, 0), 0, tid, w, lane, xp); }
        if (step == 35) { VM_WAIT(); SBAR(); }
    }
    VM_WAIT(); SBAR();
}

struct MlPF { v4u q0, q1, k0, k1; v2u v; float gi, gf; };
__device__ __forceinline__ int ml_row(int b, bool lat, int p) { return lat ? (b * SEQ + (p & 63) * 64 + (p >> 6)) : (ML + b * CTXL + p); }
__device__ __forceinline__ void ml_issue(MlPF& pf, const bf16* SIN, const float* __restrict__ SMALL, const int b, const int chunk, const bool lat, const int dir, const int h, const int ocol, const int tid, const int lane) {
    const int p0 = chunk * 64, tok0 = tid >> 4, c16 = tid & 15;
    const bf16* qa = SIN + (size_t)ml_row(b, lat, p0 + tok0) * 4096 + SC_MQ + 128 * h + c16 * 8; const bf16* qb = SIN + (size_t)ml_row(b, lat, p0 + tok0 + 32) * 4096 + SC_MQ + 128 * h + c16 * 8;
    pf.q0 = *(const v4u*)qa; pf.q1 = *(const v4u*)qb; pf.k0 = *(const v4u*)(qa + 512); pf.k1 = *(const v4u*)(qb + 512);
    pf.v = *(const v2u*)(SIN + (size_t)ml_row(b, lat, p0 + (tid >> 3)) * 4096 + SC_MV + ocol + (tid & 7) * 4);
    const int gi = dir ? 2 : 0; const size_t row = (size_t)ml_row(b, lat, p0 + lane);
    pf.gi = SMALL[row * 64 + 32 + 4 * gi + h]; pf.gf = SMALL[row * 64 + 32 + 4 * (gi + 1) + h];
}
__device__ __forceinline__ void ml_piece(LAS unsigned char* L, const v4u q, const v4u k, const int tok, const int c16) {
    *(LAS v4u*)(L + SL_AQ + tok * ST_AQ + c16 * 16) = q; *(LAS v4u*)(L + SL_AK + tok * ST_AQ + c16 * 16) = k;
}
__device__ __forceinline__ void mlstm_substep(LAS unsigned char* L, const bf16* SIN, const float* __restrict__ SMALL, bf16* OUT, const float bgi, const float bgf,
                                              const int dir, const int b, const int chunk, const bool lat, const bool rmw, const int ocol, const int h, f32x4 (&C)[3], float& mrun, MlPF& pf,
                                              const int nchunk, const bool nlat, const int ndir, const int tid, const int w, const int lane) {
    const int l15 = lane & 15, quad = lane >> 4;
    const int row0 = lat ? b * SEQ + chunk : ML + b * CTXL + chunk * 64;
    LAS float* Fp = (LAS float*)(L + SL_F);
    { const int tok0 = tid >> 4, c16 = tid & 15; ml_piece(L, pf.q0, pf.k0, tok0, c16); ml_piece(L, pf.q1, pf.k1, tok0 + 32, c16); }
    const v2u myv = pf.v;
    stage_v(L, myv, tid);
    if (w == 0) {
        const float li = pf.gi + bgi, lf = logsig_f(pf.gf + bgf);
        float x = lf;
#pragma unroll
        for (int o = 1; o < 64; o <<= 1) { const float y = __shfl_up(x, o); if (lane >= o) x += y; }
        const float total = __shfl(x, 63);
        const float bv = dir == 0 ? x : total - x + lf;
        const float av = li - bv;
        float xm = av;
        if (dir == 0) {
#pragma unroll
            for (int o = 1; o < 64; o <<= 1) { const float y = __shfl_up(xm, o); if (lane >= o) xm = fmaxf(xm, y); }
        } else {
#pragma unroll
            for (int o = 1; o < 64; o <<= 1) { const float y = __shfl_down(xm, o); if (lane + o < 64) xm = fmaxf(xm, y); }
        }
        const float Mall = __shfl(xm, dir == 0 ? 63 : 0);
        const float m = mrun;
        const float mq = bv + fmaxf(m, xm);
        const float mnew = total + fmaxf(m, Mall);
        Fp[lane] = bv - mq;
        Fp[64 + lane] = av;
        Fp[128 + lane] = fexp(-mq);
        Fp[192 + lane] = fexp(bv + m - mq);
        Fp[256 + lane] = fexp(total + av - mnew);
        if (lane == 0) Fp[320] = fexp(total + m - mnew);
        mrun = mnew;
    }
    bf16* const optr = OUT + (size_t)(row0 + (size_t)((w >> 1) * 16 + l15) * (lat ? 64 : 1)) * 1024 + ocol + (w & 1) * 16 + quad * 4;
    ml_issue(pf, SIN, SMALL, b, nchunk, nlat, ndir, h, ocol, tid, lane);
    SBAR();
    {
        const int tok = tid >> 3, dvq = (tid & 7) * 4; const float wk = Fp[256 + tok];
        LAS unsigned char* p = L + SL_VW + dvq * ST_KT + tok * 2;
        st_lds16(p, bf_lo(myv.x) * wk); st_lds16(p + ST_KT, bf_hi(myv.x) * wk); st_lds16(p + 2 * ST_KT, bf_lo(myv.y) * wk); st_lds16(p + 3 * ST_KT, bf_hi(myv.y) * wk);
        if (tid < 64) st_lds16(L + SL_VW + 32 * ST_KT + tid * 2, Fp[256 + tid]);
    }
    if (lat) {
        f32x4 sc[2]; scores2(L, w, l15, quad, sc);
        const int l = (w >> 1) * 16 + l15; const float rowt = Fp[l];
#pragma unroll
        for (int mi = 0; mi < 2; ++mi) { const int m0 = ((w & 1) * 2 + mi) * 16 + quad * 4; f32x4 v = sc[mi]; const f32x4 av = *(const LAS f32x4*)(Fp + 64 + m0);
#pragma unroll
            for (int r = 0; r < 4; ++r) { const bool keep = dir == 0 ? (m0 + r <= l) : (m0 + r >= l); v[r] = keep ? v[r] * fexp(rowt + av[r]) : 0.f; }
            *(LAS unsigned long long*)(L + SL_PM + l * ST_KT + m0 * 2) = pack4(v); }
    }
    SBAR();
    {
        bf16x8 kf[2], vf[3][2];
#pragma unroll
        for (int ks = 0; ks < 2; ++ks) { kf[ks] = ldkt(L, 16 * w, ks, l15, quad);
#pragma unroll
            for (int dvt = 0; dvt < 3; ++dvt) vf[dvt][ks] = ldf(L + SL_VW, dvt * 16 + l15, ST_KT, ks * 64 + quad * 16); }
        const float decay = Fp[320];
        if (lat) {
            const int dvo = w & 1, tt = w >> 1; bf16x8 pm[2], va[2], vd[2], aq[4], sa[4], sd[4];
#pragma unroll
            for (int ks = 0; ks < 2; ++ks) { pm[ks] = ldf(L + SL_PM, tt * 16 + l15, ST_KT, ks * 64 + quad * 16); va[ks] = ldf(L + SL_VT, dvo * 16 + l15, ST_KT, ks * 64 + quad * 16); vd[ks] = ldf(L + SL_VT, 32 + l15, ST_KT, ks * 64 + quad * 16); }
#pragma unroll
            for (int ks = 0; ks < 4; ++ks) { aq[ks] = ldf(L + SL_AQ, tt * 16 + l15, ST_AQ, ks * 64 + quad * 16); sa[ks] = ldf(L + SL_ST + dir * ST_DIR, dvo * 16 + l15, ST_AQ, ks * 64 + quad * 16); sd[ks] = ldf(L + SL_ST + dir * ST_DIR, 32 + l15, ST_AQ, ks * 64 + quad * 16); }
            const int tok = tt * 16 + l15; const float wi = Fp[192 + tok], flo = Fp[128 + tok];
            __builtin_amdgcn_sched_barrier(0);
            f32x4 n1 = {0.f, 0.f, 0.f, 0.f}, n2 = n1, d1 = n1, d2 = n1;
#pragma unroll
            for (int ks = 0; ks < 2; ++ks) { n1 = MMA16(va[ks], pm[ks], n1); d1 = MMA16(vd[ks], pm[ks], d1); }
#pragma unroll
            for (int ks = 0; ks < 4; ++ks) { n2 = MMA16(sa[ks], aq[ks], n2); d2 = MMA16(sd[ks], aq[ks], d2); }
            const float denl = d1[0] + wi * d2[0]; const float den = __shfl(denl, l15);
            const float inv = __builtin_amdgcn_rcpf(fmaxf(fabsf(den), flo));
            f32x4 hv = (n1 + n2 * wi) * inv;
            unsigned long long oldv = 0ull;
            if (rmw) oldv = __hip_atomic_load((unsigned long long*)optr, RLX_AGENT);
            out4(optr, hv, rmw, oldv);
        }
#pragma unroll
        for (int dvt = 0; dvt < 3; ++dvt) { f32x4 a4 = C[dvt] * decay;
#pragma unroll
            for (int ks = 0; ks < 2; ++ks) a4 = MMA16(kf[ks], vf[dvt][ks], a4);
            C[dvt] = a4; }
    }
    SBAR();
#pragma unroll
    for (int dvt = 0; dvt < 3; ++dvt) *(LAS unsigned long long*)(L + SL_ST + dir * ST_DIR + (dvt * 16 + l15) * ST_AQ + (16 * w + quad * 4) * 2) = pack4(C[dvt]);
}
__device__ __forceinline__ void scan_mlstm(Frame& F, const int b, const int h, const int slice) {
    LAS unsigned char* L = F.lds; const int tid = F.tid, w = F.wave, lane = F.lane;
    for (int i = tid; i < 16 * 72; i += 512) { const int r = i / 72; *(LAS unsigned short*)(L + SL_VT + 32 * ST_KT + i * 2) = r == 0 ? (unsigned short)0x3F80 : (unsigned short)0;
        *(LAS unsigned short*)(L + SL_VW + 32 * ST_KT + i * 2) = (unsigned short)0; }
    for (int i = tid; i < 2 * ST_DIR / 4; i += 512) ((LAS unsigned*)(L + SL_ST))[i] = 0u;
    f32x4 Cf[3], Cb[3];
#pragma unroll
    for (int i = 0; i < 3; ++i) { Cf[i] = (f32x4){0.f, 0.f, 0.f, 0.f}; Cb[i] = (f32x4){0.f, 0.f, 0.f, 0.f}; }
    float mf = 0.f, mb = 0.f;
    const float bg0i = F.b_gate[0 * 4 + h], bg0f = F.b_gate[1 * 4 + h], bg1i = F.b_gate[2 * 4 + h], bg1f = F.b_gate[3 * 4 + h];
    const int ocol = 256 * h + 32 * slice; bf16* OUT = (bf16*)F.out + (size_t)ML * D;
    MlPF pf; ml_issue(pf, F.SIN, F.SMALL, b, 0, false, 0, h, ocol, tid, lane);
    SBAR();
    for (int step = 0; step < 68; ++step) {
        const bool lat = step >= 4;
        const int cf = lat ? step - 4 : step, cb = lat ? 67 - step : 3 - step;
        const int ns = step < 67 ? step + 1 : 67; const bool nlat = ns >= 4; const int ncf = nlat ? ns - 4 : ns;
        mlstm_substep(L, F.SIN, F.SMALL, OUT, bg0i, bg0f, 0, b, cf, lat, lat && cf >= 32, ocol, h, Cf, mf, pf, cb, lat, 1, tid, w, lane);
        mlstm_substep(L, F.SIN, F.SMALL, OUT, bg1i, bg1f, 1, b, cb, lat, lat && cb <= 31, ocol, h, Cb, mb, pf, ncf, nlat, 0, tid, w, lane);
        if (step == 35) { VM_WAIT(); SBAR(); }
    }
    VM_WAIT(); SBAR();
}
struct MergeOrder {
    int pm, pn; bool valid;
    __device__ __forceinline__ bool next(int i, pg8::Unit& u) const {
        if (!valid || i >= 4) return false;
        u.pm = pm + (i == 0 ? 68 : (i == 2 ? 132 : 0));
        u.pn = pn + (i == 0 ? WT_BR1 : (i == 1 ? WT_MRG1 : (i == 2 ? WT_BR2 : WT_MRG2)));
        return true;
    }
    __device__ __forceinline__ void a_ready(const pg8::Unit&) const {}
    __device__ __forceinline__ void done(const pg8::Unit&) const {}
};

struct Args { const float* in[22]; float* out; unsigned char* ws; int ph_lo, ph_hi, li, pad; };
__global__ void __launch_bounds__(NWAVES * 64, 2) mk_fwd(Args args) {
    extern __shared__ __attribute__((aligned(16))) unsigned char lds[];
    Frame F;
    F.lds = (LAS unsigned char*)lds;
    F.MISC = (volatile LAS unsigned*)(F.lds + MISC_OFF);
    F.tid = threadIdx.x; F.lane = F.tid & 63; F.wave = __builtin_amdgcn_readfirstlane(F.tid >> 6);
    F.G = gridDim.x; { const int bx = blockIdx.x; F.vcu = (F.G % 8 == 0) ? (bx % 8) * (F.G / 8) + bx / 8 : bx; }
    unsigned char* ws = args.ws;
    F.ctl = (gu32*)(ws + WS_CTL);
    F.x = args.in[0]; F.c = args.in[1]; F.ctx = args.in[2]; F.cctx = args.in[3]; F.w_ada = args.in[4]; F.b_ada = args.in[5]; F.norm1_g = args.in[6]; F.w_in = args.in[7];
    F.w_up = args.in[8]; F.b_dec = args.in[9]; F.gla_g = args.in[10]; F.conv_w = args.in[11]; F.conv_b = args.in[12]; F.b_gate = args.in[13]; F.mlstm_g = args.in[14];
    F.w_br1 = args.in[15]; F.w_br2 = args.in[16]; F.w_out = args.in[17]; F.norm2_g = args.in[18]; F.w_f1 = args.in[19]; F.w_f2 = args.in[20]; F.final_g = args.in[21];
    F.out = args.out;
    F.WT = (bf16*)(ws + WS_WT); F.W2T = (bf16*)(ws + WS_W2T); F.XN = (bf16*)(ws + WS_XN); F.Y1 = (bf16*)(ws + WS_Y1); F.Y2 = (bf16*)(ws + WS_Y2); F.SIN = (bf16*)(ws + WS_SIN);
    F.Y = (bf16*)(ws + WS_Y); F.HF = (bf16*)(ws + WS_HF); F.SMALL = (float*)(ws + WS_SMALL); F.T2 = (float*)(ws + WS_T2); F.EB = (bf16*)(ws + WS_EB); F.ET = (float*)(ws + WS_ET); F.HALO = (bf16*)(ws + WS_HALO);
    F.MOD = (float*)(ws + WS_CTL + CTL_MOD); F.SS1 = (float*)(ws + WS_CTL + CTL_SS1); F.SS2 = (float*)(ws + WS_CTL + CTL_SS2);
    for (int u = F.tid; u < (LDS_BYTES - LDSCTL_OFF) / 4; u += NWAVES * 64) ((LAS unsigned*)(F.lds + LDSCTL_OFF))[u] = 0u;
    __syncthreads();
    XcdBarrier bar; bar.bar = (unsigned*)(F.ctl + CW_BAR); bar.x = 0; bar.st = nullptr;
    if (N_LAUNCHES != PER_PHASE) bar = xcd_barrier_post((unsigned*)(F.ctl + CW_BAR), F.MISC + 8);
#define GRID_BAR(seam) do { if (N_LAUNCHES == PER_PHASE) { if (F.tid == 0) __hip_atomic_store(F.ctl + CW_TMO, 0xBADBA0u | (unsigned)(seam), RLX_AGENT); } else { xcd_barrier(bar); } } while (0)
    const int lo = args.ph_lo, hi = args.ph_hi;
#define IN(k) (lo <= (k) && (k) < hi)
#define BOTH(k) (IN(k) && IN((k) + 1))
    const int gw = F.vcu * NWAVES + F.wave, NGW = F.G * NWAVES;

    if (IN(0)) { p0_prologue(F); if (BOTH(0)) GRID_BAR(0); }

    if (IN(1)) for (int rep = 0; rep <= ((MK_DUP >> 1) & 1); ++rep) { if (rep) GRID_BAR(100 + 1);
        for (int m = gw; m < MT; m += NGW) {
            const float* src = m < ML ? F.x + (size_t)m * D : F.ctx + (size_t)(m - ML) * D;
            const float* mod = F.MOD + (size_t)(m < ML ? (m >> 12) : 4) * 6144;
            norm_mod_row(F, src, -1.f, F.norm1_g, mod, mod + D, F.XN + (size_t)m * D);
        }
        if (rep == ((MK_DUP >> 1) & 1) && BOTH(1)) GRID_BAR(1);
    }

    if (IN(2)) for (int rep = 0; rep <= ((MK_DUP >> 2) & 1); ++rep) { if (rep) GRID_BAR(100 + 2);
        pg8::Gemm g{F.XN, F.WT, MT, 17 * 256, D}; pg8::StaticOrder S; S.init(MT, 17 * 256, F.G, (int)blockIdx.x);
        pg8::EpiScanIn E{F.SIN, F.SMALL};
        pg8::gemm_phase<pg8::EpiScanIn, pg8::StaticOrder, true, true>(F.lds + RING_OFF, g, S, E);
        if (rep == ((MK_DUP >> 2) & 1) && BOTH(2)) GRID_BAR(2);
    }

    if (IN(3)) {
        for (int it = F.vcu; it < 1088; it += F.G) pre_gla_item(F, it);
        for (int it = gw; it < 544; it += NGW) pre_halo_item(F, it);
        GRID_BAR(30);
        for (int it = F.vcu; it < 272; it += F.G) pre_conv_item(F, it);
        GRID_BAR(31);
        for (int rep = 0; rep <= ((MK_DUP >> 3) & 1); ++rep) {
            if (rep) GRID_BAR(103);
            for (int u = F.vcu; u < 256; u += F.G) {
                const int mixer = u >> 7, bh = (u >> 3) & 15, b = bh >> 2, h = bh & 3, slice = u & 7;
                const bool xpass = ((MK_DUP >> 3) & 1) && rep == 0;
                if (xpass && mixer != MK_DUPSEL) continue;
                if (mixer == 0) scan_gla(F, b, h, slice, xpass); else scan_mlstm(F, b, h, slice);
            }
        }
        if (BOTH(3)) GRID_BAR(3);
    }

    if (IN(4)) for (int rep = 0; rep <= ((MK_DUP >> 4) & 1); ++rep) { if (rep) GRID_BAR(100 + 4);
        pg8::Gemm g{F.XN, F.WT + (size_t)WT_OG * 256 * D, ML, 2048, D}; pg8::StaticOrder S; S.init(ML, 2048, F.G, (int)blockIdx.x);
        pg8::EpiOutGate E{(const bf16*)F.out, (const bf16*)F.out + (size_t)ML * D, F.gla_g, F.mlstm_g, F.Y1, F.Y2, (LAS float*)(F.lds + EPI_ST_OFF)};
        pg8::gemm_phase<pg8::EpiOutGate, pg8::StaticOrder, true, true>(F.lds + RING_OFF, g, S, E);
        if (rep == ((MK_DUP >> 4) & 1) && BOTH(4)) GRID_BAR(4);
    }

    if (IN(5)) for (int rep = 0; rep <= ((MK_DUP >> 5) & 1); ++rep) { if (rep) GRID_BAR(100 + 5);
        pg8::StaticOrder SO; SO.init(ML, D, F.G, (int)blockIdx.x);
        pg8::Gemm g{F.XN, F.WT, MT + 2 * ML, WT_TILES * 256, D};
        pg8::EpiMerge E{F.out, F.T2, F.Y};
        for (int r = 0;; ++r) { pg8::Unit t; MergeOrder S; S.valid = SO.next(r, t); if (!S.valid) break; S.pm = t.pm; S.pn = t.pn;
            pg8::gemm_phase<pg8::EpiMerge, MergeOrder, true, true>(F.lds + RING_OFF, g, S, E); }
        if (rep == ((MK_DUP >> 5) & 1) && BOTH(5)) GRID_BAR(5);
    }

    if (IN(6)) {
        pg8::Gemm g{F.Y, F.WT + (size_t)WT_OUT * 256 * D, ML, D, D}; pg8::StaticOrder S; S.init(ML, D, F.G, (int)blockIdx.x);
        pg8::EpiResid E{F.x, F.out, F.MOD, 2, F.SS1};
        pg8::gemm_phase<pg8::EpiResid, pg8::StaticOrder, true, true>(F.lds + RING_OFF, g, S, E);
        if (BOTH(6)) GRID_BAR(6);
    }

    if (IN(7)) {
        for (int m = gw; m < ML; m += NGW) {
            const float* mod = F.MOD + (size_t)(m >> 12) * 6144;
            const float ss = __hip_atomic_load(F.SS1 + m, RLX_AGENT);
            norm_mod_row(F, F.out + (size_t)m * D, ss, F.norm2_g, mod + 3 * D, mod + 4 * D, F.XN + (size_t)m * D);
        }
        if (BOTH(7)) GRID_BAR(7);
    }

    if (IN(8)) for (int rep = 0; rep <= ((MK_DUP >> 8) & 1); ++rep) { if (rep) GRID_BAR(100 + 8);
        pg8::Gemm g{F.XN, F.WT + (size_t)WT_FFN1 * 256 * D, ML, 2 * DFF, D}; pg8::StaticOrder S; S.init(ML, 2 * DFF, F.G, (int)blockIdx.x);
        pg8::EpiSwiglu E{F.HF};
        pg8::gemm_phase<pg8::EpiSwiglu, pg8::StaticOrder, true, true>(F.lds + RING_OFF, g, S, E);
        if (rep == ((MK_DUP >> 8) & 1) && BOTH(8)) GRID_BAR(8);
    }

    if (IN(9)) {
        pg8::Gemm g{F.HF, F.W2T, ML, D, DFF}; pg8::StaticOrder S; S.init(ML, D, F.G, (int)blockIdx.x);
        pg8::EpiResid E{F.out, F.out, F.MOD, 5, F.SS2};
        pg8::gemm_phase<pg8::EpiResid, pg8::StaticOrder, true, true>(F.lds + RING_OFF, g, S, E);
        if (BOTH(9)) GRID_BAR(9);
    }

    if (IN(10)) {
        for (int m = gw; m < ML; m += NGW) {
            const float ss = __hip_atomic_load(F.SS2 + m, RLX_AGENT);
            const float rstd = 1.f / sqrtf(ss * (1.f / D) + RMS_EPS);
            GAS f32x4* xr = (GAS f32x4*)(F.out + (size_t)m * D) + F.lane;
#pragma unroll
            for (int j = 0; j < 4; ++j) { const f32x4 gv = ((const GAS f32x4*)F.final_g)[F.lane + 64 * j]; xr[64 * j] = xr[64 * j] * rstd * gv; }
        }
    }
#undef IN
#undef BOTH
}

extern "C" void kernel_launch(void* const* d_in, const int* in_sizes, int n_in, void* d_out, int out_size, void* d_ws, size_t ws_size, hipStream_t stream) {
    static int grid = 0;
    if (grid == 0) {
        if (n_in != 22 || in_sizes[0] != ML * D || out_size != ML * D || ws_size < WS_END) { fprintf(stderr, "kernel_launch: unexpected shapes (n_in %d, in0 %d, out %d, ws %zu)\n", n_in, n_in > 0 ? in_sizes[0] : -1, out_size, ws_size); grid = -1; return; }
        int dev = 0, cus = 0;
        if (hipGetDevice(&dev) != hipSuccess || hipDeviceGetAttribute(&cus, hipDeviceAttributeMultiprocessorCount, dev) != hipSuccess) { grid = -1; return; }
        if (hipFuncSetAttribute((const void*)mk_fwd, hipFuncAttributeMaxDynamicSharedMemorySize, LDS_BYTES) != hipSuccess) { fprintf(stderr, "kernel_launch: hipFuncSetAttribute failed\n"); grid = -1; return; }
        int per_cu = 0;
        if (hipOccupancyMaxActiveBlocksPerMultiprocessor(&per_cu, (const void*)mk_fwd, NWAVES * 64, LDS_BYTES) != hipSuccess || per_cu < 1) fprintf(stderr, "kernel_launch: occupancy query reports %d\n", per_cu);
        (void)hipGetLastError();
        grid = cus;
    }
    if (grid < 0) return;
    if (hipMemsetAsync((char*)d_ws + WS_CTL, 0, CTL_ZERO_BYTES, stream) != hipSuccess) return;
    Args a{};
    for (int i = 0; i < 22; ++i) a.in[i] = (const float*)d_in[i];
    a.out = (float*)d_out; a.ws = (unsigned char*)d_ws;
    for (int li = 0; li < N_LAUNCHES; ++li) {
        a.ph_lo = (N_LAUNCHES == PER_PHASE) ? li : 0; a.ph_hi = (N_LAUNCHES == PER_PHASE) ? li + 1 : PER_PHASE; a.li = li;
        hipLaunchKernelGGL(mk_fwd, dim3(grid), dim3(NWAVES * 64), LDS_BYTES, stream, a);
    }
}
```

```cpp
#include <hip/hip_runtime.h>
#include <cstdio>
#include <cstdint>
#ifndef MK_N_LAUNCHES
#define MK_N_LAUNCHES 1
#endif
#ifndef MK_PROBE
#define MK_PROBE 2
#endif
#ifndef MK_DUPSEL
#define MK_DUPSEL 0
#endif
#ifndef MK_DUP
#define MK_DUP 0
#endif
namespace pg8 {
#define PG8_LAS __attribute__((address_space(3)))
typedef unsigned short bf16_t;
typedef short bf16x8 __attribute__((ext_vector_type(8)));
typedef float f32x4 __attribute__((ext_vector_type(4)));
typedef unsigned u32x4 __attribute__((ext_vector_type(4)));
constexpr int BM = 256, BK = 64, HALF = 128, HTB = HALF * BK * 2  , STAGE_BYTES = 8 * HTB, NXCD = 8, WGM = 8;

__host__ __device__ __forceinline__ int lds_byte(int r, int c) { const int st = (r >> 4) * 2 + (c >> 5), rr = r & 15, cc = c & 31, ob = rr * 64 + cc * 2; return st * 1024 + (ob ^ (((ob >> 9) & 1) << 5)); }
__host__ __device__ __forceinline__ void stage_rc(int b, int& R, int& C) { const int st = b / 1024, sb = b % 1024, swz = sb ^ (((sb >> 9) & 1) << 5); R = (st >> 1) * 16 + swz / 64; C = (st & 1) * 32 + (swz % 64) / 2; }
__host__ __device__ __forceinline__ int perm32(int rho) { const int n = rho >> 4, i = rho & 15; return 8 * (i >> 2) + 4 * n + (i & 3); }

struct Unit { int pm, pn; };
struct Gemm { const bf16_t* A; const bf16_t* Bt; int M, N, K; };

struct StaticOrder {
    int nM, nN, nwg, G, c;
    __host__ __device__ void init(int M, int N, int G_, int c_) { nM = M / BM; nN = N / BM; nwg = nM * nN; G = G_; c = c_; }
    __host__ __device__ bool next(int i, Unit& u) const {
        const long L = (long)i * G + c; if (L >= nwg) return false;
        int wgid = (int)L; { const int q = nwg / NXCD, r = nwg % NXCD, xcd = wgid % NXCD, off = wgid / NXCD; wgid = (xcd < r ? xcd * (q + 1) : r * (q + 1) + (xcd - r) * q) + off; }
        const int nig = WGM * nN, gid = wgid / nig, fm = gid * WGM, gsz = (nM - fm) < WGM ? (nM - fm) : WGM;
        u.pm = fm + ((wgid % nig) % gsz); u.pn = (wgid % nig) / gsz; return true;
    }
    __device__ __forceinline__ void a_ready(const Unit&) const {}
    __device__ __forceinline__ void done(const Unit&) const {}
};

typedef float f32x2c __attribute__((ext_vector_type(2))); typedef __bf16 bf16x2c __attribute__((ext_vector_type(2)));
__device__ __forceinline__ unsigned cvt_pk_bf16(float lo, float hi) { const f32x2c v = {lo, hi}; const bf16x2c b = __builtin_convertvector(v, bf16x2c); return __builtin_bit_cast(unsigned, b); }
typedef float f32x2 __attribute__((ext_vector_type(2)));
__device__ __forceinline__ float sigm_f(float x) { return __builtin_amdgcn_rcpf(1.f + __expf(-x)); }
__device__ __forceinline__ float silu_f(float x) { return x * sigm_f(x); }
__device__ __forceinline__ float bf_lo(unsigned w) { return __uint_as_float(w << 16); }
__device__ __forceinline__ float bf_hi(unsigned w) { return __uint_as_float(w & 0xffff0000u); }
__device__ __forceinline__ u32x4 pack8(const f32x4& a, const f32x4& b) { u32x4 w; w.x = cvt_pk_bf16(a[0], a[1]); w.y = cvt_pk_bf16(a[2], a[3]); w.z = cvt_pk_bf16(b[0], b[1]); w.w = cvt_pk_bf16(b[2], b[3]); return w; }

struct EpiScanIn {
    static constexpr bool PERM = true, AFTER_DRAIN = false;
    bf16_t* SIN; float* SMALL;
    __device__ __forceinline__ void operator()(const f32x4 (&acc)[2][2][4][2], const Unit& u, int wr, int wc, int fr, int fq) const {
        const int row0 = u.pm * BM + wr * 64 + fr;
        if (u.pn < 16) {
#pragma unroll
            for (int ai = 0; ai < 2; ++ai)
#pragma unroll
                for (int m = 0; m < 4; ++m) { bf16_t* rowp = SIN + (size_t)(row0 + ai * HALF + m * 16) * 4096 + u.pn * BM + wc * 32 + 8 * fq;
#pragma unroll
                    for (int bj = 0; bj < 2; ++bj) *(u32x4*)(rowp + bj * HALF) = pack8(acc[ai][bj][m][0], acc[ai][bj][m][1]); }
        } else if (wc < 2) {
#pragma unroll
            for (int ai = 0; ai < 2; ++ai)
#pragma unroll
                for (int m = 0; m < 4; ++m) { float* p = SMALL + (size_t)(row0 + ai * HALF + m * 16) * 64 + wc * 32 + 8 * fq;
                    *(f32x4*)p = acc[ai][0][m][0]; *(f32x4*)(p + 4) = acc[ai][0][m][1]; }
        }
    }
};

struct EpiOutGate {
    static constexpr bool PERM = true, AFTER_DRAIN = false;
    const bf16_t* OHo; const bf16_t* OHh; const float* gg; const float* mg; bf16_t* Y1; bf16_t* Y2; PG8_LAS float* st;
    __device__ __forceinline__ void operator()(const f32x4 (&acc)[2][2][4][2], const Unit& u, int wr, int wc, int fr, int fq) const {
        const bool isg = u.pn < 4; const int head = u.pn & 3;
        const bf16_t* src = (isg ? OHo : OHh) + head * 256; const float* gain = (isg ? gg : mg) + head * 256; bf16_t* dst = (isg ? Y1 : Y2) + head * 256;
        const int row0 = u.pm * BM + wr * 64 + fr, cb = wc * 32 + 8 * fq;
#pragma unroll
        for (int ai = 0; ai < 2; ++ai)
#pragma unroll
            for (int m = 0; m < 4; ++m) { float s = 0.f; const bf16_t* rp = src + (size_t)(row0 + ai * HALF + m * 16) * 1024 + cb;
#pragma unroll
                for (int bj = 0; bj < 2; ++bj) { const u32x4 w = *(const u32x4*)(rp + bj * HALF);
                    float a; a = bf_lo(w.x); s += a * a; a = bf_hi(w.x); s += a * a; a = bf_lo(w.y); s += a * a; a = bf_hi(w.y); s += a * a;
                    a = bf_lo(w.z); s += a * a; a = bf_hi(w.z); s += a * a; a = bf_lo(w.w); s += a * a; a = bf_hi(w.w); s += a * a; }
                s += __shfl_xor(s, 16); s += __shfl_xor(s, 32);
                if (fq == 0) st[(ai * HALF + wr * 64 + m * 16 + fr) * 4 + wc] = s; }
        asm volatile("s_waitcnt lgkmcnt(0)" ::: "memory"); __builtin_amdgcn_s_barrier(); asm volatile("" ::: "memory");
        f32x4 g8[2][2];
#pragma unroll
        for (int bj = 0; bj < 2; ++bj) { g8[bj][0] = *(const f32x4*)(gain + cb + bj * HALF); g8[bj][1] = *(const f32x4*)(gain + cb + bj * HALF + 4); }
#pragma unroll
        for (int ai = 0; ai < 2; ++ai)
#pragma unroll
            for (int m = 0; m < 4; ++m) { const int rl = ai * HALF + wr * 64 + m * 16 + fr; const f32x4 t = *(const PG8_LAS f32x4*)(st + rl * 4);
                const float rstd = __builtin_amdgcn_rsqf(((t[0] + t[1]) + (t[2] + t[3])) * (1.f / 256.f) + 1e-6f);
                const bf16_t* rp = src + (size_t)(row0 + ai * HALF + m * 16) * 1024 + cb; bf16_t* dp = dst + (size_t)(row0 + ai * HALF + m * 16) * 1024 + cb;
#pragma unroll
                for (int bj = 0; bj < 2; ++bj) { const u32x4 w = *(const u32x4*)(rp + bj * HALF);
                    f32x4 o0 = {bf_lo(w.x), bf_hi(w.x), bf_lo(w.y), bf_hi(w.y)}, o1 = {bf_lo(w.z), bf_hi(w.z), bf_lo(w.w), bf_hi(w.w)};
                    f32x4 a0 = acc[ai][bj][m][0], a1 = acc[ai][bj][m][1];
#pragma unroll
                    for (int e = 0; e < 4; ++e) { a0[e] = isg ? silu_f(a0[e]) : sigm_f(a0[e]); a1[e] = isg ? silu_f(a1[e]) : sigm_f(a1[e]); }
                    o0 = o0 * rstd * g8[bj][0] * a0; o1 = o1 * rstd * g8[bj][1] * a1;
                    *(u32x4*)(dp + bj * HALF) = pack8(o0, o1); } }
        asm volatile("s_waitcnt lgkmcnt(0)" ::: "memory"); __builtin_amdgcn_s_barrier(); asm volatile("" ::: "memory");
    }
};

struct EpiMerge {
    static constexpr bool PERM = true, AFTER_DRAIN = false;
    float* T; float* T2; bf16_t* Y;
    __device__ __forceinline__ void operator()(const f32x4 (&acc)[2][2][4][2], const Unit& u, int wr, int wc, int fr, int fq) const {
        const int step = u.pn >= 37 ? 2 : (u.pn >= 33 ? 0 : (u.pn >= 29 ? 3 : 1));
        const int opm = u.pm - (step == 0 ? 68 : (step == 2 ? 132 : 0)), opn = (u.pn - 25) & 3;
        const size_t tb = ((size_t)(opm * 4 + opn) * 32) * 512 + threadIdx.x;
        f32x4* t = (f32x4*)T + tb; f32x4* t2 = (f32x4*)T2 + tb;
        const int row0 = opm * BM + wr * 64 + fr, cb = opn * BM + wc * 32 + 8 * fq;
#pragma unroll
        for (int ai = 0; ai < 2; ++ai)
#pragma unroll
            for (int m = 0; m < 4; ++m)
#pragma unroll
                for (int bj = 0; bj < 2; ++bj) {
                    const int j0 = ((ai * 2 + bj) * 4 + m) * 2;
                    if (step == 0) { t[(size_t)j0 * 512] = acc[ai][bj][m][0]; t[(size_t)(j0 + 1) * 512] = acc[ai][bj][m][1]; }
                    else if (step == 2) { t2[(size_t)j0 * 512] = acc[ai][bj][m][0]; t2[(size_t)(j0 + 1) * 512] = acc[ai][bj][m][1]; }
                    else {
                        f32x4 s0 = acc[ai][bj][m][0], s1 = acc[ai][bj][m][1];
#pragma unroll
                        for (int e = 0; e < 4; ++e) { s0[e] = sigm_f(s0[e]); s1[e] = sigm_f(s1[e]); }
                        if (step == 1) { t[(size_t)j0 * 512] = t[(size_t)j0 * 512] * s0; t[(size_t)(j0 + 1) * 512] = t[(size_t)(j0 + 1) * 512] * s1; }
                        else { const f32x4 y0 = t[(size_t)j0 * 512] + t2[(size_t)j0 * 512] * s0, y1 = t[(size_t)(j0 + 1) * 512] + t2[(size_t)(j0 + 1) * 512] * s1;
                            *(u32x4*)(Y + (size_t)(row0 + ai * HALF + m * 16) * 1024 + cb + bj * HALF) = pack8(y0, y1); }
                    }
                }
    }
};

struct EpiResid {
    static constexpr bool PERM = false, AFTER_DRAIN = false;
    const float* base; float* out; const float* mod; int gidx; float* ss;
    __device__ __forceinline__ void operator()(const f32x4 (&acc)[2][2][4][2], const Unit& u, int wr, int wc, int fr, int fq) const {
        const float* gate = mod + (size_t)(u.pm >> 4) * 6144 + gidx * 1024;
        const int row0 = u.pm * BM + wr * 64 + fr, col0 = u.pn * BM + wc * 32 + 4 * fq;
        f32x4 gv[2][2];
#pragma unroll
        for (int bj = 0; bj < 2; ++bj)
#pragma unroll
            for (int n = 0; n < 2; ++n) gv[bj][n] = *(const f32x4*)(gate + col0 + bj * HALF + n * 16);
#pragma unroll
        for (int ai = 0; ai < 2; ++ai)
#pragma unroll
            for (int m = 0; m < 4; ++m) { const int row = row0 + ai * HALF + m * 16; const size_t off = (size_t)row * 1024 + col0; float s = 0.f;
#pragma unroll
                for (int bj = 0; bj < 2; ++bj)
#pragma unroll
                    for (int n = 0; n < 2; ++n) { const f32x4 xv = *(const f32x4*)(base + off + bj * HALF + n * 16); const f32x4 o = xv + gv[bj][n] * acc[ai][bj][m][n];
                        *(f32x4*)(out + off + bj * HALF + n * 16) = o; s += (o[0] * o[0] + o[1] * o[1]) + (o[2] * o[2] + o[3] * o[3]); }
                s += __shfl_xor(s, 16); s += __shfl_xor(s, 32);
                if (fq == 0) atomicAdd(ss + row, s); }
    }
};

struct EpiSwiglu {
    static constexpr bool PERM = true, AFTER_DRAIN = false;
    bf16_t* Hf;
    __device__ __forceinline__ void operator()(const f32x4 (&acc)[2][2][4][2], const Unit& u, int wr, int wc, int fr, int fq) const {
        const int row0 = u.pm * BM + wr * 64 + fr, cb = u.pn * HALF + wc * 32 + 8 * fq;
#pragma unroll
        for (int ai = 0; ai < 2; ++ai)
#pragma unroll
            for (int m = 0; m < 4; ++m) { f32x4 h0 = acc[ai][0][m][0], h1 = acc[ai][0][m][1];
#pragma unroll
                for (int e = 0; e < 4; ++e) { h0[e] = silu_f(h0[e]) * acc[ai][1][m][0][e]; h1[e] = silu_f(h1[e]) * acc[ai][1][m][1][e]; }
                *(u32x4*)(Hf + (size_t)(row0 + ai * HALF + m * 16) * 2816 + cb) = pack8(h0, h1); }
    }
};
template <class Epi, class Sched, bool ALIGN_EPI = false, bool SP2 = false>
__device__ __forceinline__ void gemm_phase(PG8_LAS unsigned char* lds, const Gemm g, const Sched& S, const Epi& E) {
    const int tid = threadIdx.x, wid = __builtin_amdgcn_readfirstlane(tid >> 6), lane = tid & 63, wr = wid >> 2, wc = wid & 3, fr = lane & 15, fq = lane >> 4;
    const int K = g.K, nt = K / BK;
    unsigned voffA[2], voffB[2];
#pragma unroll
    for (int i = 0; i < 2; ++i) { int R, C; stage_rc(tid * 16 + i * 8192, R, C); const int Rb = Epi::PERM ? ((R & ~31) + perm32(R & 31)) : R;
        voffA[i] = (unsigned)(R * K + C) * 2u; voffB[i] = (unsigned)(Rb * K + C) * 2u; }
    const size_t kstep = (size_t)(BK * 2);
    const size_t hstep = (size_t)HALF * K * 2;
    const size_t tstep = 2 * hstep;
    const unsigned ldsw = (unsigned)wid * 1024u;
    const int aoff = lds_byte(wr * 64 + fr, fq * 8), boff = lds_byte(wc * 32 + fr, fq * 8);
#define PG8_SA(b, h) (((b) * 2 + (h)) * HTB)
#define PG8_SB(b, h) ((4 + (b) * 2 + (h)) * HTB)
#define PG8_STAGE(bufoff, gbase, voff) do { _Pragma("unroll") for (int _i = 0; _i < 2; ++_i) \
        __builtin_amdgcn_global_load_lds((const unsigned*)((const char*)(gbase) + (voff)[_i]), (PG8_LAS unsigned*)(lds + (bufoff) + ldsw + _i * 8192), 16, 0, 0); } while (0)
#define PG8_LDA(dst, b, h) do { _Pragma("unroll") for (int m = 0; m < 4; ++m) _Pragma("unroll") for (int k = 0; k < 2; ++k) dst[m][k] = *(const PG8_LAS bf16x8*)(lds + PG8_SA(b, h) + aoff + m * 2048 + k * 1024); } while (0)
#define PG8_LDB(dst, b, h) do { _Pragma("unroll") for (int n = 0; n < 2; ++n) _Pragma("unroll") for (int k = 0; k < 2; ++k) dst[n][k] = *(const PG8_LAS bf16x8*)(lds + PG8_SB(b, h) + boff + n * 2048 + k * 1024); } while (0)
#define PG8_MMA(ai, bj, At, Bt) do { __builtin_amdgcn_s_setprio(1); _Pragma("unroll") for (int m = 0; m < 4; ++m) _Pragma("unroll") for (int n = 0; n < 2; ++n) _Pragma("unroll") for (int k = 0; k < 2; ++k) \
        acc[ai][bj][m][n] = __builtin_amdgcn_mfma_f32_16x16x32_bf16(Bt[n][k], At[m][k], acc[ai][bj][m][n], 0, 0, 0); __builtin_amdgcn_s_setprio(0); } while (0)
#define PG8_WAIT_V(n) asm volatile("s_waitcnt vmcnt(" #n ")" ::: "memory")
#define PG8_WAIT_L(n) asm volatile("s_waitcnt lgkmcnt(" #n ")" ::: "memory")
#define PG8_BAR __builtin_amdgcn_s_barrier()
#define PG8_SCHED __builtin_amdgcn_sched_barrier(0)
    Unit cur, nxt; int ui = 0;
    if (!S.next(0, cur)) return;
    f32x4 acc[2][2][4][2];
#pragma unroll
    for (int a = 0; a < 2; ++a)
#pragma unroll
        for (int b = 0; b < 2; ++b)
#pragma unroll
            for (int m = 0; m < 4; ++m)
#pragma unroll
                for (int n = 0; n < 2; ++n) acc[a][b][m][n] = (f32x4){0.f, 0.f, 0.f, 0.f};
    bf16x8 At[4][2], B0[2][2], B1[2][2];
    const char* cA = (const char*)g.A + (size_t)cur.pm * tstep; const char* cB = (const char*)g.Bt + (size_t)cur.pn * tstep;
    S.a_ready(cur);
    if constexpr (SP2) {
        PG8_STAGE(PG8_SB(0, 0), cB, voffB); PG8_STAGE(PG8_SB(0, 1), cB + hstep, voffB); PG8_STAGE(PG8_SA(0, 0), cA, voffA); PG8_STAGE(PG8_SA(0, 1), cA + hstep, voffA);
        if (wr == 1) PG8_BAR;
        PG8_WAIT_V(2); PG8_BAR;
        PG8_STAGE(PG8_SB(1, 0), cB + kstep, voffB); PG8_STAGE(PG8_SA(1, 0), cA + kstep, voffA); PG8_STAGE(PG8_SB(1, 1), cB + hstep + kstep, voffB);
        PG8_WAIT_V(6); PG8_BAR;
    } else {
        PG8_STAGE(PG8_SB(0, 0), cB, voffB); PG8_STAGE(PG8_SA(0, 0), cA, voffA); PG8_STAGE(PG8_SB(0, 1), cB + hstep, voffB); PG8_STAGE(PG8_SA(0, 1), cA + hstep, voffA);
        if (wr == 1) PG8_BAR;
        PG8_WAIT_V(4); PG8_BAR;
        PG8_STAGE(PG8_SB(1, 0), cB + kstep, voffB); PG8_STAGE(PG8_SA(1, 0), cA + kstep, voffA); PG8_STAGE(PG8_SB(1, 1), cB + hstep + kstep, voffB);
        PG8_WAIT_V(6); PG8_BAR;
    }
    for (;;) {
        const bool has_next = S.next(ui + 1, nxt);
        const char* nA = has_next ? (const char*)g.A + (size_t)nxt.pm * tstep : cA; const char* nB = has_next ? (const char*)g.Bt + (size_t)nxt.pn * tstep : cB;
        for (int t = 0; t < nt; t += 2) {
            const bool last = (t == nt - 2);
            const char* a1 = cA + (size_t)(t + 1) * kstep;
            const char* a2 = last ? nA : cA + (size_t)(t + 2) * kstep; const char* b2 = last ? nB : cB + (size_t)(t + 2) * kstep;
            const char* a3 = a2 + kstep; const char* b3 = b2 + kstep;
            if (last && has_next) S.a_ready(nxt);
            if constexpr (SP2) {
            PG8_LDB(B0, 0, 0); PG8_LDB(B1, 0, 1); PG8_SCHED; PG8_LDA(At, 0, 0); PG8_STAGE(PG8_SA(1, 1), a1 + hstep, voffA);
            PG8_WAIT_V(8); PG8_WAIT_L(0); PG8_BAR; PG8_MMA(0, 0, At, B0); PG8_MMA(0, 1, At, B1); PG8_BAR; PG8_SCHED;
            PG8_LDA(At, 0, 1); PG8_STAGE(PG8_SB(0, 0), b2, voffB); PG8_STAGE(PG8_SB(0, 1), b2 + hstep, voffB); PG8_STAGE(PG8_SA(0, 0), a2, voffA);
            PG8_WAIT_V(8); PG8_WAIT_L(0); PG8_BAR; PG8_MMA(1, 0, At, B0); PG8_MMA(1, 1, At, B1); PG8_BAR; PG8_SCHED;
            PG8_LDB(B0, 1, 0); PG8_LDB(B1, 1, 1); PG8_SCHED; PG8_LDA(At, 1, 0); PG8_STAGE(PG8_SA(0, 1), a2 + hstep, voffA);
            PG8_WAIT_V(8); PG8_WAIT_L(0); PG8_BAR; PG8_MMA(0, 0, At, B0); PG8_MMA(0, 1, At, B1); PG8_BAR; PG8_SCHED;
            PG8_LDA(At, 1, 1); PG8_STAGE(PG8_SB(1, 0), b3, voffB); PG8_STAGE(PG8_SB(1, 1), b3 + hstep, voffB); PG8_STAGE(PG8_SA(1, 0), a3, voffA);
            PG8_WAIT_V(8); PG8_WAIT_L(0); PG8_BAR; PG8_MMA(1, 0, At, B0); PG8_MMA(1, 1, At, B1); PG8_BAR; PG8_SCHED;
            } else {
            PG8_LDB(B0, 0, 0); PG8_SCHED; PG8_LDA(At, 0, 0); PG8_STAGE(PG8_SA(1, 1), a1 + hstep, voffA);
            PG8_WAIT_L(8); PG8_BAR; PG8_WAIT_L(0); PG8_MMA(0, 0, At, B0); PG8_BAR; PG8_SCHED;
            PG8_LDB(B1, 0, 1); PG8_STAGE(PG8_SB(0, 0), b2, voffB);
            PG8_BAR; PG8_WAIT_L(0); PG8_MMA(0, 1, At, B1); PG8_BAR;
            PG8_LDA(At, 0, 1); PG8_STAGE(PG8_SA(0, 0), a2, voffA);
            PG8_BAR; PG8_WAIT_L(0); PG8_MMA(1, 0, At, B0); PG8_BAR; PG8_SCHED;
            PG8_STAGE(PG8_SB(0, 1), b2 + hstep, voffB);
            PG8_WAIT_V(6); PG8_BAR; PG8_MMA(1, 1, At, B1); PG8_BAR;
            PG8_LDB(B0, 1, 0); PG8_SCHED; PG8_LDA(At, 1, 0); PG8_STAGE(PG8_SA(0, 1), a2 + hstep, voffA);
            PG8_WAIT_L(8); PG8_BAR; PG8_WAIT_L(0); PG8_MMA(0, 0, At, B0); PG8_BAR; PG8_SCHED;
            PG8_LDB(B1, 1, 1); PG8_STAGE(PG8_SB(1, 0), b3, voffB);
            PG8_BAR; PG8_WAIT_L(0); PG8_MMA(0, 1, At, B1); PG8_BAR;
            PG8_LDA(At, 1, 1); PG8_STAGE(PG8_SA(1, 0), a3, voffA);
            PG8_BAR; PG8_WAIT_L(0); PG8_MMA(1, 0, At, B0); PG8_BAR; PG8_SCHED;
            PG8_STAGE(PG8_SB(1, 1), b3 + hstep, voffB);
            PG8_WAIT_V(6); PG8_BAR; PG8_MMA(1, 1, At, B1); PG8_BAR;
            }
        }
        if constexpr (ALIGN_EPI) { if (wr == 0) PG8_BAR; }
        if constexpr (!Epi::AFTER_DRAIN) { E(acc, cur, wr, wc, fr, fq); S.done(cur); }
        if (!has_next) break;
#pragma unroll
        for (int a = 0; a < 2; ++a)
#pragma unroll
            for (int b = 0; b < 2; ++b)
#pragma unroll
                for (int m = 0; m < 4; ++m)
#pragma unroll
                    for (int n = 0; n < 2; ++n) acc[a][b][m][n] = (f32x4){0.f, 0.f, 0.f, 0.f};
        cur = nxt; cA = nA; cB = nB; ++ui;
        if constexpr (ALIGN_EPI) { if (wr == 1) PG8_BAR; }
    }
    PG8_WAIT_V(0);
    if constexpr (!ALIGN_EPI) { if (wr == 0) PG8_BAR; }
    PG8_BAR;
    if constexpr (Epi::AFTER_DRAIN) { E.fused(acc, cur, wr, wc, fr, fq, lds, wid, lane); S.done(cur); }
#undef PG8_SA
#undef PG8_SB
#undef PG8_STAGE
#undef PG8_LDA
#undef PG8_LDB
#undef PG8_MMA
#undef PG8_WAIT_V
#undef PG8_WAIT_L
#undef PG8_BAR
#undef PG8_SCHED
}
}
constexpr int NWAVES = 8;
constexpr int N_LAUNCHES = MK_N_LAUNCHES;
constexpr int PER_PHASE = 11;
constexpr int D = 1024, NB = 4, SEQ = 4096, CTXL = 256, ML = NB * SEQ, MC = NB * CTXL, MT = ML + MC;
constexpr int NIN = 8240, DFF = 2816;
constexpr float RMS_EPS = 1e-6f, QK_SCALE = 0.08838834764831845f;
constexpr int SC_GQ = 0, SC_GK = 512, SC_GV = 1024, SC_MQ = 2048, SC_MK = 2560, SC_MV = 3072;
constexpr int WT_OG = 17, WT_MRG1 = 25, WT_MRG2 = 29, WT_BR1 = 33, WT_BR2 = 37, WT_OUT = 41, WT_FFN1 = 45, WT_TILES = 67;
constexpr size_t MiB = 1u << 20;
constexpr size_t WS_CTL = 0, CTL_ZERO_BYTES = 1 * MiB;
constexpr size_t WS_WT = 2 * MiB;
constexpr size_t WS_W2T = 36 * MiB;
constexpr size_t WS_XN = 42 * MiB;
constexpr size_t WS_Y1 = 76 * MiB, WS_Y2 = 108 * MiB;
constexpr size_t WS_SIN = 76 * MiB;
constexpr size_t WS_SMALL = 212 * MiB;
constexpr size_t WS_EB = 217 * MiB;
constexpr size_t WS_ET = 251 * MiB;
constexpr size_t WS_HALO = 253 * MiB;
constexpr size_t WS_T2 = 140 * MiB;
constexpr size_t WS_Y = 204 * MiB;
constexpr size_t WS_HF = 76 * MiB;
constexpr size_t WS_END = 256 * MiB;
static_assert(WS_XN + (size_t)MT * D * 2 == WS_Y1 && WS_Y1 + (size_t)ML * D * 2 == WS_Y2 && WS_SIN + (size_t)MT * 4096 * 2 <= WS_SMALL && WS_SMALL + (size_t)MT * 64 * 4 <= 256 * MiB, "ws map");
static_assert(WS_Y2 + (size_t)ML * D * 2 <= WS_T2 && WS_T2 + 64 * MiB <= WS_Y && WS_HF + (size_t)ML * DFF * 2 <= WS_Y && WS_WT + (size_t)WT_TILES * 256 * D * 2 <= WS_W2T && WS_W2T + (size_t)D * DFF * 2 <= WS_XN, "ws map 2");
constexpr int CW_TMO = 0, CW_CODE = 1, CW_BAR = 4096;
constexpr size_t CTL_MOD = 65536, CTL_SS1 = 262144, CTL_SS2 = 327680;
constexpr int RING_OFF = 0, RING_BYTES = 131072, EPI_ST_OFF = RING_BYTES, LDSCTL_OFF = 155648, MISC_OFF = LDSCTL_OFF + 320, LDS_BYTES = 163840;
static_assert(MISC_OFF + 128 <= LDS_BYTES, "LDS map");

#define GAS __attribute__((address_space(1)))
#define LAS __attribute__((address_space(3)))
typedef unsigned short bf16;
typedef unsigned v4u __attribute__((ext_vector_type(4)));
typedef unsigned v2u __attribute__((ext_vector_type(2)));
typedef float f32x4 __attribute__((ext_vector_type(4)));
typedef short bf16x8 __attribute__((ext_vector_type(8)));
typedef GAS unsigned gu32;
#define RLX_AGENT __ATOMIC_RELAXED, __HIP_MEMORY_SCOPE_AGENT
#define LDS_WAIT() asm volatile("s_waitcnt lgkmcnt(0)" ::: "memory")
#define VM_WAIT() asm volatile("s_waitcnt vmcnt(0)" ::: "memory")
__device__ __forceinline__ unsigned f2bf(float f) { unsigned u = __builtin_bit_cast(unsigned, f); return (u + 0x7fffu + ((u >> 16) & 1u)) >> 16; }
__device__ __forceinline__ unsigned pk2(float lo, float hi) { return pg8::cvt_pk_bf16(lo, hi); }
__device__ __forceinline__ float bf2f(bf16 h) { return __uint_as_float((unsigned)h << 16); }
using pg8::bf_lo; using pg8::bf_hi;
__device__ __forceinline__ float logsig_f(float z) { return fminf(z, 0.f) - __logf(1.f + __expf(-fabsf(z))); }
#define XB_TMO      128
#define XB_XCNT(j)  (256  + 64 * (j))
#define XB_XSUB(j)  (1280 + 64 * (j))
#define XB_XGEN(j)  (2304 + 64 * (j))
#define XB_TOP      3328
#define XB_TOPGEN   3392
#define XCD_BAR_WORDS 3456
#define XB_SPIN_CAP (1u << 18)

__device__ __forceinline__ unsigned xb_ld(unsigned* p)              { return __hip_atomic_load(p, __ATOMIC_RELAXED, __HIP_MEMORY_SCOPE_AGENT); }
__device__ __forceinline__ unsigned xb_add(unsigned* p, unsigned v) { return __hip_atomic_fetch_add(p, v, __ATOMIC_RELAXED, __HIP_MEMORY_SCOPE_AGENT); }
__device__ __forceinline__ unsigned xb_xcc_id() { return (unsigned)__builtin_amdgcn_s_getreg((3 << 11) | 20) & 0xFu; }
#define XB_SPIN(cond, bar) do { unsigned _sp = 0; while (cond) { __builtin_amdgcn_s_sleep(1); \
    if ((++_sp & 255u) == 0u) { if (xb_ld(&(bar)[XB_TMO])) break; if (_sp > XB_SPIN_CAP) { atomicAdd(&(bar)[XB_TMO], 1u); break; } } } } while (0)

struct XcdBarrier {
    unsigned* bar; unsigned x;
    volatile LAS unsigned* st;
};

__device__ __forceinline__ XcdBarrier xcd_barrier_post(unsigned* bar, volatile LAS unsigned* st) {
    XcdBarrier b; b.bar = bar; b.x = xb_xcc_id(); b.st = st;
    if (threadIdx.x == 0) (void)xb_add(&bar[XB_XCNT(b.x)], 1u);
    return b;
}
__device__ __forceinline__ void xcd_barrier_complete(unsigned* bar, unsigned x, unsigned& nloc, unsigned& nx) {
    const unsigned G = gridDim.x * gridDim.y * gridDim.z;
    unsigned sum, cnt, mine, sp = 0u;
    for (;;) {
        sum = 0u; cnt = 0u; mine = 0u;
#pragma unroll
        for (unsigned j = 0; j < 16; ++j) { const unsigned c = xb_ld(&bar[XB_XCNT(j)]); sum += c; cnt += (c > 0u) ? 1u : 0u; mine = (j == x) ? c : mine; }
        if (sum == G) break;
        __builtin_amdgcn_s_sleep(1);
        if ((++sp & 255u) == 0u) { if (xb_ld(&bar[XB_TMO])) break; if (sp > XB_SPIN_CAP) { atomicAdd(&bar[XB_TMO], 1u); break; } }
    }
    nloc = mine > 0u ? mine : 1u; nx = cnt > 0u ? cnt : 1u;
}

__device__ __forceinline__ void xcd_barrier(const XcdBarrier& b) {
    asm volatile("s_waitcnt vmcnt(0)" ::: "memory");
    __syncthreads();
    if (threadIdx.x == 0) {
        unsigned* bar = b.bar;
        __builtin_amdgcn_s_waitcnt(0);
        unsigned nloc = b.st[0], nx = b.st[1];
        if (nloc == 0u) { xcd_barrier_complete(bar, b.x, nloc, nx); b.st[0] = nloc; b.st[1] = nx; }
        const unsigned old = xb_add(&bar[XB_XSUB(b.x)], 1u);
        const unsigned gen = old / nloc;
        if (old + 1u == (gen + 1u) * nloc) {
            __builtin_amdgcn_fence(__ATOMIC_RELEASE, "agent");
            asm volatile("s_waitcnt vmcnt(0)" ::: "memory");
            const unsigned og = xb_add(&bar[XB_TOP], 1u);
            const unsigned tg = og / nx;
            if (og + 1u == (tg + 1u) * nx) xb_add(&bar[XB_TOPGEN], 1u);
            else XB_SPIN(xb_ld(&bar[XB_TOPGEN]) == tg, bar);
            __builtin_amdgcn_fence(__ATOMIC_ACQUIRE, "agent");
            xb_add(&bar[XB_XGEN(b.x)], 1u);
            asm volatile("s_waitcnt vmcnt(0)" ::: "memory");
        } else {
            XB_SPIN(xb_ld(&bar[XB_XGEN(b.x)]) == gen, bar);
            __builtin_amdgcn_fence(__ATOMIC_ACQUIRE, "agent");
            asm volatile("s_waitcnt vmcnt(0)" ::: "memory");
        }
    }
    __syncthreads();
}
struct Args { const float* in[22]; float* out; unsigned char* ws; int ph_lo, ph_hi, li, pad; };
typedef __attribute__((address_space(4))) const Args* KArgsPtr;
struct Frame {
    LAS unsigned char* lds;
    volatile LAS unsigned* MISC;
    gu32* ctl;
    int tid, lane, wave;
    int vcu, G;
    KArgsPtr a; unsigned char* ws;
};
#define FIN(k) ((const float*)F.a->in[k])
__device__ __forceinline__ float wave_sum(float v) {
#pragma unroll
    for (int o = 1; o < 64; o <<= 1) v += __shfl_xor(v, o);
    return v;
}
__device__ __forceinline__ int map_col(int which, int off, int n) {
    if (which == 1) return off + n;
    if (which == 2) { const int isb = n >= DFF, j = isb ? n - DFF : n; return off + 256 * (j >> 7) + (isb ? 128 : 0) + (j & 127); }
    if (n < 2048) return n;
    if (n < 3072) return WT_OG * 256 + (n - 2048);
    if (n < 3104) return 4096 + (n - 3072);
    if (n < 4128) return 2048 + (n - 3104);
    if (n < 5152) return 3072 + (n - 4128);
    if (n < 6176) return (WT_OG + 4) * 256 + (n - 5152);
    if (n < 6192) return 4096 + 32 + (n - 6176);
    if (n < 7216) return WT_MRG1 * 256 + (n - 6192);
    return WT_MRG2 * 256 + (n - 7216);
}
__device__ __forceinline__ void p0_transpose_item(const float* W, int K, int N, bf16* WTb, int which, int off, LAS float* scr, int item, int lane) {
    const int nblk = (N + 31) / 32, kb = item / nblk, nb = item % nblk, k0 = 64 * kb, n0 = 32 * nb;
    const bool okc = n0 + (lane & 31) < N;
    float tv[32];
#pragma unroll
    for (int i = 0; i < 32; ++i) tv[i] = W[(size_t)(k0 + 2 * i + (lane >> 5)) * N + (okc ? n0 + (lane & 31) : n0)];
#pragma unroll
    for (int i = 0; i < 32; ++i) scr[(2 * i + (lane >> 5)) * 33 + (lane & 31)] = okc ? tv[i] : 0.f;
    LDS_WAIT(); asm volatile("" ::: "memory");
    const int c8 = lane & 7;
#pragma unroll
    for (int j = 0; j < 4; ++j) { const int n = (lane >> 3) + 8 * j; const LAS float* s = scr + (8 * c8) * 33 + n;
        v4u o; o.x = pk2(s[0 * 33], s[1 * 33]); o.y = pk2(s[2 * 33], s[3 * 33]); o.z = pk2(s[4 * 33], s[5 * 33]); o.w = pk2(s[6 * 33], s[7 * 33]);
        if (n0 + n < N) *(GAS v4u*)(WTb + (size_t)map_col(which, off, n0 + n) * K + k0 + 8 * c8) = o; }
    LDS_WAIT(); asm volatile("" ::: "memory");
}
__device__ __forceinline__ void p0_prologue(Frame& F) {
    LAS float* scr = (LAS float*)(F.lds + RING_OFF + F.wave * 16384);
    const int gw = F.vcu * NWAVES + F.wave, NGW = F.G * NWAVES;
    constexpr int I_IN = 16 * 258, I_BR = 16 * 32, I_F1 = 16 * 176, I_F2 = 44 * 32, I_MOD = 96 * 32;
    constexpr int NITEMS = I_IN + 3 * I_BR + I_F1 + I_F2 + I_MOD;
    for (int it = gw; it < NITEMS; it += NGW) {
        int r = it;
        if (r < I_MOD) {
            const int ncb = r >> 5, kb = r & 31, n = ncb * 64 + F.lane, kbase = kb * 32;
            float sA[5], acc[5];
#pragma unroll
            for (int q = 0; q < 5; ++q) { const float* src = q < 4 ? FIN(1) + q * D : FIN(3); const float a = src[kbase + (F.lane & 31)];
                sA[q] = a / (1.f + __expf(-a)); acc[q] = 0.f; }
            const float* wp = FIN(4) + (size_t)kbase * 6144 + n;
            float wv[32];
#pragma unroll
            for (int kk = 0; kk < 32; ++kk) wv[kk] = wp[(size_t)kk * 6144];
#pragma unroll
            for (int kk = 0; kk < 32; ++kk) {
#pragma unroll
                for (int q = 0; q < 5; ++q) acc[q] += __shfl(sA[q], kk) * wv[kk]; }
            const float bias = kb == 0 ? FIN(5)[n] : 0.f;
#pragma unroll
            for (int q = 0; q < 5; ++q) atomicAdd(((float*)(F.ws + WS_CTL + CTL_MOD)) + q * 6144 + n, acc[q] + bias);
            continue; }
        r -= I_MOD;
        if (r < I_IN) { p0_transpose_item(FIN(7), D, NIN, ((bf16*)(F.ws + WS_WT)), 0, 0, scr, r, F.lane); continue; } r -= I_IN;
        if (r < I_BR) { p0_transpose_item(FIN(15), D, D, ((bf16*)(F.ws + WS_WT)), 1, WT_BR1 * 256, scr, r, F.lane); continue; } r -= I_BR;
        if (r < I_BR) { p0_transpose_item(FIN(16), D, D, ((bf16*)(F.ws + WS_WT)), 1, WT_BR2 * 256, scr, r, F.lane); continue; } r -= I_BR;
        if (r < I_BR) { p0_transpose_item(FIN(17), D, D, ((bf16*)(F.ws + WS_WT)), 1, WT_OUT * 256, scr, r, F.lane); continue; } r -= I_BR;
        if (r < I_F1) { p0_transpose_item(FIN(19), D, 2 * DFF, ((bf16*)(F.ws + WS_WT)), 2, WT_FFN1 * 256, scr, r, F.lane); continue; } r -= I_F1;
        p0_transpose_item(FIN(20), DFF, D, ((bf16*)(F.ws + WS_W2T)), 1, 0, scr, r, F.lane);
    }
    { GAS v4u* z = (GAS v4u*)(((bf16*)(F.ws + WS_WT)) + (size_t)(4096 + 48) * D); const int n16 = 208 * 2048 / 16;
      for (int i = gw * 64 + F.lane; i < n16; i += NGW * 64) z[i] = (v4u){0u, 0u, 0u, 0u}; }
}
__device__ __forceinline__ void norm_mod_row(Frame& F, const float* xrow, float ssq_or_neg, const float* g, const float* shift, const float* scale, bf16* orow) {
    const GAS f32x4* xr = (const GAS f32x4*)xrow + F.lane;
    f32x4 v[4]; float s = 0.f;
#pragma unroll
    for (int j = 0; j < 4; ++j) { v[j] = xr[64 * j]; s += (v[j].x * v[j].x + v[j].y * v[j].y) + (v[j].z * v[j].z + v[j].w * v[j].w); }
    const float tot = ssq_or_neg >= 0.f ? ssq_or_neg : wave_sum(s);
    const float rstd = 1.f / sqrtf(tot * (1.f / D) + RMS_EPS);
    GAS unsigned long long* o8 = (GAS unsigned long long*)orow + F.lane;
#pragma unroll
    for (int j = 0; j < 4; ++j) { const f32x4 gv = ((const GAS f32x4*)g)[F.lane + 64 * j], sh = ((const GAS f32x4*)shift)[F.lane + 64 * j], sc = ((const GAS f32x4*)scale)[F.lane + 64 * j];
        const f32x4 y = (v[j] * rstd * gv) * (1.f + sc) + sh;
        o8[64 * j] = (unsigned long long)pk2(y.x, y.y) | ((unsigned long long)pk2(y.z, y.w) << 32); }
}
constexpr int SL_AQ = 0, SL_AK = 17408, SL_PM = 34816, SL_VT = 44032, SL_VW = 50944, SL_F = 57856, SL_DIRSZ = 59904, SL_ST = 2 * SL_DIRSZ;
constexpr int ST_AQ = 272, ST_KT = 144, ST_DIR = 48 * 272;
static_assert(SL_ST + 2 * ST_DIR <= LDSCTL_OFF, "scan LDS map");
#define MMA16(a, b, c) __builtin_amdgcn_mfma_f32_16x16x32_bf16((a), (b), (c), 0, 0, 0)
#define SBAR() do { asm volatile("s_waitcnt lgkmcnt(0)" ::: "memory"); __builtin_amdgcn_s_barrier(); asm volatile("" ::: "memory"); } while (0)
__device__ __forceinline__ bf16x8 ldf(LAS unsigned char* base, int row, int stride, int kb) { return *(const LAS bf16x8*)(base + row * stride + kb); }
__device__ __forceinline__ unsigned long long pack4(const f32x4& v) { return (unsigned long long)pk2(v[0], v[1]) | ((unsigned long long)pk2(v[2], v[3]) << 32); }
__device__ __forceinline__ void st_lds16(LAS unsigned char* p, float v) { *(LAS unsigned short*)p = (unsigned short)f2bf(v); }
__device__ __forceinline__ float fexp(float x) { return __builtin_amdgcn_exp2f(x * 1.4426950408889634f); }
__device__ __forceinline__ void out4(bf16* p, f32x4 v, bool rmw, unsigned long long o) {
    if (rmw) { const unsigned lo = (unsigned)o, hi = (unsigned)(o >> 32);
        v[0] += __uint_as_float(lo << 16); v[1] += __uint_as_float(lo & 0xffff0000u); v[2] += __uint_as_float(hi << 16); v[3] += __uint_as_float(hi & 0xffff0000u); }
    *(unsigned long long*)p = pack4(v);
}
__device__ __forceinline__ void stage_v(LAS unsigned char* L, const v2u w, int tid) {
    const int tok = tid >> 3, dvq = (tid & 7) * 4;
    LAS unsigned char* p = L + SL_VT + dvq * ST_KT + tok * 2;
    *(LAS unsigned short*)(p) = (unsigned short)(w.x & 0xffffu); *(LAS unsigned short*)(p + ST_KT) = (unsigned short)(w.x >> 16);
    *(LAS unsigned short*)(p + 2 * ST_KT) = (unsigned short)(w.y & 0xffffu); *(LAS unsigned short*)(p + 3 * ST_KT) = (unsigned short)(w.y >> 16);
}
__device__ __forceinline__ void scores2(LAS unsigned char* L, int w, int l15, int quad, f32x4 (&acc)[2]) {
    const int lt = w >> 1; bf16x8 fa[2][4], fb[4];
#pragma unroll
    for (int ks = 0; ks < 4; ++ks) { fb[ks] = ldf(L + SL_AQ, lt * 16 + l15, ST_AQ, ks * 64 + quad * 16);
#pragma unroll
        for (int mi = 0; mi < 2; ++mi) fa[mi][ks] = ldf(L + SL_AK, ((w & 1) * 2 + mi) * 16 + l15, ST_AQ, ks * 64 + quad * 16); }
    __builtin_amdgcn_sched_barrier(0);
#pragma unroll
    for (int mi = 0; mi < 2; ++mi) { f32x4 a4 = {0.f, 0.f, 0.f, 0.f};
#pragma unroll
        for (int ks = 0; ks < 4; ++ks) a4 = MMA16(fa[mi][ks], fb[ks], a4);
        acc[mi] = a4; }
}
typedef short v4i16_t __attribute__((ext_vector_type(4)));
__device__ __forceinline__ bf16x8 ldkt(LAS unsigned char* L, int ch0, int ks, int l15, int quad) {
    LAS unsigned char* p = L + SL_AK + (ks * 32 + quad * 8 + (l15 >> 2)) * ST_AQ + (ch0 + 4 * (l15 & 3)) * 2;
    const v4i16_t lo = __builtin_amdgcn_ds_read_tr16_b64_v4i16((LAS v4i16_t*)p), hi = __builtin_amdgcn_ds_read_tr16_b64_v4i16((LAS v4i16_t*)(p + 4 * ST_AQ));
    bf16x8 r; r[0] = lo[0]; r[1] = lo[1]; r[2] = lo[2]; r[3] = lo[3]; r[4] = hi[0]; r[5] = hi[1]; r[6] = hi[2]; r[7] = hi[3]; return r;
}

__device__ __forceinline__ void pre_gla_item(Frame& F, const int item) {
    LAS unsigned char* L = F.lds; const int tid = F.tid, w = F.wave, lane = F.lane, l15 = lane & 15, quad = lane >> 4;
    const int bh = item / 68, cg = item % 68, b = bh >> 2, h = bh & 3;
    const int rowbase = cg < 4 ? ML + b * CTXL + cg * 64 : b * SEQ + (cg - 4) * 64;
    const int ch = 16 * w + l15;
#pragma unroll
    for (int dir = 0; dir < 2; ++dir) {
        bf16x8 wfr;
        { float wv[8];
#pragma unroll
          for (int j = 0; j < 8; ++j) wv[j] = quad < 2 ? FIN(8)[(size_t)(dir * 16 + quad * 8 + j) * 512 + 128 * h + ch] : 0.f;
          v4u t; t.x = pk2(wv[0], wv[1]); t.y = pk2(wv[2], wv[3]); t.z = pk2(wv[4], wv[5]); t.w = pk2(wv[6], wv[7]); wfr = __builtin_bit_cast(bf16x8, t); }
        const float bd = FIN(9)[dir * 512 + 128 * h + ch];
        float g[4][4], p[4][4]; float carry = 0.f;
#pragma unroll
        for (int tt = 0; tt < 4; ++tt) {
            bf16x8 afr;
            { const float* sp = ((float*)(F.ws + WS_SMALL)) + (size_t)(rowbase + tt * 16 + l15) * 64 + dir * 16 + (quad & 1) * 8;
              const f32x4 a0 = *(const f32x4*)sp, a1 = *(const f32x4*)(sp + 4);
              v4u t; t.x = pk2(a0[0], a0[1]); t.y = pk2(a0[2], a0[3]); t.z = pk2(a1[0], a1[1]); t.w = pk2(a1[2], a1[3]);
              if (quad >= 2) t = (v4u){0u, 0u, 0u, 0u};
              afr = __builtin_bit_cast(bf16x8, t); }
            f32x4 z = {0.f, 0.f, 0.f, 0.f};
            z = MMA16(afr, wfr, z);
            float run = 0.f;
#pragma unroll
            for (int r = 0; r < 4; ++r) { g[tt][r] = logsig_f(z[r] + bd) * (1.f / 16.f); run += g[tt][r]; p[tt][r] = run; }
            float x = run, y = __shfl_up(x, 16); if (quad >= 1) x += y; y = __shfl_up(x, 32); if (quad >= 2) x += y;
            const float excl = x - run + carry;
#pragma unroll
            for (int r = 0; r < 4; ++r) p[tt][r] += excl;
            carry += __shfl(x, 48 + l15);
        }
        const float T = carry;
        if (quad == 0) ((float*)(F.ws + WS_ET))[(size_t)(dir * 272 + (rowbase >> 6)) * 512 + 128 * h + ch] = fexp(T);
#pragma unroll
        for (int tt = 0; tt < 4; ++tt)
#pragma unroll
            for (int r = 0; r < 4; ++r) { const int tok = tt * 16 + quad * 4 + r; const float bcum = dir == 0 ? p[tt][r] : T - p[tt][r] + g[tt][r];
                st_lds16(L + dir * 17408 + tok * ST_AQ + ch * 2, fexp(bcum)); }
    }
    SBAR();
    { const int tok0 = tid >> 4, c16 = tid & 15;
#pragma unroll
      for (int dir = 0; dir < 2; ++dir)
#pragma unroll
        for (int hh = 0; hh < 2; ++hh) { const int tok = tok0 + 32 * hh;
            *(v4u*)(((bf16*)(F.ws + WS_EB)) + ((size_t)dir * MT + rowbase + tok) * 512 + 128 * h + c16 * 8) = *(const LAS v4u*)(L + dir * 17408 + tok * ST_AQ + c16 * 16); } }
    SBAR();
}
__device__ __forceinline__ int mlc_row(int b, int cm, int r) { return cm < 4 ? ML + b * CTXL + cm * 64 + r : b * SEQ + r * 64 + (cm - 4); }
__device__ __forceinline__ void pre_halo_item(Frame& F, const int item) {
    const int ci = item >> 1, which = item & 1, b = ci / 68, cm = ci % 68;
    const v4u* src = (const v4u*)(((bf16*)(F.ws + WS_SIN)) + (size_t)mlc_row(b, cm, which ? 63 : 0) * 4096 + SC_MQ);
    v4u* dst = (v4u*)(((bf16*)(F.ws + WS_HALO)) + (size_t)item * 1024);
    dst[F.lane] = src[F.lane]; dst[F.lane + 64] = src[F.lane + 64];
}
__device__ __forceinline__ void pre_conv_item(Frame& F, const int ci) {
    const int b = ci / 68, cm = ci % 68, ch0 = 2 * F.tid;
    const bool first = (cm == 0 || cm == 4), last = (cm == 3 || cm == 67);
    float cw[8];
#pragma unroll
    for (int e = 0; e < 2; ++e) { cw[4 * e] = FIN(11)[ch0 + e]; cw[4 * e + 1] = FIN(11)[1024 + ch0 + e]; cw[4 * e + 2] = FIN(11)[2048 + ch0 + e]; cw[4 * e + 3] = FIN(12)[ch0 + e]; }
    const float sc = ch0 >= 512 ? QK_SCALE : 1.f;
    bf16* base = ((bf16*)(F.ws + WS_SIN)) + SC_MQ + ch0;
    unsigned prev = first ? 0u : *(const unsigned*)(((bf16*)(F.ws + WS_HALO)) + (size_t)((ci - 1) * 2 + 1) * 1024 + ch0);
    unsigned cur = *(const unsigned*)(base + (size_t)mlc_row(b, cm, 0) * 4096);
    const unsigned tail = last ? 0u : *(const unsigned*)(((bf16*)(F.ws + WS_HALO)) + (size_t)((ci + 1) * 2 + 0) * 1024 + ch0);
#pragma unroll
    for (int bq = 0; bq < 4; ++bq) {
        unsigned nx[16];
#pragma unroll
        for (int i = 0; i < 16; ++i) { const int pp = bq * 16 + i + 1; nx[i] = pp < 64 ? *(const unsigned*)(base + (size_t)mlc_row(b, cm, pp < 64 ? pp : 63) * 4096) : tail; }
#pragma unroll
        for (int i = 0; i < 16; ++i) {
            const float a0 = cw[3] + cw[0] * bf_lo(prev) + cw[1] * bf_lo(cur) + cw[2] * bf_lo(nx[i]);
            const float a1 = cw[7] + cw[4] * bf_hi(prev) + cw[5] * bf_hi(cur) + cw[6] * bf_hi(nx[i]);
            *(unsigned*)(base + (size_t)mlc_row(b, cm, bq * 16 + i) * 4096) = pk2(a0 * __builtin_amdgcn_rcpf(1.f + fexp(-a0)) * sc, a1 * __builtin_amdgcn_rcpf(1.f + fexp(-a1)) * sc);
            prev = cur; cur = nx[i]; }
    }
}

struct GlaPF { v4u q0, q1, k0, k1, e0, e1; v2u v; float et; };
__device__ __forceinline__ void gla_issue(GlaPF& pf, const bf16* SIN, const bf16* __restrict__ EB, const float* __restrict__ ET, const int rowbase, const int dir, const int h, const int ocol, const int tid) {
    const int tok0 = tid >> 4, c16 = tid & 15;
    const bf16* qp = SIN + (size_t)(rowbase + tok0) * 4096 + SC_GQ + 128 * h + c16 * 8;
    pf.q0 = *(const v4u*)qp; pf.q1 = *(const v4u*)(qp + (size_t)32 * 4096); pf.k0 = *(const v4u*)(qp + 512); pf.k1 = *(const v4u*)(qp + (size_t)32 * 4096 + 512);
    const bf16* ep = EB + ((size_t)dir * MT + rowbase + tok0) * 512 + 128 * h + c16 * 8;
    pf.e0 = *(const v4u*)ep; pf.e1 = *(const v4u*)(ep + 32 * 512);
    pf.v = *(const v2u*)(SIN + (size_t)(rowbase + (tid >> 3)) * 4096 + SC_GV + ocol + (tid & 7) * 4);
    pf.et = ET[(size_t)(dir * 272 + (rowbase >> 6)) * 512 + 128 * h + (tid & 127)];
}
__device__ __forceinline__ void gla_piece(LAS unsigned char* L, const v4u q, const v4u k, const v4u e, const int tok, const int c16) {
    v4u qo, ko;
#pragma unroll
    for (int j = 0; j < 4; ++j) {
        const float e0 = bf_lo(e[j]), e1 = bf_hi(e[j]); const float r0 = __builtin_amdgcn_rcpf(e0), r1 = __builtin_amdgcn_rcpf(e1);
        qo[j] = pk2(bf_lo(q[j]) * QK_SCALE * e0, bf_hi(q[j]) * QK_SCALE * e1);
        ko[j] = pk2(bf_lo(k[j]) * r0, bf_hi(k[j]) * r1);
    }
    *(LAS v4u*)(L + SL_AQ + tok * ST_AQ + c16 * 16) = qo; *(LAS v4u*)(L + SL_AK + tok * ST_AQ + c16 * 16) = ko;
}
__device__ __forceinline__ void gla_s1(LAS unsigned char* L, const GlaPF& pf, const int tid) {
    const int tok0 = tid >> 4, c16 = tid & 15;
    gla_piece(L, pf.q0, pf.k0, pf.e0, tok0, c16); gla_piece(L, pf.q1, pf.k1, pf.e1, tok0 + 32, c16);
    stage_v(L, pf.v, tid);
    if (tid < 128) *(LAS float*)(L + SL_F + tid * 4) = pf.et;
}
__device__ __forceinline__ void gla_s3(LAS unsigned char* L, const int dir, const int w, const int l15, const int quad) {
    f32x4 sc[2]; scores2(L, w, l15, quad, sc);
    const int l = (w >> 1) * 16 + l15;
#pragma unroll
    for (int mi = 0; mi < 2; ++mi) { const int m0 = ((w & 1) * 2 + mi) * 16 + quad * 4; f32x4 v = sc[mi];
#pragma unroll
        for (int r = 0; r < 4; ++r) { const bool keep = dir == 0 ? (m0 + r <= l) : (m0 + r >= l); v[r] = keep ? v[r] : 0.f; }
        *(LAS unsigned long long*)(L + SL_PM + l * ST_KT + m0 * 2) = pack4(v); }
}
__device__ __forceinline__ void gla_s4(LAS unsigned char* L, LAS unsigned char* STp, bf16* optr, const bool lat, const bool rmw, f32x4 (&S)[2], const int w, const int l15, const int quad) {
    bf16x8 kf[2], vf[2][2];
#pragma unroll
    for (int ks = 0; ks < 2; ++ks) { kf[ks] = ldkt(L, 16 * w, ks, l15, quad);
#pragma unroll
        for (int dvt = 0; dvt < 2; ++dvt) vf[dvt][ks] = ldf(L + SL_VT, dvt * 16 + l15, ST_KT, ks * 64 + quad * 16); }
    const f32x4 dec = *(const LAS f32x4*)(L + SL_F + (16 * w + quad * 4) * 4);
    if (lat) {
        const int dvt = w & 1, tt = w >> 1; bf16x8 pa[2], pb[2], sa[4], sb[4];
#pragma unroll
        for (int ks = 0; ks < 2; ++ks) { pa[ks] = ldf(L + SL_VT, dvt * 16 + l15, ST_KT, ks * 64 + quad * 16); pb[ks] = ldf(L + SL_PM, tt * 16 + l15, ST_KT, ks * 64 + quad * 16); }
#pragma unroll
        for (int ks = 0; ks < 4; ++ks) { sa[ks] = ldf(STp, dvt * 16 + l15, ST_AQ, ks * 64 + quad * 16); sb[ks] = ldf(L + SL_AQ, tt * 16 + l15, ST_AQ, ks * 64 + quad * 16); }
        __builtin_amdgcn_sched_barrier(0);
        f32x4 a4 = {0.f, 0.f, 0.f, 0.f};
#pragma unroll
        for (int ks = 0; ks < 2; ++ks) a4 = MMA16(pa[ks], pb[ks], a4);
#pragma unroll
        for (int ks = 0; ks < 4; ++ks) a4 = MMA16(sa[ks], sb[ks], a4);
        unsigned long long oldv = 0ull;
        if (rmw) oldv = __hip_atomic_load((unsigned long long*)optr, RLX_AGENT);
        out4(optr, a4, rmw, oldv);
    }
#pragma unroll
    for (int dvt = 0; dvt < 2; ++dvt) { f32x4 a4 = S[dvt];
#pragma unroll
        for (int ks = 0; ks < 2; ++ks) a4 = MMA16(kf[ks], vf[dvt][ks], a4);
        S[dvt] = a4 * dec; }
}
__device__ __forceinline__ int gla_rowbase(int b, int step, int dir) {
    const bool lat = step >= 4; const int chunk = lat ? (dir ? 67 - step : step - 4) : (dir ? 3 - step : step);
    return lat ? b * SEQ + chunk * 64 : ML + b * CTXL + chunk * 64;
}
__device__ __forceinline__ void scan_gla(Frame& F, const int b, const int h, const int slice) {
    LAS unsigned char* L = F.lds; const int tid = F.tid, w = F.wave, lane = F.lane, l15 = lane & 15, quad = lane >> 4;
    LAS unsigned char* L0 = L; LAS unsigned char* L1 = L + SL_DIRSZ;
    for (int i = tid; i < 2 * ST_DIR / 4; i += 512) ((LAS unsigned*)(L + SL_ST))[i] = 0u;
    f32x4 Sf[2], Sb[2];
#pragma unroll
    for (int i = 0; i < 2; ++i) { Sf[i] = (f32x4){0.f, 0.f, 0.f, 0.f}; Sb[i] = (f32x4){0.f, 0.f, 0.f, 0.f}; }
    const int ocol = 256 * h + 32 * slice; bf16* OUT = (bf16*)((float*)F.a->out);
    const size_t ooff = (size_t)((w >> 1) * 16 + l15) * 1024 + ocol + (w & 1) * 16 + quad * 4;
    GlaPF pf0, pf1; gla_issue(pf0, ((bf16*)(F.ws + WS_SIN)), ((bf16*)(F.ws + WS_EB)), ((float*)(F.ws + WS_ET)), gla_rowbase(b, 0, 0), 0, h, ocol, tid); gla_issue(pf1, ((bf16*)(F.ws + WS_SIN)), ((bf16*)(F.ws + WS_EB)), ((float*)(F.ws + WS_ET)), gla_rowbase(b, 0, 1), 1, h, ocol, tid);
    SBAR();
    for (int step = 0; step < 68; ++step) {
        const bool lat = step >= 4, rmw = step >= 36; const int ns = step < 67 ? step + 1 : 67;
        const int rb0 = gla_rowbase(b, step, 0), rb1 = gla_rowbase(b, step, 1);
        gla_s1(L0, pf0, tid); __builtin_amdgcn_sched_barrier(0); gla_s1(L1, pf1, tid);
        gla_issue(pf0, ((bf16*)(F.ws + WS_SIN)), ((bf16*)(F.ws + WS_EB)), ((float*)(F.ws + WS_ET)), gla_rowbase(b, ns, 0), 0, h, ocol, tid); gla_issue(pf1, ((bf16*)(F.ws + WS_SIN)), ((bf16*)(F.ws + WS_EB)), ((float*)(F.ws + WS_ET)), gla_rowbase(b, ns, 1), 1, h, ocol, tid);
        SBAR();
        if (lat) { gla_s3(L0, 0, w, l15, quad); __builtin_amdgcn_sched_barrier(0); gla_s3(L1, 1, w, l15, quad); SBAR(); }
        gla_s4(L0, L + SL_ST, OUT + (size_t)rb0 * 1024 + ooff, lat, rmw, Sf, w, l15, quad);
        __builtin_amdgcn_sched_barrier(0);
        gla_s4(L1, L + SL_ST + ST_DIR, OUT + (size_t)rb1 * 1024 + ooff, lat, rmw, Sb, w, l15, quad);
        SBAR();
#pragma unroll
        for (int dvt = 0; dvt < 2; ++dvt) { *(LAS unsigned long long*)(L + SL_ST + (dvt * 16 + l15) * ST_AQ + (16 * w + quad * 4) * 2) = pack4(Sf[dvt]);
            *(LAS unsigned long long*)(L + SL_ST + ST_DIR + (dvt * 16 + l15) * ST_AQ + (16 * w + quad * 4) * 2) = pack4(Sb[dvt]); }
        if (step == 35) { VM_WAIT(); SBAR(); }
    }
    VM_WAIT(); SBAR();
}

struct MlPF { v4u q0, q1, k0, k1; v2u v; float gi, gf; };
__device__ __forceinline__ int ml_row(int b, bool lat, int p) { return lat ? (b * SEQ + (p & 63) * 64 + (p >> 6)) : (ML + b * CTXL + p); }
__device__ __forceinline__ void ml_issue(MlPF& pf, const bf16* SIN, const float* __restrict__ SMALL, const int b, const int chunk, const bool lat, const int dir, const int h, const int ocol, const int tid, const int lane) {
    const int p0 = chunk * 64, tok0 = tid >> 4, c16 = tid & 15;
    const bf16* qa = SIN + (size_t)ml_row(b, lat, p0 + tok0) * 4096 + SC_MQ + 128 * h + c16 * 8; const bf16* qb = SIN + (size_t)ml_row(b, lat, p0 + tok0 + 32) * 4096 + SC_MQ + 128 * h + c16 * 8;
    pf.q0 = *(const v4u*)qa; pf.q1 = *(const v4u*)qb; pf.k0 = *(const v4u*)(qa + 512); pf.k1 = *(const v4u*)(qb + 512);
    pf.v = *(const v2u*)(SIN + (size_t)ml_row(b, lat, p0 + (tid >> 3)) * 4096 + SC_MV + ocol + (tid & 7) * 4);
    const int gi = dir ? 2 : 0; const size_t row = (size_t)ml_row(b, lat, p0 + lane);
    pf.gi = SMALL[row * 64 + 32 + 4 * gi + h]; pf.gf = SMALL[row * 64 + 32 + 4 * (gi + 1) + h];
}
__device__ __forceinline__ void ml_s1(LAS unsigned char* L, const MlPF& pf, const int dir, const float bgi, const float bgf, float& mrun, const bool scanner, const int tid, const int lane) {
    { const int tok0 = tid >> 4, c16 = tid & 15;
      *(LAS v4u*)(L + SL_AQ + tok0 * ST_AQ + c16 * 16) = pf.q0; *(LAS v4u*)(L + SL_AK + tok0 * ST_AQ + c16 * 16) = pf.k0;
      *(LAS v4u*)(L + SL_AQ + (tok0 + 32) * ST_AQ + c16 * 16) = pf.q1; *(LAS v4u*)(L + SL_AK + (tok0 + 32) * ST_AQ + c16 * 16) = pf.k1; }
    stage_v(L, pf.v, tid);
    if (scanner) {
        LAS float* Fp = (LAS float*)(L + SL_F);
        const float li = pf.gi + bgi, lf = logsig_f(pf.gf + bgf);
        float x = lf;
#pragma unroll
        for (int o = 1; o < 64; o <<= 1) { const float y = __shfl_up(x, o); if (lane >= o) x += y; }
        const float total = __shfl(x, 63);
        const float bv = dir == 0 ? x : total - x + lf;
        const float av = li - bv;
        float xm = av;
        if (dir == 0) {
#pragma unroll
            for (int o = 1; o < 64; o <<= 1) { const float y = __shfl_up(xm, o); if (lane >= o) xm = fmaxf(xm, y); }
        } else {
#pragma unroll
            for (int o = 1; o < 64; o <<= 1) { const float y = __shfl_down(xm, o); if (lane + o < 64) xm = fmaxf(xm, y); }
        }
        const float Mall = __shfl(xm, dir == 0 ? 63 : 0);
        const float m = mrun;
        const float mq = bv + fmaxf(m, xm);
        const float mnew = total + fmaxf(m, Mall);
        Fp[lane] = bv - mq;
        Fp[64 + lane] = av;
        Fp[128 + lane] = fexp(-mq);
        Fp[192 + lane] = fexp(bv + m - mq);
        Fp[256 + lane] = fexp(total + av - mnew);
        if (lane == 0) Fp[320] = fexp(total + m - mnew);
        mrun = mnew;
    }
}
__device__ __forceinline__ void ml_s2(LAS unsigned char* L, const int dir, const bool lat, const int tid, const int w, const int l15, const int quad) {
    const LAS float* Fp = (const LAS float*)(L + SL_F);
    { const int tok = tid >> 3, dvq = (tid & 7) * 4; const float wk = Fp[256 + tok];
      LAS unsigned char* p = L + SL_VW + dvq * ST_KT + tok * 2; const LAS unsigned char* pv = L + SL_VT + dvq * ST_KT + tok * 2;
#pragma unroll
      for (int e = 0; e < 4; ++e) st_lds16(p + e * ST_KT, __uint_as_float((unsigned)(*(const LAS unsigned short*)(pv + e * ST_KT)) << 16) * wk);
      if (tid < 64) st_lds16(L + SL_VW + 32 * ST_KT + tid * 2, Fp[256 + tid]); }
    if (lat) {
        f32x4 sc[2]; scores2(L, w, l15, quad, sc);
        const int l = (w >> 1) * 16 + l15; const float rowt = Fp[l];
#pragma unroll
        for (int mi = 0; mi < 2; ++mi) { const int m0 = ((w & 1) * 2 + mi) * 16 + quad * 4; f32x4 v = sc[mi]; const f32x4 av = *(const LAS f32x4*)(Fp + 64 + m0);
#pragma unroll
            for (int r = 0; r < 4; ++r) { const bool keep = dir == 0 ? (m0 + r <= l) : (m0 + r >= l); v[r] = keep ? v[r] * fexp(rowt + av[r]) : 0.f; }
            *(LAS unsigned long long*)(L + SL_PM + l * ST_KT + m0 * 2) = pack4(v); }
    }
}
__device__ __forceinline__ void ml_s4(LAS unsigned char* L, LAS unsigned char* STp, bf16* optr, const bool lat, const bool rmw, f32x4 (&C)[3], const int w, const int l15, const int quad) {
    const LAS float* Fp = (const LAS float*)(L + SL_F);
    if (lat) {
        const int dvo = w & 1, tt = w >> 1; f32x4 n1 = {0.f, 0.f, 0.f, 0.f}, n2 = n1, d1 = n1, d2 = n1;
        { bf16x8 pm[2], va[2], vd[2];
#pragma unroll
          for (int ks = 0; ks < 2; ++ks) { pm[ks] = ldf(L + SL_PM, tt * 16 + l15, ST_KT, ks * 64 + quad * 16); va[ks] = ldf(L + SL_VT, dvo * 16 + l15, ST_KT, ks * 64 + quad * 16); vd[ks] = ldf(L + SL_VT, 32 + l15, ST_KT, ks * 64 + quad * 16); }
          __builtin_amdgcn_sched_barrier(0);
#pragma unroll
          for (int ks = 0; ks < 2; ++ks) { n1 = MMA16(va[ks], pm[ks], n1); d1 = MMA16(vd[ks], pm[ks], d1); } }
        __builtin_amdgcn_sched_barrier(0);
        { bf16x8 aq[4], sa[4], sd[4];
#pragma unroll
          for (int ks = 0; ks < 4; ++ks) { aq[ks] = ldf(L + SL_AQ, tt * 16 + l15, ST_AQ, ks * 64 + quad * 16); sa[ks] = ldf(STp, dvo * 16 + l15, ST_AQ, ks * 64 + quad * 16); sd[ks] = ldf(STp, 32 + l15, ST_AQ, ks * 64 + quad * 16); }
          __builtin_amdgcn_sched_barrier(0);
#pragma unroll
          for (int ks = 0; ks < 4; ++ks) { n2 = MMA16(sa[ks], aq[ks], n2); d2 = MMA16(sd[ks], aq[ks], d2); } }
        const int tok = tt * 16 + l15; const float wi = Fp[192 + tok], flo = Fp[128 + tok];
        const float denl = d1[0] + wi * d2[0]; const float den = __shfl(denl, l15);
        const float inv = __builtin_amdgcn_rcpf(fmaxf(fabsf(den), flo));
        f32x4 hv = (n1 + n2 * wi) * inv;
        unsigned long long oldv = 0ull;
        if (rmw) oldv = __hip_atomic_load((unsigned long long*)optr, RLX_AGENT);
        out4(optr, hv, rmw, oldv);
    }
    __builtin_amdgcn_sched_barrier(0);
    bf16x8 kf[2], vf[3][2];
#pragma unroll
    for (int ks = 0; ks < 2; ++ks) { kf[ks] = ldkt(L, 16 * w, ks, l15, quad);
#pragma unroll
        for (int dvt = 0; dvt < 3; ++dvt) vf[dvt][ks] = ldf(L + SL_VW, dvt * 16 + l15, ST_KT, ks * 64 + quad * 16); }
    const float decay = Fp[320];
#pragma unroll
    for (int dvt = 0; dvt < 3; ++dvt) { f32x4 a4 = C[dvt] * decay;
#pragma unroll
        for (int ks = 0; ks < 2; ++ks) a4 = MMA16(kf[ks], vf[dvt][ks], a4);
        C[dvt] = a4; }
}
__device__ __forceinline__ void scan_mlstm(Frame& F, const int b, const int h, const int slice) {
    LAS unsigned char* L = F.lds; const int tid = F.tid, w = F.wave, lane = F.lane, l15 = lane & 15, quad = lane >> 4;
    LAS unsigned char* L0 = L; LAS unsigned char* L1 = L + SL_DIRSZ;
    for (int i = tid; i < 16 * 72; i += 512) { const int r = i / 72; const unsigned short one = r == 0 ? (unsigned short)0x3F80 : (unsigned short)0;
        *(LAS unsigned short*)(L0 + SL_VT + 32 * ST_KT + i * 2) = one; *(LAS unsigned short*)(L1 + SL_VT + 32 * ST_KT + i * 2) = one;
        *(LAS unsigned short*)(L0 + SL_VW + 32 * ST_KT + i * 2) = (unsigned short)0; *(LAS unsigned short*)(L1 + SL_VW + 32 * ST_KT + i * 2) = (unsigned short)0; }
    for (int i = tid; i < 2 * ST_DIR / 4; i += 512) ((LAS unsigned*)(L + SL_ST))[i] = 0u;
    f32x4 Cf[3], Cb[3];
#pragma unroll
    for (int i = 0; i < 3; ++i) { Cf[i] = (f32x4){0.f, 0.f, 0.f, 0.f}; Cb[i] = (f32x4){0.f, 0.f, 0.f, 0.f}; }
    float mf = 0.f, mb = 0.f;
    const float bg0i = FIN(13)[0 * 4 + h], bg0f = FIN(13)[1 * 4 + h], bg1i = FIN(13)[2 * 4 + h], bg1f = FIN(13)[3 * 4 + h];
    const int ocol = 256 * h + 32 * slice; bf16* OUT = (bf16*)((float*)F.a->out) + (size_t)ML * D;
    const size_t ocl = (size_t)ocol + (w & 1) * 16 + quad * 4; const int otok = (w >> 1) * 16 + l15;
    MlPF pf; ml_issue(pf, ((bf16*)(F.ws + WS_SIN)), ((float*)(F.ws + WS_SMALL)), b, 0, false, 0, h, ocol, tid, lane);
    SBAR();
    for (int step = 0; step < 68; ++step) {
        const bool lat = step >= 4, rmw = step >= 36;
        const int cf = lat ? step - 4 : step, cb = lat ? 67 - step : 3 - step;
        const int ns = step < 67 ? step + 1 : 67; const bool nlat = ns >= 4; const int ncf = nlat ? ns - 4 : ns;
        ml_s1(L0, pf, 0, bg0i, bg0f, mf, w == 0, tid, lane);
        ml_issue(pf, ((bf16*)(F.ws + WS_SIN)), ((float*)(F.ws + WS_SMALL)), b, cb, lat, 1, h, ocol, tid, lane);
        SBAR();
        ml_s2(L0, 0, lat, tid, w, l15, quad);
        SBAR();
        ml_s4(L0, L + SL_ST, OUT + (lat ? (size_t)b * SEQ + cf + (size_t)otok * 64 : 0) * 1024 + ocl, lat, rmw, Cf, w, l15, quad);
        SBAR();
#pragma unroll
        for (int dvt = 0; dvt < 3; ++dvt) *(LAS unsigned long long*)(L + SL_ST + (dvt * 16 + l15) * ST_AQ + (16 * w + quad * 4) * 2) = pack4(Cf[dvt]);
        ml_s1(L0, pf, 1, bg1i, bg1f, mb, w == 0, tid, lane);
        ml_issue(pf, ((bf16*)(F.ws + WS_SIN)), ((float*)(F.ws + WS_SMALL)), b, ncf, nlat, 0, h, ocol, tid, lane);
        SBAR();
        ml_s2(L0, 1, lat, tid, w, l15, quad);
        SBAR();
        ml_s4(L0, L + SL_ST + ST_DIR, OUT + (lat ? (size_t)b * SEQ + cb + (size_t)otok * 64 : 0) * 1024 + ocl, lat, rmw, Cb, w, l15, quad);
        SBAR();
#pragma unroll
        for (int dvt = 0; dvt < 3; ++dvt) *(LAS unsigned long long*)(L + SL_ST + ST_DIR + (dvt * 16 + l15) * ST_AQ + (16 * w + quad * 4) * 2) = pack4(Cb[dvt]);
        if (step == 35) { VM_WAIT(); SBAR(); }
    }
    VM_WAIT(); SBAR();
}
struct MergeOrder {
    int pm, pn; bool valid;
    __device__ __forceinline__ bool next(int i, pg8::Unit& u) const {
        if (!valid || i >= 4) return false;
        u.pm = pm + (i == 0 ? 68 : (i == 2 ? 132 : 0));
        u.pn = pn + (i == 0 ? WT_BR1 : (i == 1 ? WT_MRG1 : (i == 2 ? WT_BR2 : WT_MRG2)));
        return true;
    }
    __device__ __forceinline__ void a_ready(const pg8::Unit&) const {}
    __device__ __forceinline__ void done(const pg8::Unit&) const {}
};

__global__ void __launch_bounds__(NWAVES * 64, 2) mk_fwd(Args args) {
    extern __shared__ __attribute__((aligned(16))) unsigned char lds[];
    Frame F;
    F.lds = (LAS unsigned char*)lds;
    F.MISC = (volatile LAS unsigned*)(F.lds + MISC_OFF);
    F.tid = threadIdx.x; F.lane = F.tid & 63; F.wave = __builtin_amdgcn_readfirstlane(F.tid >> 6);
    F.G = gridDim.x; { const int bx = blockIdx.x; F.vcu = (F.G % 8 == 0) ? (bx % 8) * (F.G / 8) + bx / 8 : bx; }
    F.ctl = (gu32*)(args.ws + WS_CTL);
    F.a = (KArgsPtr)__builtin_amdgcn_kernarg_segment_ptr(); F.ws = F.a->ws;
    for (int u = F.tid; u < (LDS_BYTES - LDSCTL_OFF) / 4; u += NWAVES * 64) ((LAS unsigned*)(F.lds + LDSCTL_OFF))[u] = 0u;
    __syncthreads();
    XcdBarrier bar; bar.bar = (unsigned*)(F.ctl + CW_BAR); bar.x = 0; bar.st = nullptr;
    if (N_LAUNCHES != PER_PHASE) bar = xcd_barrier_post((unsigned*)(F.ctl + CW_BAR), F.MISC + 8);
#define GRID_BAR(seam) do { if (N_LAUNCHES == PER_PHASE) { if (F.tid == 0) __hip_atomic_store(F.ctl + CW_TMO, 0xBADBA0u | (unsigned)(seam), RLX_AGENT); } else { xcd_barrier(bar); } } while (0)
    const int lo = args.ph_lo, hi = args.ph_hi;
#define IN(k) (lo <= (k) && (k) < hi)
#define BOTH(k) (IN(k) && IN((k) + 1))
    const int gw = F.vcu * NWAVES + F.wave, NGW = F.G * NWAVES;

    if (IN(0)) { p0_prologue(F); if (BOTH(0)) GRID_BAR(0); }

    if (IN(1)) for (int rep = 0; rep <= ((MK_DUP >> 1) & 1); ++rep) { if (rep) GRID_BAR(100 + 1);
        for (int m = gw; m < MT; m += NGW) {
            const float* src = m < ML ? FIN(0) + (size_t)m * D : FIN(2) + (size_t)(m - ML) * D;
            const float* mod = ((float*)(F.ws + WS_CTL + CTL_MOD)) + (size_t)(m < ML ? (m >> 12) : 4) * 6144;
            norm_mod_row(F, src, -1.f, FIN(6), mod, mod + D, ((bf16*)(F.ws + WS_XN)) + (size_t)m * D);
        }
        if (rep == ((MK_DUP >> 1) & 1) && BOTH(1)) GRID_BAR(1);
    }

    if (IN(2)) for (int rep = 0; rep <= ((MK_DUP >> 2) & 1); ++rep) { if (rep) GRID_BAR(100 + 2);
        pg8::Gemm g{((bf16*)(F.ws + WS_XN)), ((bf16*)(F.ws + WS_WT)), MT, 17 * 256, D}; pg8::StaticOrder S; S.init(MT, 17 * 256, F.G, (int)blockIdx.x);
        pg8::EpiScanIn E{((bf16*)(F.ws + WS_SIN)), ((float*)(F.ws + WS_SMALL))};
        pg8::gemm_phase<pg8::EpiScanIn, pg8::StaticOrder, true, true>(F.lds + RING_OFF, g, S, E);
        if (rep == ((MK_DUP >> 2) & 1) && BOTH(2)) GRID_BAR(2);
    }

    if (IN(3)) {
        for (int it = F.vcu; it < 1088; it += F.G) pre_gla_item(F, it);
        for (int it = gw; it < 544; it += NGW) pre_halo_item(F, it);
        GRID_BAR(30);
        for (int it = F.vcu; it < 272; it += F.G) pre_conv_item(F, it);
        GRID_BAR(31);
        for (int rep = 0; rep <= ((MK_DUP >> 3) & 1); ++rep) {
            if (rep) GRID_BAR(103);
            for (int u = F.vcu; u < 256; u += F.G) {
                const int mixer = u >> 7, bh = (u >> 3) & 15, b = bh >> 2, h = bh & 3, slice = u & 7;
                const bool xpass = ((MK_DUP >> 3) & 1) && rep == 0;
                if (xpass && mixer != MK_DUPSEL) continue;
                if (mixer == 0) scan_gla(F, b, h, slice); else scan_mlstm(F, b, h, slice);
            }
        }
        if (BOTH(3)) GRID_BAR(3);
    }

    if (IN(4)) for (int rep = 0; rep <= ((MK_DUP >> 4) & 1); ++rep) { if (rep) GRID_BAR(100 + 4);
        pg8::Gemm g{((bf16*)(F.ws + WS_XN)), ((bf16*)(F.ws + WS_WT)) + (size_t)WT_OG * 256 * D, ML, 2048, D}; pg8::StaticOrder S; S.init(ML, 2048, F.G, (int)blockIdx.x);
        pg8::EpiOutGate E{(const bf16*)((float*)F.a->out), (const bf16*)((float*)F.a->out) + (size_t)ML * D, FIN(10), FIN(14), ((bf16*)(F.ws + WS_Y1)), ((bf16*)(F.ws + WS_Y2)), (LAS float*)(F.lds + EPI_ST_OFF)};
        pg8::gemm_phase<pg8::EpiOutGate, pg8::StaticOrder, true, true>(F.lds + RING_OFF, g, S, E);
        if (rep == ((MK_DUP >> 4) & 1) && BOTH(4)) GRID_BAR(4);
    }

    if (IN(5)) for (int rep = 0; rep <= ((MK_DUP >> 5) & 1); ++rep) { if (rep) GRID_BAR(100 + 5);
        pg8::StaticOrder SO; SO.init(ML, D, F.G, (int)blockIdx.x);
        pg8::Gemm g{((bf16*)(F.ws + WS_XN)), ((bf16*)(F.ws + WS_WT)), MT + 2 * ML, WT_TILES * 256, D};
        pg8::EpiMerge E{((float*)F.a->out), ((float*)(F.ws + WS_T2)), ((bf16*)(F.ws + WS_Y))};
        for (int r = 0;; ++r) { pg8::Unit t; MergeOrder S; S.valid = SO.next(r, t); if (!S.valid) break; S.pm = t.pm; S.pn = t.pn;
            pg8::gemm_phase<pg8::EpiMerge, MergeOrder, true, true>(F.lds + RING_OFF, g, S, E); }
        if (rep == ((MK_DUP >> 5) & 1) && BOTH(5)) GRID_BAR(5);
    }

    if (IN(6)) {
        pg8::Gemm g{((bf16*)(F.ws + WS_Y)), ((bf16*)(F.ws + WS_WT)) + (size_t)WT_OUT * 256 * D, ML, D, D}; pg8::StaticOrder S; S.init(ML, D, F.G, (int)blockIdx.x);
        pg8::EpiResid E{FIN(0), ((float*)F.a->out), ((float*)(F.ws + WS_CTL + CTL_MOD)), 2, ((float*)(F.ws + WS_CTL + CTL_SS1))};
        pg8::gemm_phase<pg8::EpiResid, pg8::StaticOrder, true, true>(F.lds + RING_OFF, g, S, E);
        if (BOTH(6)) GRID_BAR(6);
    }

    if (IN(7)) {
        for (int m = gw; m < ML; m += NGW) {
            const float* mod = ((float*)(F.ws + WS_CTL + CTL_MOD)) + (size_t)(m >> 12) * 6144;
            const float ss = __hip_atomic_load(((float*)(F.ws + WS_CTL + CTL_SS1)) + m, RLX_AGENT);
            norm_mod_row(F, ((float*)F.a->out) + (size_t)m * D, ss, FIN(18), mod + 3 * D, mod + 4 * D, ((bf16*)(F.ws + WS_XN)) + (size_t)m * D);
        }
        if (BOTH(7)) GRID_BAR(7);
    }

    if (IN(8)) for (int rep = 0; rep <= ((MK_DUP >> 8) & 1); ++rep) { if (rep) GRID_BAR(100 + 8);
        pg8::Gemm g{((bf16*)(F.ws + WS_XN)), ((bf16*)(F.ws + WS_WT)) + (size_t)WT_FFN1 * 256 * D, ML, 2 * DFF, D}; pg8::StaticOrder S; S.init(ML, 2 * DFF, F.G, (int)blockIdx.x);
        pg8::EpiSwiglu E{((bf16*)(F.ws + WS_HF))};
        pg8::gemm_phase<pg8::EpiSwiglu, pg8::StaticOrder, true, true>(F.lds + RING_OFF, g, S, E);
        if (rep == ((MK_DUP >> 8) & 1) && BOTH(8)) GRID_BAR(8);
    }

    if (IN(9)) {
        pg8::Gemm g{((bf16*)(F.ws + WS_HF)), ((bf16*)(F.ws + WS_W2T)), ML, D, DFF}; pg8::StaticOrder S; S.init(ML, D, F.G, (int)blockIdx.x);
        pg8::EpiResid E{((float*)F.a->out), ((float*)F.a->out), ((float*)(F.ws + WS_CTL + CTL_MOD)), 5, ((float*)(F.ws + WS_CTL + CTL_SS2))};
        pg8::gemm_phase<pg8::EpiResid, pg8::StaticOrder, true, true>(F.lds + RING_OFF, g, S, E);
        if (BOTH(9)) GRID_BAR(9);
    }

    if (IN(10)) {
        for (int m = gw; m < ML; m += NGW) {
            const float ss = __hip_atomic_load(((float*)(F.ws + WS_CTL + CTL_SS2)) + m, RLX_AGENT);
            const float rstd = 1.f / sqrtf(ss * (1.f / D) + RMS_EPS);
            GAS f32x4* xr = (GAS f32x4*)(((float*)F.a->out) + (size_t)m * D) + F.lane;
#pragma unroll
            for (int j = 0; j < 4; ++j) { const f32x4 gv = ((const GAS f32x4*)FIN(21))[F.lane + 64 * j]; xr[64 * j] = xr[64 * j] * rstd * gv; }
        }
    }
#undef IN
#undef BOTH
}

extern "C" void kernel_launch(void* const* d_in, const int* in_sizes, int n_in, void* d_out, int out_size, void* d_ws, size_t ws_size, hipStream_t stream) {
    static int grid = 0;
    if (grid == 0) {
        if (n_in != 22 || in_sizes[0] != ML * D || out_size != ML * D || ws_size < WS_END) { fprintf(stderr, "kernel_launch: unexpected shapes (n_in %d, in0 %d, out %d, ws %zu)\n", n_in, n_in > 0 ? in_sizes[0] : -1, out_size, ws_size); grid = -1; return; }
        int dev = 0, cus = 0;
        if (hipGetDevice(&dev) != hipSuccess || hipDeviceGetAttribute(&cus, hipDeviceAttributeMultiprocessorCount, dev) != hipSuccess) { grid = -1; return; }
        if (hipFuncSetAttribute((const void*)mk_fwd, hipFuncAttributeMaxDynamicSharedMemorySize, LDS_BYTES) != hipSuccess) { fprintf(stderr, "kernel_launch: hipFuncSetAttribute failed\n"); grid = -1; return; }
        int per_cu = 0;
        if (hipOccupancyMaxActiveBlocksPerMultiprocessor(&per_cu, (const void*)mk_fwd, NWAVES * 64, LDS_BYTES) != hipSuccess || per_cu < 1) fprintf(stderr, "kernel_launch: occupancy query reports %d\n", per_cu);
        (void)hipGetLastError();
        grid = cus;
    }
    if (grid < 0) return;
    if (hipMemsetAsync((char*)d_ws + WS_CTL, 0, CTL_ZERO_BYTES, stream) != hipSuccess) return;
    Args a{};
    for (int i = 0; i < 22; ++i) a.in[i] = (const float*)d_in[i];
    a.out = (float*)d_out; a.ws = (unsigned char*)d_ws;
    for (int li = 0; li < N_LAUNCHES; ++li) {
        a.ph_lo = (N_LAUNCHES == PER_PHASE) ? li : 0; a.ph_hi = (N_LAUNCHES == PER_PHASE) ? li + 1 : PER_PHASE; a.li = li;
        hipLaunchKernelGGL(mk_fwd, dim3(grid), dim3(NWAVES * 64), LDS_BYTES, stream, a);
    }
}
```

```cpp
#include <hip/hip_runtime.h>
#include <cstdio>
#include <cstdint>
#ifndef MK_N_LAUNCHES
#define MK_N_LAUNCHES 1
#endif
#ifndef MK_PROBE
#define MK_PROBE 2
#endif
#ifndef MK_DUPSEL
#define MK_DUPSEL 0
#endif
#ifndef MK_DUP
#define MK_DUP 0
#endif
namespace pg8 {
#define PG8_LAS __attribute__((address_space(3)))
typedef unsigned short bf16_t;
typedef short bf16x8 __attribute__((ext_vector_type(8)));
typedef float f32x4 __attribute__((ext_vector_type(4)));
typedef unsigned u32x4 __attribute__((ext_vector_type(4)));
constexpr int BM = 256, BK = 64, HALF = 128, HTB = HALF * BK * 2  , STAGE_BYTES = 8 * HTB, NXCD = 8, WGM = 8;

__host__ __device__ __forceinline__ int lds_byte(int r, int c) { const int st = (r >> 4) * 2 + (c >> 5), rr = r & 15, cc = c & 31, ob = rr * 64 + cc * 2; return st * 1024 + (ob ^ (((ob >> 9) & 1) << 5)); }
__host__ __device__ __forceinline__ void stage_rc(int b, int& R, int& C) { const int st = b / 1024, sb = b % 1024, swz = sb ^ (((sb >> 9) & 1) << 5); R = (st >> 1) * 16 + swz / 64; C = (st & 1) * 32 + (swz % 64) / 2; }
__host__ __device__ __forceinline__ int perm32(int rho) { const int n = rho >> 4, i = rho & 15; return 8 * (i >> 2) + 4 * n + (i & 3); }

struct Unit { int pm, pn; };
struct Gemm { const bf16_t* A; const bf16_t* Bt; int M, N, K; };

struct StaticOrder {
    int nM, nN, nwg, G, c;
    __host__ __device__ void init(int M, int N, int G_, int c_) { nM = M / BM; nN = N / BM; nwg = nM * nN; G = G_; c = c_; }
    __host__ __device__ bool next(int i, Unit& u) const {
        const long L = (long)i * G + c; if (L >= nwg) return false;
        int wgid = (int)L; { const int q = nwg / NXCD, r = nwg % NXCD, xcd = wgid % NXCD, off = wgid / NXCD; wgid = (xcd < r ? xcd * (q + 1) : r * (q + 1) + (xcd - r) * q) + off; }
        const int nig = WGM * nN, gid = wgid / nig, fm = gid * WGM, gsz = (nM - fm) < WGM ? (nM - fm) : WGM;
        u.pm = fm + ((wgid % nig) % gsz); u.pn = (wgid % nig) / gsz; return true;
    }
    __device__ __forceinline__ void a_ready(const Unit&) const {}
    __device__ __forceinline__ void done(const Unit&) const {}
};

typedef float f32x2c __attribute__((ext_vector_type(2))); typedef __bf16 bf16x2c __attribute__((ext_vector_type(2)));
__device__ __forceinline__ unsigned cvt_pk_bf16(float lo, float hi) { const f32x2c v = {lo, hi}; const bf16x2c b = __builtin_convertvector(v, bf16x2c); return __builtin_bit_cast(unsigned, b); }
typedef float f32x2 __attribute__((ext_vector_type(2)));
__device__ __forceinline__ float sigm_f(float x) { return __builtin_amdgcn_rcpf(1.f + __expf(-x)); }
__device__ __forceinline__ float silu_f(float x) { return x * sigm_f(x); }
__device__ __forceinline__ float bf_lo(unsigned w) { return __uint_as_float(w << 16); }
__device__ __forceinline__ float bf_hi(unsigned w) { return __uint_as_float(w & 0xffff0000u); }
__device__ __forceinline__ u32x4 pack8(const f32x4& a, const f32x4& b) { u32x4 w; w.x = cvt_pk_bf16(a[0], a[1]); w.y = cvt_pk_bf16(a[2], a[3]); w.z = cvt_pk_bf16(b[0], b[1]); w.w = cvt_pk_bf16(b[2], b[3]); return w; }

struct EpiScanIn {
    static constexpr bool PERM = true, AFTER_DRAIN = false;
    bf16_t* SIN; float* SMALL;
    __device__ __forceinline__ void operator()(const f32x4 (&acc)[2][2][4][2], const Unit& u, int wr, int wc, int fr, int fq) const {
        const int row0 = u.pm * BM + wr * 64 + fr;
        if (u.pn < 16) {
#pragma unroll
            for (int ai = 0; ai < 2; ++ai)
#pragma unroll
                for (int m = 0; m < 4; ++m) { bf16_t* rowp = SIN + (size_t)(row0 + ai * HALF + m * 16) * 4096 + u.pn * BM + wc * 32 + 8 * fq;
#pragma unroll
                    for (int bj = 0; bj < 2; ++bj) *(u32x4*)(rowp + bj * HALF) = pack8(acc[ai][bj][m][0], acc[ai][bj][m][1]); }
        } else if (wc < 2) {
#pragma unroll
            for (int ai = 0; ai < 2; ++ai)
#pragma unroll
                for (int m = 0; m < 4; ++m) { float* p = SMALL + (size_t)(row0 + ai * HALF + m * 16) * 64 + wc * 32 + 8 * fq;
                    *(f32x4*)p = acc[ai][0][m][0]; *(f32x4*)(p + 4) = acc[ai][0][m][1]; }
        }
    }
};

struct EpiOutGate {
    static constexpr bool PERM = true, AFTER_DRAIN = false;
    const bf16_t* OHo; const bf16_t* OHh; const float* gg; const float* mg; bf16_t* Y1; bf16_t* Y2; PG8_LAS float* st;
    __device__ __forceinline__ void operator()(const f32x4 (&acc)[2][2][4][2], const Unit& u, int wr, int wc, int fr, int fq) const {
        const bool isg = u.pn < 4; const int head = u.pn & 3;
        const bf16_t* src = (isg ? OHo : OHh) + head * 256; const float* gain = (isg ? gg : mg) + head * 256; bf16_t* dst = (isg ? Y1 : Y2) + head * 256;
        const int row0 = u.pm * BM + wr * 64 + fr, cb = wc * 32 + 8 * fq;
#pragma unroll
        for (int ai = 0; ai < 2; ++ai)
#pragma unroll
            for (int m = 0; m < 4; ++m) { float s = 0.f; const bf16_t* rp = src + (size_t)(row0 + ai * HALF + m * 16) * 1024 + cb;
#pragma unroll
                for (int bj = 0; bj < 2; ++bj) { const u32x4 w = *(const u32x4*)(rp + bj * HALF);
                    float a; a = bf_lo(w.x); s += a * a; a = bf_hi(w.x); s += a * a; a = bf_lo(w.y); s += a * a; a = bf_hi(w.y); s += a * a;
                    a = bf_lo(w.z); s += a * a; a = bf_hi(w.z); s += a * a; a = bf_lo(w.w); s += a * a; a = bf_hi(w.w); s += a * a; }
                s += __shfl_xor(s, 16); s += __shfl_xor(s, 32);
                if (fq == 0) st[(ai * HALF + wr * 64 + m * 16 + fr) * 4 + wc] = s; }
        asm volatile("s_waitcnt lgkmcnt(0)" ::: "memory"); __builtin_amdgcn_s_barrier(); asm volatile("" ::: "memory");
        f32x4 g8[2][2];
#pragma unroll
        for (int bj = 0; bj < 2; ++bj) { g8[bj][0] = *(const f32x4*)(gain + cb + bj * HALF); g8[bj][1] = *(const f32x4*)(gain + cb + bj * HALF + 4); }
#pragma unroll
        for (int ai = 0; ai < 2; ++ai)
#pragma unroll
            for (int m = 0; m < 4; ++m) { const int rl = ai * HALF + wr * 64 + m * 16 + fr; const f32x4 t = *(const PG8_LAS f32x4*)(st + rl * 4);
                const float rstd = __builtin_amdgcn_rsqf(((t[0] + t[1]) + (t[2] + t[3])) * (1.f / 256.f) + 1e-6f);
                const bf16_t* rp = src + (size_t)(row0 + ai * HALF + m * 16) * 1024 + cb; bf16_t* dp = dst + (size_t)(row0 + ai * HALF + m * 16) * 1024 + cb;
#pragma unroll
                for (int bj = 0; bj < 2; ++bj) { const u32x4 w = *(const u32x4*)(rp + bj * HALF);
                    f32x4 o0 = {bf_lo(w.x), bf_hi(w.x), bf_lo(w.y), bf_hi(w.y)}, o1 = {bf_lo(w.z), bf_hi(w.z), bf_lo(w.w), bf_hi(w.w)};
                    f32x4 a0 = acc[ai][bj][m][0], a1 = acc[ai][bj][m][1];
#pragma unroll
                    for (int e = 0; e < 4; ++e) { a0[e] = isg ? silu_f(a0[e]) : sigm_f(a0[e]); a1[e] = isg ? silu_f(a1[e]) : sigm_f(a1[e]); }
                    o0 = o0 * rstd * g8[bj][0] * a0; o1 = o1 * rstd * g8[bj][1] * a1;
                    *(u32x4*)(dp + bj * HALF) = pack8(o0, o1); } }
        asm volatile("s_waitcnt lgkmcnt(0)" ::: "memory"); __builtin_amdgcn_s_barrier(); asm volatile("" ::: "memory");
    }
};

struct EpiMerge {
    static constexpr bool PERM = true, AFTER_DRAIN = false;
    float* T; float* T2; bf16_t* Y;
    __device__ __forceinline__ void operator()(const f32x4 (&acc)[2][2][4][2], const Unit& u, int wr, int wc, int fr, int fq) const {
        const int step = u.pn >= 37 ? 2 : (u.pn >= 33 ? 0 : (u.pn >= 29 ? 3 : 1));
        const int opm = u.pm - (step == 0 ? 68 : (step == 2 ? 132 : 0)), opn = (u.pn - 25) & 3;
        const size_t tb = ((size_t)(opm * 4 + opn) * 32) * 512 + threadIdx.x;
        f32x4* t = (f32x4*)T + tb; f32x4* t2 = (f32x4*)T2 + tb;
        const int row0 = opm * BM + wr * 64 + fr, cb = opn * BM + wc * 32 + 8 * fq;
#pragma unroll
        for (int ai = 0; ai < 2; ++ai)
#pragma unroll
            for (int m = 0; m < 4; ++m)
#pragma unroll
                for (int bj = 0; bj < 2; ++bj) {
                    const int j0 = ((ai * 2 + bj) * 4 + m) * 2;
                    if (step == 0) { t[(size_t)j0 * 512] = acc[ai][bj][m][0]; t[(size_t)(j0 + 1) * 512] = acc[ai][bj][m][1]; }
                    else if (step == 2) { t2[(size_t)j0 * 512] = acc[ai][bj][m][0]; t2[(size_t)(j0 + 1) * 512] = acc[ai][bj][m][1]; }
                    else {
                        f32x4 s0 = acc[ai][bj][m][0], s1 = acc[ai][bj][m][1];
#pragma unroll
                        for (int e = 0; e < 4; ++e) { s0[e] = sigm_f(s0[e]); s1[e] = sigm_f(s1[e]); }
                        if (step == 1) { t[(size_t)j0 * 512] = t[(size_t)j0 * 512] * s0; t[(size_t)(j0 + 1) * 512] = t[(size_t)(j0 + 1) * 512] * s1; }
                        else { const f32x4 y0 = t[(size_t)j0 * 512] + t2[(size_t)j0 * 512] * s0, y1 = t[(size_t)(j0 + 1) * 512] + t2[(size_t)(j0 + 1) * 512] * s1;
                            *(u32x4*)(Y + (size_t)(row0 + ai * HALF + m * 16) * 1024 + cb + bj * HALF) = pack8(y0, y1); }
                    }
                }
    }
};

struct EpiResid {
    static constexpr bool PERM = false, AFTER_DRAIN = false;
    const float* base; float* out; const float* mod; int gidx; float* ss;
    __device__ __forceinline__ void operator()(const f32x4 (&acc)[2][2][4][2], const Unit& u, int wr, int wc, int fr, int fq) const {
        const float* gate = mod + (size_t)(u.pm >> 4) * 6144 + gidx * 1024;
        const int row0 = u.pm * BM + wr * 64 + fr, col0 = u.pn * BM + wc * 32 + 4 * fq;
        f32x4 gv[2][2];
#pragma unroll
        for (int bj = 0; bj < 2; ++bj)
#pragma unroll
            for (int n = 0; n < 2; ++n) gv[bj][n] = *(const f32x4*)(gate + col0 + bj * HALF + n * 16);
#pragma unroll
        for (int ai = 0; ai < 2; ++ai)
#pragma unroll
            for (int m = 0; m < 4; ++m) { const int row = row0 + ai * HALF + m * 16; const size_t off = (size_t)row * 1024 + col0; float s = 0.f;
#pragma unroll
                for (int bj = 0; bj < 2; ++bj)
#pragma unroll
                    for (int n = 0; n < 2; ++n) { const f32x4 xv = *(const f32x4*)(base + off + bj * HALF + n * 16); const f32x4 o = xv + gv[bj][n] * acc[ai][bj][m][n];
                        *(f32x4*)(out + off + bj * HALF + n * 16) = o; s += (o[0] * o[0] + o[1] * o[1]) + (o[2] * o[2] + o[3] * o[3]); }
                s += __shfl_xor(s, 16); s += __shfl_xor(s, 32);
                if (fq == 0) atomicAdd(ss + row, s); }
    }
};

struct EpiSwiglu {
    static constexpr bool PERM = true, AFTER_DRAIN = false;
    bf16_t* Hf;
    __device__ __forceinline__ void operator()(const f32x4 (&acc)[2][2][4][2], const Unit& u, int wr, int wc, int fr, int fq) const {
        const int row0 = u.pm * BM + wr * 64 + fr, cb = u.pn * HALF + wc * 32 + 8 * fq;
#pragma unroll
        for (int ai = 0; ai < 2; ++ai)
#pragma unroll
            for (int m = 0; m < 4; ++m) { f32x4 h0 = acc[ai][0][m][0], h1 = acc[ai][0][m][1];
#pragma unroll
                for (int e = 0; e < 4; ++e) { h0[e] = silu_f(h0[e]) * acc[ai][1][m][0][e]; h1[e] = silu_f(h1[e]) * acc[ai][1][m][1][e]; }
                *(u32x4*)(Hf + (size_t)(row0 + ai * HALF + m * 16) * 2816 + cb) = pack8(h0, h1); }
    }
};
template <class Epi, class Sched, bool ALIGN_EPI = false, bool SP2 = false>
__device__ __forceinline__ void gemm_phase(PG8_LAS unsigned char* lds, const Gemm g, const Sched& S, const Epi& E) {
    const int tid = threadIdx.x, wid = __builtin_amdgcn_readfirstlane(tid >> 6), lane = tid & 63, wr = wid >> 2, wc = wid & 3, fr = lane & 15, fq = lane >> 4;
    const int K = g.K, nt = K / BK;
    unsigned voffA[2], voffB[2];
#pragma unroll
    for (int i = 0; i < 2; ++i) { int R, C; stage_rc(tid * 16 + i * 8192, R, C); const int Rb = Epi::PERM ? ((R & ~31) + perm32(R & 31)) : R;
        voffA[i] = (unsigned)(R * K + C) * 2u; voffB[i] = (unsigned)(Rb * K + C) * 2u; }
    const size_t kstep = (size_t)(BK * 2);
    const size_t hstep = (size_t)HALF * K * 2;
    const size_t tstep = 2 * hstep;
    const unsigned ldsw = (unsigned)wid * 1024u;
    const int aoff = lds_byte(wr * 64 + fr, fq * 8), boff = lds_byte(wc * 32 + fr, fq * 8);
#define PG8_SA(b, h) (((b) * 2 + (h)) * HTB)
#define PG8_SB(b, h) ((4 + (b) * 2 + (h)) * HTB)
#define PG8_STAGE(bufoff, gbase, voff) do { _Pragma("unroll") for (int _i = 0; _i < 2; ++_i) \
        __builtin_amdgcn_global_load_lds((const unsigned*)((const char*)(gbase) + (voff)[_i]), (PG8_LAS unsigned*)(lds + (bufoff) + ldsw + _i * 8192), 16, 0, 0); } while (0)
#define PG8_LDA(dst, b, h) do { _Pragma("unroll") for (int m = 0; m < 4; ++m) _Pragma("unroll") for (int k = 0; k < 2; ++k) dst[m][k] = *(const PG8_LAS bf16x8*)(lds + PG8_SA(b, h) + aoff + m * 2048 + k * 1024); } while (0)
#define PG8_LDB(dst, b, h) do { _Pragma("unroll") for (int n = 0; n < 2; ++n) _Pragma("unroll") for (int k = 0; k < 2; ++k) dst[n][k] = *(const PG8_LAS bf16x8*)(lds + PG8_SB(b, h) + boff + n * 2048 + k * 1024); } while (0)
#define PG8_MMA(ai, bj, At, Bt) do { __builtin_amdgcn_s_setprio(1); _Pragma("unroll") for (int m = 0; m < 4; ++m) _Pragma("unroll") for (int n = 0; n < 2; ++n) _Pragma("unroll") for (int k = 0; k < 2; ++k) \
        acc[ai][bj][m][n] = __builtin_amdgcn_mfma_f32_16x16x32_bf16(Bt[n][k], At[m][k], acc[ai][bj][m][n], 0, 0, 0); __builtin_amdgcn_s_setprio(0); } while (0)
#define PG8_WAIT_V(n) asm volatile("s_waitcnt vmcnt(" #n ")" ::: "memory")
#define PG8_WAIT_L(n) asm volatile("s_waitcnt lgkmcnt(" #n ")" ::: "memory")
#define PG8_BAR __builtin_amdgcn_s_barrier()
#define PG8_SCHED __builtin_amdgcn_sched_barrier(0)
    Unit cur, nxt; int ui = 0;
    if (!S.next(0, cur)) return;
    f32x4 acc[2][2][4][2];
#pragma unroll
    for (int a = 0; a < 2; ++a)
#pragma unroll
        for (int b = 0; b < 2; ++b)
#pragma unroll
            for (int m = 0; m < 4; ++m)
#pragma unroll
                for (int n = 0; n < 2; ++n) acc[a][b][m][n] = (f32x4){0.f, 0.f, 0.f, 0.f};
    bf16x8 At[4][2], B0[2][2], B1[2][2];
    const char* cA = (const char*)g.A + (size_t)cur.pm * tstep; const char* cB = (const char*)g.Bt + (size_t)cur.pn * tstep;
    S.a_ready(cur);
    if constexpr (SP2) {
        PG8_STAGE(PG8_SB(0, 0), cB, voffB); PG8_STAGE(PG8_SB(0, 1), cB + hstep, voffB); PG8_STAGE(PG8_SA(0, 0), cA, voffA); PG8_STAGE(PG8_SA(0, 1), cA + hstep, voffA);
        if (wr == 1) PG8_BAR;
        PG8_WAIT_V(2); PG8_BAR;
        PG8_STAGE(PG8_SB(1, 0), cB + kstep, voffB); PG8_STAGE(PG8_SA(1, 0), cA + kstep, voffA); PG8_STAGE(PG8_SB(1, 1), cB + hstep + kstep, voffB);
        PG8_WAIT_V(6); PG8_BAR;
    } else {
        PG8_STAGE(PG8_SB(0, 0), cB, voffB); PG8_STAGE(PG8_SA(0, 0), cA, voffA); PG8_STAGE(PG8_SB(0, 1), cB + hstep, voffB); PG8_STAGE(PG8_SA(0, 1), cA + hstep, voffA);
        if (wr == 1) PG8_BAR;
        PG8_WAIT_V(4); PG8_BAR;
        PG8_STAGE(PG8_SB(1, 0), cB + kstep, voffB); PG8_STAGE(PG8_SA(1, 0), cA + kstep, voffA); PG8_STAGE(PG8_SB(1, 1), cB + hstep + kstep, voffB);
        PG8_WAIT_V(6); PG8_BAR;
    }
    for (;;) {
        const bool has_next = S.next(ui + 1, nxt);
        const char* nA = has_next ? (const char*)g.A + (size_t)nxt.pm * tstep : cA; const char* nB = has_next ? (const char*)g.Bt + (size_t)nxt.pn * tstep : cB;
        for (int t = 0; t < nt; t += 2) {
            const bool last = (t == nt - 2);
            const char* a1 = cA + (size_t)(t + 1) * kstep;
            const char* a2 = last ? nA : cA + (size_t)(t + 2) * kstep; const char* b2 = last ? nB : cB + (size_t)(t + 2) * kstep;
            const char* a3 = a2 + kstep; const char* b3 = b2 + kstep;
            if (last && has_next) S.a_ready(nxt);
            if constexpr (SP2) {
            PG8_LDB(B0, 0, 0); PG8_LDB(B1, 0, 1); PG8_SCHED; PG8_LDA(At, 0, 0); PG8_STAGE(PG8_SA(1, 1), a1 + hstep, voffA);
            PG8_WAIT_V(8); PG8_WAIT_L(0); PG8_BAR; PG8_MMA(0, 0, At, B0); PG8_MMA(0, 1, At, B1); PG8_BAR; PG8_SCHED;
            PG8_LDA(At, 0, 1); PG8_STAGE(PG8_SB(0, 0), b2, voffB); PG8_STAGE(PG8_SB(0, 1), b2 + hstep, voffB); PG8_STAGE(PG8_SA(0, 0), a2, voffA);
            PG8_WAIT_V(8); PG8_WAIT_L(0); PG8_BAR; PG8_MMA(1, 0, At, B0); PG8_MMA(1, 1, At, B1); PG8_BAR; PG8_SCHED;
            PG8_LDB(B0, 1, 0); PG8_LDB(B1, 1, 1); PG8_SCHED; PG8_LDA(At, 1, 0); PG8_STAGE(PG8_SA(0, 1), a2 + hstep, voffA);
            PG8_WAIT_V(8); PG8_WAIT_L(0); PG8_BAR; PG8_MMA(0, 0, At, B0); PG8_MMA(0, 1, At, B1); PG8_BAR; PG8_SCHED;
            PG8_LDA(At, 1, 1); PG8_STAGE(PG8_SB(1, 0), b3, voffB); PG8_STAGE(PG8_SB(1, 1), b3 + hstep, voffB); PG8_STAGE(PG8_SA(1, 0), a3, voffA);
            PG8_WAIT_V(8); PG8_WAIT_L(0); PG8_BAR; PG8_MMA(1, 0, At, B0); PG8_MMA(1, 1, At, B1); PG8_BAR; PG8_SCHED;
            } else {
            PG8_LDB(B0, 0, 0); PG8_SCHED; PG8_LDA(At, 0, 0); PG8_STAGE(PG8_SA(1, 1), a1 + hstep, voffA);
            PG8_WAIT_L(8); PG8_BAR; PG8_WAIT_L(0); PG8_MMA(0, 0, At, B0); PG8_BAR; PG8_SCHED;
            PG8_LDB(B1, 0, 1); PG8_STAGE(PG8_SB(0, 0), b2, voffB);
            PG8_BAR; PG8_WAIT_L(0); PG8_MMA(0, 1, At, B1); PG8_BAR;
            PG8_LDA(At, 0, 1); PG8_STAGE(PG8_SA(0, 0), a2, voffA);
            PG8_BAR; PG8_WAIT_L(0); PG8_MMA(1, 0, At, B0); PG8_BAR; PG8_SCHED;
            PG8_STAGE(PG8_SB(0, 1), b2 + hstep, voffB);
            PG8_WAIT_V(6); PG8_BAR; PG8_MMA(1, 1, At, B1); PG8_BAR;
            PG8_LDB(B0, 1, 0); PG8_SCHED; PG8_LDA(At, 1, 0); PG8_STAGE(PG8_SA(0, 1), a2 + hstep, voffA);
            PG8_WAIT_L(8); PG8_BAR; PG8_WAIT_L(0); PG8_MMA(0, 0, At, B0); PG8_BAR; PG8_SCHED;
            PG8_LDB(B1, 1, 1); PG8_STAGE(PG8_SB(1, 0), b3, voffB);
            PG8_BAR; PG8_WAIT_L(0); PG8_MMA(0, 1, At, B1); PG8_BAR;
            PG8_LDA(At, 1, 1); PG8_STAGE(PG8_SA(1, 0), a3, voffA);
            PG8_BAR; PG8_WAIT_L(0); PG8_MMA(1, 0, At, B0); PG8_BAR; PG8_SCHED;
            PG8_STAGE(PG8_SB(1, 1), b3 + hstep, voffB);
            PG8_WAIT_V(6); PG8_BAR; PG8_MMA(1, 1, At, B1); PG8_BAR;
            }
        }
        if constexpr (ALIGN_EPI) { if (wr == 0) PG8_BAR; }
        if constexpr (!Epi::AFTER_DRAIN) { E(acc, cur, wr, wc, fr, fq); S.done(cur); }
        if (!has_next) break;
#pragma unroll
        for (int a = 0; a < 2; ++a)
#pragma unroll
            for (int b = 0; b < 2; ++b)
#pragma unroll
                for (int m = 0; m < 4; ++m)
#pragma unroll
                    for (int n = 0; n < 2; ++n) acc[a][b][m][n] = (f32x4){0.f, 0.f, 0.f, 0.f};
        cur = nxt; cA = nA; cB = nB; ++ui;
        if constexpr (ALIGN_EPI) { if (wr == 1) PG8_BAR; }
    }
    PG8_WAIT_V(0);
    if constexpr (!ALIGN_EPI) { if (wr == 0) PG8_BAR; }
    PG8_BAR;
    if constexpr (Epi::AFTER_DRAIN) { E.fused(acc, cur, wr, wc, fr, fq, lds, wid, lane); S.done(cur); }
#undef PG8_SA
#undef PG8_SB
#undef PG8_STAGE
#undef PG8_LDA
#undef PG8_LDB
#undef PG8_MMA
#undef PG8_WAIT_V
#undef PG8_WAIT_L
#undef PG8_BAR
#undef PG8_SCHED
}
}
constexpr int NWAVES = 8;
constexpr int N_LAUNCHES = MK_N_LAUNCHES;
constexpr int PER_PHASE = 11;
constexpr int D = 1024, NB = 4, SEQ = 4096, CTXL = 256, ML = NB * SEQ, MC = NB * CTXL, MT = ML + MC;
constexpr int NIN = 8240, DFF = 2816;
constexpr float RMS_EPS = 1e-6f, QK_SCALE = 0.08838834764831845f;
constexpr int SC_GQ = 0, SC_GK = 512, SC_GV = 1024, SC_MQ = 2048, SC_MK = 2560, SC_MV = 3072;
constexpr int WT_OG = 17, WT_MRG1 = 25, WT_MRG2 = 29, WT_BR1 = 33, WT_BR2 = 37, WT_OUT = 41, WT_FFN1 = 45, WT_TILES = 67;
constexpr size_t MiB = 1u << 20;
constexpr size_t WS_CTL = 0, CTL_ZERO_BYTES = 1 * MiB;
constexpr size_t WS_WT = 2 * MiB;
constexpr size_t WS_W2T = 36 * MiB;
constexpr size_t WS_XN = 42 * MiB;
constexpr size_t WS_Y1 = 76 * MiB, WS_Y2 = 108 * MiB;
constexpr size_t WS_SIN = 76 * MiB;
constexpr size_t WS_SMALL = 212 * MiB;
constexpr size_t WS_EB = 217 * MiB;
constexpr size_t WS_ET = 251 * MiB;
constexpr size_t WS_HALO = 252 * MiB;
constexpr size_t WS_GV = 253 * MiB + 512 * 1024;
constexpr size_t WS_T2 = 140 * MiB;
constexpr size_t WS_Y = 204 * MiB;
constexpr size_t WS_HF = 76 * MiB;
constexpr size_t WS_END = 256 * MiB;
static_assert(WS_XN + (size_t)MT * D * 2 == WS_Y1 && WS_Y1 + (size_t)ML * D * 2 == WS_Y2 && WS_SIN + (size_t)MT * 4096 * 2 <= WS_SMALL && WS_SMALL + (size_t)MT * 64 * 4 <= 256 * MiB, "ws map");
static_assert(WS_Y2 + (size_t)ML * D * 2 <= WS_T2 && WS_T2 + 64 * MiB <= WS_Y && WS_HF + (size_t)ML * DFF * 2 <= WS_Y && WS_WT + (size_t)WT_TILES * 256 * D * 2 <= WS_W2T && WS_W2T + (size_t)D * DFF * 2 <= WS_XN, "ws map 2");
constexpr int CW_TMO = 0, CW_CODE = 1, CW_BAR = 4096;
constexpr size_t CTL_MOD = 65536, CTL_SS1 = 262144, CTL_SS2 = 327680;
constexpr int RING_OFF = 0, RING_BYTES = 131072, EPI_ST_OFF = RING_BYTES, LDSCTL_OFF = 155648, MISC_OFF = LDSCTL_OFF + 320, LDS_BYTES = 163840;
static_assert(MISC_OFF + 128 <= LDS_BYTES, "LDS map");

#define GAS __attribute__((address_space(1)))
#define LAS __attribute__((address_space(3)))
typedef unsigned short bf16;
typedef unsigned v4u __attribute__((ext_vector_type(4)));
typedef unsigned v2u __attribute__((ext_vector_type(2)));
typedef float f32x4 __attribute__((ext_vector_type(4)));
typedef short bf16x8 __attribute__((ext_vector_type(8)));
typedef GAS unsigned gu32;
#define RLX_AGENT __ATOMIC_RELAXED, __HIP_MEMORY_SCOPE_AGENT
#define LDS_WAIT() asm volatile("s_waitcnt lgkmcnt(0)" ::: "memory")
#define VM_WAIT() asm volatile("s_waitcnt vmcnt(0)" ::: "memory")
__device__ __forceinline__ unsigned f2bf(float f) { unsigned u = __builtin_bit_cast(unsigned, f); return (u + 0x7fffu + ((u >> 16) & 1u)) >> 16; }
__device__ __forceinline__ unsigned pk2(float lo, float hi) { return pg8::cvt_pk_bf16(lo, hi); }
__device__ __forceinline__ float bf2f(bf16 h) { return __uint_as_float((unsigned)h << 16); }
using pg8::bf_lo; using pg8::bf_hi;
__device__ __forceinline__ float logsig_f(float z) { return fminf(z, 0.f) - __logf(1.f + __expf(-fabsf(z))); }
#define XB_TMO      128
#define XB_XCNT(j)  (256  + 64 * (j))
#define XB_XSUB(j)  (1280 + 64 * (j))
#define XB_XGEN(j)  (2304 + 64 * (j))
#define XB_TOP      3328
#define XB_TOPGEN   3392
#define XCD_BAR_WORDS 3456
#define XB_SPIN_CAP (1u << 18)

__device__ __forceinline__ unsigned xb_ld(unsigned* p)              { return __hip_atomic_load(p, __ATOMIC_RELAXED, __HIP_MEMORY_SCOPE_AGENT); }
__device__ __forceinline__ unsigned xb_add(unsigned* p, unsigned v) { return __hip_atomic_fetch_add(p, v, __ATOMIC_RELAXED, __HIP_MEMORY_SCOPE_AGENT); }
__device__ __forceinline__ unsigned xb_xcc_id() { return (unsigned)__builtin_amdgcn_s_getreg((3 << 11) | 20) & 0xFu; }
#define XB_SPIN(cond, bar) do { unsigned _sp = 0; while (cond) { __builtin_amdgcn_s_sleep(1); \
    if ((++_sp & 255u) == 0u) { if (xb_ld(&(bar)[XB_TMO])) break; if (_sp > XB_SPIN_CAP) { atomicAdd(&(bar)[XB_TMO], 1u); break; } } } } while (0)

struct XcdBarrier {
    unsigned* bar; unsigned x;
    volatile LAS unsigned* st;
};

__device__ __forceinline__ XcdBarrier xcd_barrier_post(unsigned* bar, volatile LAS unsigned* st) {
    XcdBarrier b; b.bar = bar; b.x = xb_xcc_id(); b.st = st;
    if (threadIdx.x == 0) (void)xb_add(&bar[XB_XCNT(b.x)], 1u);
    return b;
}
__device__ __forceinline__ void xcd_barrier_complete(unsigned* bar, unsigned x, unsigned& nloc, unsigned& nx) {
    const unsigned G = gridDim.x * gridDim.y * gridDim.z;
    unsigned sum, cnt, mine, sp = 0u;
    for (;;) {
        sum = 0u; cnt = 0u; mine = 0u;
#pragma unroll
        for (unsigned j = 0; j < 16; ++j) { const unsigned c = xb_ld(&bar[XB_XCNT(j)]); sum += c; cnt += (c > 0u) ? 1u : 0u; mine = (j == x) ? c : mine; }
        if (sum == G) break;
        __builtin_amdgcn_s_sleep(1);
        if ((++sp & 255u) == 0u) { if (xb_ld(&bar[XB_TMO])) break; if (sp > XB_SPIN_CAP) { atomicAdd(&bar[XB_TMO], 1u); break; } }
    }
    nloc = mine > 0u ? mine : 1u; nx = cnt > 0u ? cnt : 1u;
}

__device__ __forceinline__ void xcd_barrier(const XcdBarrier& b) {
    asm volatile("s_waitcnt vmcnt(0)" ::: "memory");
    __syncthreads();
    if (threadIdx.x == 0) {
        unsigned* bar = b.bar;
        __builtin_amdgcn_s_waitcnt(0);
        unsigned nloc = b.st[0], nx = b.st[1];
        if (nloc == 0u) { xcd_barrier_complete(bar, b.x, nloc, nx); b.st[0] = nloc; b.st[1] = nx; }
        const unsigned old = xb_add(&bar[XB_XSUB(b.x)], 1u);
        const unsigned gen = old / nloc;
        if (old + 1u == (gen + 1u) * nloc) {
            __builtin_amdgcn_fence(__ATOMIC_RELEASE, "agent");
            asm volatile("s_waitcnt vmcnt(0)" ::: "memory");
            const unsigned og = xb_add(&bar[XB_TOP], 1u);
            const unsigned tg = og / nx;
            if (og + 1u == (tg + 1u) * nx) xb_add(&bar[XB_TOPGEN], 1u);
            else XB_SPIN(xb_ld(&bar[XB_TOPGEN]) == tg, bar);
            __builtin_amdgcn_fence(__ATOMIC_ACQUIRE, "agent");
            xb_add(&bar[XB_XGEN(b.x)], 1u);
            asm volatile("s_waitcnt vmcnt(0)" ::: "memory");
        } else {
            XB_SPIN(xb_ld(&bar[XB_XGEN(b.x)]) == gen, bar);
            __builtin_amdgcn_fence(__ATOMIC_ACQUIRE, "agent");
            asm volatile("s_waitcnt vmcnt(0)" ::: "memory");
        }
    }
    __syncthreads();
}
struct Args { const float* in[22]; float* out; unsigned char* ws; int ph_lo, ph_hi, li, pad; };
typedef __attribute__((address_space(4))) const Args* KArgsPtr;
struct Frame {
    LAS unsigned char* lds;
    volatile LAS unsigned* MISC;
    gu32* ctl;
    int tid, lane, wave;
    int vcu, G;
    KArgsPtr a; unsigned char* ws;
};
#define FIN(k) ((const float*)F.a->in[k])
__device__ __forceinline__ float wave_sum(float v) {
#pragma unroll
    for (int o = 1; o < 64; o <<= 1) v += __shfl_xor(v, o);
    return v;
}
__device__ __forceinline__ int map_col(int which, int off, int n) {
    if (which == 1) return off + n;
    if (which == 2) { const int isb = n >= DFF, j = isb ? n - DFF : n; return off + 256 * (j >> 7) + (isb ? 128 : 0) + (j & 127); }
    if (n < 2048) return n;
    if (n < 3072) return WT_OG * 256 + (n - 2048);
    if (n < 3104) return 4096 + (n - 3072);
    if (n < 4128) return 2048 + (n - 3104);
    if (n < 5152) return 3072 + (n - 4128);
    if (n < 6176) return (WT_OG + 4) * 256 + (n - 5152);
    if (n < 6192) return 4096 + 32 + (n - 6176);
    if (n < 7216) return WT_MRG1 * 256 + (n - 6192);
    return WT_MRG2 * 256 + (n - 7216);
}
__device__ __forceinline__ void p0_transpose_item(const float* W, int K, int N, bf16* WTb, int which, int off, LAS float* scr, int item, int lane) {
    const int nblk = (N + 31) / 32, kb = item / nblk, nb = item % nblk, k0 = 64 * kb, n0 = 32 * nb;
    const bool okc = n0 + (lane & 31) < N;
    float tv[32];
#pragma unroll
    for (int i = 0; i < 32; ++i) tv[i] = W[(size_t)(k0 + 2 * i + (lane >> 5)) * N + (okc ? n0 + (lane & 31) : n0)];
#pragma unroll
    for (int i = 0; i < 32; ++i) scr[(2 * i + (lane >> 5)) * 33 + (lane & 31)] = okc ? tv[i] : 0.f;
    LDS_WAIT(); asm volatile("" ::: "memory");
    const int c8 = lane & 7;
#pragma unroll
    for (int j = 0; j < 4; ++j) { const int n = (lane >> 3) + 8 * j; const LAS float* s = scr + (8 * c8) * 33 + n;
        v4u o; o.x = pk2(s[0 * 33], s[1 * 33]); o.y = pk2(s[2 * 33], s[3 * 33]); o.z = pk2(s[4 * 33], s[5 * 33]); o.w = pk2(s[6 * 33], s[7 * 33]);
        if (n0 + n < N) *(GAS v4u*)(WTb + (size_t)map_col(which, off, n0 + n) * K + k0 + 8 * c8) = o; }
    LDS_WAIT(); asm volatile("" ::: "memory");
}
__device__ __forceinline__ void p0_prologue(Frame& F) {
    LAS float* scr = (LAS float*)(F.lds + RING_OFF + F.wave * 16384);
    const int gw = F.vcu * NWAVES + F.wave, NGW = F.G * NWAVES;
    constexpr int I_IN = 16 * 258, I_BR = 16 * 32, I_F1 = 16 * 176, I_F2 = 44 * 32, I_MOD = 96 * 32;
    constexpr int NITEMS = I_IN + 3 * I_BR + I_F1 + I_F2 + I_MOD;
    for (int it = gw; it < NITEMS; it += NGW) {
        int r = it;
        if (r < I_MOD) {
            const int ncb = r >> 5, kb = r & 31, n = ncb * 64 + F.lane, kbase = kb * 32;
            float sA[5], acc[5];
#pragma unroll
            for (int q = 0; q < 5; ++q) { const float* src = q < 4 ? FIN(1) + q * D : FIN(3); const float a = src[kbase + (F.lane & 31)];
                sA[q] = a / (1.f + __expf(-a)); acc[q] = 0.f; }
            const float* wp = FIN(4) + (size_t)kbase * 6144 + n;
            float wv[32];
#pragma unroll
            for (int kk = 0; kk < 32; ++kk) wv[kk] = wp[(size_t)kk * 6144];
#pragma unroll
            for (int kk = 0; kk < 32; ++kk) {
#pragma unroll
                for (int q = 0; q < 5; ++q) acc[q] += __shfl(sA[q], kk) * wv[kk]; }
            const float bias = kb == 0 ? FIN(5)[n] : 0.f;
#pragma unroll
            for (int q = 0; q < 5; ++q) atomicAdd(((float*)(F.ws + WS_CTL + CTL_MOD)) + q * 6144 + n, acc[q] + bias);
            continue; }
        r -= I_MOD;
        if (r < I_IN) { p0_transpose_item(FIN(7), D, NIN, ((bf16*)(F.ws + WS_WT)), 0, 0, scr, r, F.lane); continue; } r -= I_IN;
        if (r < I_BR) { p0_transpose_item(FIN(15), D, D, ((bf16*)(F.ws + WS_WT)), 1, WT_BR1 * 256, scr, r, F.lane); continue; } r -= I_BR;
        if (r < I_BR) { p0_transpose_item(FIN(16), D, D, ((bf16*)(F.ws + WS_WT)), 1, WT_BR2 * 256, scr, r, F.lane); continue; } r -= I_BR;
        if (r < I_BR) { p0_transpose_item(FIN(17), D, D, ((bf16*)(F.ws + WS_WT)), 1, WT_OUT * 256, scr, r, F.lane); continue; } r -= I_BR;
        if (r < I_F1) { p0_transpose_item(FIN(19), D, 2 * DFF, ((bf16*)(F.ws + WS_WT)), 2, WT_FFN1 * 256, scr, r, F.lane); continue; } r -= I_F1;
        p0_transpose_item(FIN(20), DFF, D, ((bf16*)(F.ws + WS_W2T)), 1, 0, scr, r, F.lane);
    }
    { GAS v4u* z = (GAS v4u*)(((bf16*)(F.ws + WS_WT)) + (size_t)(4096 + 48) * D); const int n16 = 208 * 2048 / 16;
      for (int i = gw * 64 + F.lane; i < n16; i += NGW * 64) z[i] = (v4u){0u, 0u, 0u, 0u}; }
}
__device__ __forceinline__ void norm_mod_row(Frame& F, const float* xrow, float ssq_or_neg, const float* g, const float* shift, const float* scale, bf16* orow) {
    const GAS f32x4* xr = (const GAS f32x4*)xrow + F.lane;
    f32x4 v[4]; float s = 0.f;
#pragma unroll
    for (int j = 0; j < 4; ++j) { v[j] = xr[64 * j]; s += (v[j].x * v[j].x + v[j].y * v[j].y) + (v[j].z * v[j].z + v[j].w * v[j].w); }
    const float tot = ssq_or_neg >= 0.f ? ssq_or_neg : wave_sum(s);
    const float rstd = 1.f / sqrtf(tot * (1.f / D) + RMS_EPS);
    GAS unsigned long long* o8 = (GAS unsigned long long*)orow + F.lane;
#pragma unroll
    for (int j = 0; j < 4; ++j) { const f32x4 gv = ((const GAS f32x4*)g)[F.lane + 64 * j], sh = ((const GAS f32x4*)shift)[F.lane + 64 * j], sc = ((const GAS f32x4*)scale)[F.lane + 64 * j];
        const f32x4 y = (v[j] * rstd * gv) * (1.f + sc) + sh;
        o8[64 * j] = (unsigned long long)pk2(y.x, y.y) | ((unsigned long long)pk2(y.z, y.w) << 32); }
}
constexpr int TC = 128, NSTEP = 34, NCH = MT / TC;
constexpr int SL_AQ = 0, SL_AK = 34816, SL_PM = 69632, SL_VT = 104448, SL_VW = 113424, SL_F = 122400, SL_ST = 126496, ST_AQ = 272, ST_DIR = 33 * 272;
static_assert(SL_ST + 2 * ST_DIR <= LDSCTL_OFF, "scan LDS map");
#define MMA16(a, b, c) __builtin_amdgcn_mfma_f32_16x16x32_bf16((a), (b), (c), 0, 0, 0)
#define SBAR() do { asm volatile("s_waitcnt lgkmcnt(0)" ::: "memory"); __builtin_amdgcn_s_barrier(); asm volatile("" ::: "memory"); } while (0)
#define SCHED() __builtin_amdgcn_sched_barrier(0)
__device__ __forceinline__ bf16x8 ldf(LAS unsigned char* base, int row, int kb) { return *(const LAS bf16x8*)(base + row * ST_AQ + kb); }
__device__ __forceinline__ unsigned long long pack4(const f32x4& v) { return (unsigned long long)pk2(v[0], v[1]) | ((unsigned long long)pk2(v[2], v[3]) << 32); }
__device__ __forceinline__ void st_lds16(LAS unsigned char* p, float v) { *(LAS unsigned short*)p = (unsigned short)f2bf(v); }
__device__ __forceinline__ float fexp(float x) { return __builtin_amdgcn_exp2f(x * 1.4426950408889634f); }
__device__ __forceinline__ void out4(bf16* p, f32x4 v, bool rmw) {
    if (rmw) { const unsigned long long o = __hip_atomic_load((unsigned long long*)p, RLX_AGENT); const unsigned lo = (unsigned)o, hi = (unsigned)(o >> 32);
        v[0] += __uint_as_float(lo << 16); v[1] += __uint_as_float(lo & 0xffff0000u); v[2] += __uint_as_float(hi << 16); v[3] += __uint_as_float(hi & 0xffff0000u); }
    *(unsigned long long*)p = pack4(v);
}
__device__ __forceinline__ void stage_v(LAS unsigned char* L, const v4u w, int tid) {
    const int tok = tid >> 2, dv8 = (tid & 3) * 8;
    LAS unsigned char* p = L + SL_VT + dv8 * ST_AQ + tok * 2;
#pragma unroll
    for (int j = 0; j < 4; ++j) { *(LAS unsigned short*)(p + (2 * j) * ST_AQ) = (unsigned short)(w[j] & 0xffffu); *(LAS unsigned short*)(p + (2 * j + 1) * ST_AQ) = (unsigned short)(w[j] >> 16); }
}
typedef short v4i16_t __attribute__((ext_vector_type(4)));
__device__ __forceinline__ bf16x8 ldkt(LAS unsigned char* L, int ch0, int ks, int l15, int quad) {
    LAS unsigned char* p = L + SL_AK + (ks * 32 + quad * 8 + (l15 >> 2)) * ST_AQ + (ch0 + 4 * (l15 & 3)) * 2;
    const v4i16_t lo = __builtin_amdgcn_ds_read_tr16_b64_v4i16((LAS v4i16_t*)p), hi = __builtin_amdgcn_ds_read_tr16_b64_v4i16((LAS v4i16_t*)(p + 4 * ST_AQ));
    bf16x8 r; r[0] = lo[0]; r[1] = lo[1]; r[2] = lo[2]; r[3] = lo[3]; r[4] = hi[0]; r[5] = hi[1]; r[6] = hi[2]; r[7] = hi[3]; return r;
}
__device__ __forceinline__ void scores_half(LAS unsigned char* L, const bf16x8 (&fb)[4], int half, int l15, int quad, f32x4 (&sc)[4]) {
    bf16x8 fa[4][4];
#pragma unroll
    for (int mi = 0; mi < 4; ++mi)
#pragma unroll
        for (int ks = 0; ks < 4; ++ks) fa[mi][ks] = ldf(L + SL_AK, (4 * half + mi) * 16 + l15, ks * 64 + quad * 16);
    SCHED();
#pragma unroll
    for (int mi = 0; mi < 4; ++mi) { f32x4 a4 = {0.f, 0.f, 0.f, 0.f};
#pragma unroll
        for (int ks = 0; ks < 4; ++ks) a4 = MMA16(fa[mi][ks], fb[ks], a4);
        sc[mi] = a4; }
}

__device__ __forceinline__ void pre_gla_item(Frame& F, const int item) {
    LAS unsigned char* L = F.lds; const int tid = F.tid, w = F.wave, lane = F.lane, l15 = lane & 15, quad = lane >> 4;
    const int bh = item / NSTEP, cs = item % NSTEP, b = bh >> 2, h = bh & 3;
    const int rowbase = cs < 2 ? ML + b * CTXL + cs * TC : b * SEQ + (cs - 2) * TC;
    const int ch = 16 * w + l15;
    const float* SMALLp = (const float*)(F.ws + WS_SMALL);
    for (int dir = 0; dir < 2; ++dir) {
        bf16x8 wfr;
        { float wv[8];
#pragma unroll
          for (int j = 0; j < 8; ++j) wv[j] = quad < 2 ? FIN(8)[(size_t)(dir * 16 + quad * 8 + j) * 512 + 128 * h + ch] : 0.f;
          v4u t; t.x = pk2(wv[0], wv[1]); t.y = pk2(wv[2], wv[3]); t.z = pk2(wv[4], wv[5]); t.w = pk2(wv[6], wv[7]); wfr = __builtin_bit_cast(bf16x8, t); }
        const float bd = FIN(9)[dir * 512 + 128 * h + ch];
        float g[8][4], p[8][4]; float carry = 0.f;
#pragma unroll
        for (int tt = 0; tt < 8; ++tt) {
            bf16x8 afr;
            { const float* sp = SMALLp + (size_t)(rowbase + tt * 16 + l15) * 64 + dir * 16 + (quad & 1) * 8;
              const f32x4 a0 = *(const f32x4*)sp, a1 = *(const f32x4*)(sp + 4);
              v4u t; t.x = pk2(a0[0], a0[1]); t.y = pk2(a0[2], a0[3]); t.z = pk2(a1[0], a1[1]); t.w = pk2(a1[2], a1[3]);
              if (quad >= 2) t = (v4u){0u, 0u, 0u, 0u};
              afr = __builtin_bit_cast(bf16x8, t); }
            f32x4 z = {0.f, 0.f, 0.f, 0.f};
            z = MMA16(afr, wfr, z);
            float run = 0.f;
#pragma unroll
            for (int r = 0; r < 4; ++r) { g[tt][r] = logsig_f(z[r] + bd) * (1.f / 16.f); run += g[tt][r]; p[tt][r] = run; }
            float x = run, y = __shfl_up(x, 16); if (quad >= 1) x += y; y = __shfl_up(x, 32); if (quad >= 2) x += y;
            const float excl = x - run + carry;
#pragma unroll
            for (int r = 0; r < 4; ++r) p[tt][r] += excl;
            carry += __shfl(x, 48 + l15);
        }
        const float T = carry;
        if (quad == 0) ((float*)(F.ws + WS_ET))[(size_t)(dir * NCH + (rowbase >> 7)) * 512 + 128 * h + ch] = fexp(T);
#pragma unroll
        for (int tt = 0; tt < 8; ++tt)
#pragma unroll
            for (int r = 0; r < 4; ++r) { const int tok = tt * 16 + quad * 4 + r; const float bcum = dir == 0 ? p[tt][r] : T - p[tt][r] + g[tt][r];
                st_lds16(L + dir * 34816 + tok * ST_AQ + ch * 2, fexp(bcum)); }
    }
    SBAR();
    { const int tok0 = tid >> 4, c16 = tid & 15; bf16* EBp = (bf16*)(F.ws + WS_EB);
#pragma unroll
      for (int dir = 0; dir < 2; ++dir)
#pragma unroll
        for (int hh = 0; hh < 4; ++hh) { const int tok = tok0 + 32 * hh;
            *(v4u*)(EBp + ((size_t)dir * MT + rowbase + tok) * 512 + 128 * h + c16 * 8) = *(const LAS v4u*)(L + dir * 34816 + tok * ST_AQ + c16 * 16); } }
    SBAR();
}
__device__ __forceinline__ int ml_row(int b, int cs, int r) { return cs < 2 ? ML + b * CTXL + cs * TC + r : b * SEQ + (r & 63) * 64 + 2 * (cs - 2) + (r >> 6); }
__device__ __forceinline__ void pre_gate_item(Frame& F, const int item) {
    const int lane = F.lane; const int cs = item % NSTEP, h = (item / NSTEP) & 3, b = (item / (NSTEP * 4)) & 3, dir = item / (NSTEP * 16);
    const float* SMALLp = (const float*)(F.ws + WS_SMALL); const int gi = dir ? 2 : 0;
    const float bgi = FIN(13)[gi * 4 + h], bgf = FIN(13)[(gi + 1) * 4 + h];
    float li[2], lf[2], x[2], xm[2];
#pragma unroll
    for (int e = 0; e < 2; ++e) { const size_t row = (size_t)ml_row(b, cs, lane + 64 * e);
        li[e] = SMALLp[row * 64 + 32 + 4 * gi + h] + bgi; lf[e] = logsig_f(SMALLp[row * 64 + 32 + 4 * (gi + 1) + h] + bgf); x[e] = lf[e]; }
#pragma unroll
    for (int o = 1; o < 64; o <<= 1) {
#pragma unroll
        for (int e = 0; e < 2; ++e) { const float y = __shfl_up(x[e], o); if (lane >= o) x[e] += y; } }
    const float t0 = __shfl(x[0], 63), t1 = __shfl(x[1], 63), total = t0 + t1;
    x[1] += t0;
    float bv[2], av[2];
#pragma unroll
    for (int e = 0; e < 2; ++e) { bv[e] = dir == 0 ? x[e] : total - x[e] + lf[e]; av[e] = li[e] - bv[e]; xm[e] = av[e]; }
    if (dir == 0) {
#pragma unroll
        for (int o = 1; o < 64; o <<= 1) {
#pragma unroll
            for (int e = 0; e < 2; ++e) { const float y = __shfl_up(xm[e], o); if (lane >= o) xm[e] = fmaxf(xm[e], y); } }
        xm[1] = fmaxf(xm[1], __shfl(xm[0], 63));
    } else {
#pragma unroll
        for (int o = 1; o < 64; o <<= 1) {
#pragma unroll
            for (int e = 0; e < 2; ++e) { const float y = __shfl_down(xm[e], o); if (lane + o < 64) xm[e] = fmaxf(xm[e], y); } }
        xm[0] = fmaxf(xm[0], __shfl(xm[1], 0));
    }
    const float Mall = dir == 0 ? __shfl(xm[1], 63) : __shfl(xm[0], 0);
    float* gv = (float*)(F.ws + WS_GV) + (size_t)item * 400;
#pragma unroll
    for (int e = 0; e < 2; ++e) { gv[lane + 64 * e] = bv[e]; gv[128 + lane + 64 * e] = av[e]; gv[256 + lane + 64 * e] = xm[e]; }
    if (lane == 0) { gv[384] = total; gv[385] = Mall; }
}
__device__ __forceinline__ int mlc_row(int b, int cm, int r) { return cm < 4 ? ML + b * CTXL + cm * 64 + r : b * SEQ + r * 64 + (cm - 4); }
__device__ __forceinline__ void pre_halo_item(Frame& F, const int item) {
    const int ci = item >> 1, which = item & 1, b = ci / 68, cm = ci % 68;
    const v4u* src = (const v4u*)((bf16*)(F.ws + WS_SIN) + (size_t)mlc_row(b, cm, which ? 63 : 0) * 4096 + SC_MQ);
    v4u* dst = (v4u*)((bf16*)(F.ws + WS_HALO) + (size_t)item * 1024);
    dst[F.lane] = src[F.lane]; dst[F.lane + 64] = src[F.lane + 64];
}
__device__ __forceinline__ void pre_conv_item(Frame& F, const int ci) {
    const int b = ci / 68, cm = ci % 68, ch0 = 2 * F.tid;
    const bool first = (cm == 0 || cm == 4), last = (cm == 3 || cm == 67);
    float cw[8];
#pragma unroll
    for (int e = 0; e < 2; ++e) { cw[4 * e] = FIN(11)[ch0 + e]; cw[4 * e + 1] = FIN(11)[1024 + ch0 + e]; cw[4 * e + 2] = FIN(11)[2048 + ch0 + e]; cw[4 * e + 3] = FIN(12)[ch0 + e]; }
    const float sc = ch0 >= 512 ? QK_SCALE : 1.f;
    bf16* base = (bf16*)(F.ws + WS_SIN) + SC_MQ + ch0; const bf16* HALOp = (const bf16*)(F.ws + WS_HALO);
    unsigned prev = first ? 0u : *(const unsigned*)(HALOp + (size_t)((ci - 1) * 2 + 1) * 1024 + ch0);
    unsigned cur = *(const unsigned*)(base + (size_t)mlc_row(b, cm, 0) * 4096);
    const unsigned tail = last ? 0u : *(const unsigned*)(HALOp + (size_t)((ci + 1) * 2 + 0) * 1024 + ch0);
#pragma unroll
    for (int bq = 0; bq < 4; ++bq) {
        unsigned nx[16];
#pragma unroll
        for (int i = 0; i < 16; ++i) { const int pp = bq * 16 + i + 1; nx[i] = pp < 64 ? *(const unsigned*)(base + (size_t)mlc_row(b, cm, pp < 64 ? pp : 63) * 4096) : tail; }
#pragma unroll
        for (int i = 0; i < 16; ++i) {
            const float a0 = cw[3] + cw[0] * bf_lo(prev) + cw[1] * bf_lo(cur) + cw[2] * bf_lo(nx[i]);
            const float a1 = cw[7] + cw[4] * bf_hi(prev) + cw[5] * bf_hi(cur) + cw[6] * bf_hi(nx[i]);
            *(unsigned*)(base + (size_t)mlc_row(b, cm, bq * 16 + i) * 4096) = pk2(a0 * __builtin_amdgcn_rcpf(1.f + fexp(-a0)) * sc, a1 * __builtin_amdgcn_rcpf(1.f + fexp(-a1)) * sc);
            prev = cur; cur = nx[i]; }
    }
}

struct GlaPF { v4u q[4], k[4], e[4], v; float et; };
__device__ __forceinline__ int gla_rowbase(int b, int step, int dir) {
    const bool lat = step >= 2; const int chunk = lat ? (dir ? 33 - step : step - 2) : (dir ? 1 - step : step);
    return lat ? b * SEQ + chunk * TC : ML + b * CTXL + chunk * TC;
}
__device__ __forceinline__ void gla_issue(GlaPF& pf, const unsigned char* ws, const int rowbase, const int dir, const int h, const int ocol, const int tid) {
    const int tok0 = tid >> 4, c16 = tid & 15;
    const bf16* qp = (const bf16*)(ws + WS_SIN) + (size_t)(rowbase + tok0) * 4096 + SC_GQ + 128 * h + c16 * 8;
    const bf16* ep = (const bf16*)(ws + WS_EB) + ((size_t)dir * MT + rowbase + tok0) * 512 + 128 * h + c16 * 8;
#pragma unroll
    for (int i = 0; i < 4; ++i) { pf.q[i] = *(const v4u*)(qp + (size_t)i * 32 * 4096); pf.k[i] = *(const v4u*)(qp + (size_t)i * 32 * 4096 + 512); pf.e[i] = *(const v4u*)(ep + (size_t)i * 32 * 512); }
    pf.v = *(const v4u*)((const bf16*)(ws + WS_SIN) + (size_t)(rowbase + (tid >> 2)) * 4096 + SC_GV + ocol + (tid & 3) * 8);
    pf.et = ((const float*)(ws + WS_ET))[(size_t)(dir * NCH + (rowbase >> 7)) * 512 + 128 * h + (tid & 127)];
}
__device__ __forceinline__ void gla_piece(LAS unsigned char* L, const v4u q, const v4u k, const v4u e, const int tok, const int c16) {
    v4u qo, ko;
#pragma unroll
    for (int j = 0; j < 4; ++j) {
        const float e0 = bf_lo(e[j]), e1 = bf_hi(e[j]); const float r0 = __builtin_amdgcn_rcpf(e0), r1 = __builtin_amdgcn_rcpf(e1);
        qo[j] = pk2(bf_lo(q[j]) * QK_SCALE * e0, bf_hi(q[j]) * QK_SCALE * e1);
        ko[j] = pk2(bf_lo(k[j]) * r0, bf_hi(k[j]) * r1);
    }
    *(LAS v4u*)(L + SL_AQ + tok * ST_AQ + c16 * 16) = qo; *(LAS v4u*)(L + SL_AK + tok * ST_AQ + c16 * 16) = ko;
}
__device__ __forceinline__ void gla_substep(LAS unsigned char* L, const unsigned char* ws, bf16* OUT, const int dir, const int rowbase, const bool lat, const bool rmw, const int ocol, const int h,
                                            f32x4 (&S)[2], GlaPF& pf, const int nrowbase, const int ndir, const int tid, const int w, const int lane) {
    const int l15 = lane & 15, quad = lane >> 4;
    { const int tok0 = tid >> 4, c16 = tid & 15;
#pragma unroll
      for (int i = 0; i < 4; ++i) gla_piece(L, pf.q[i], pf.k[i], pf.e[i], tok0 + 32 * i, c16);
      stage_v(L, pf.v, tid);
      if (tid < 128) *(LAS float*)(L + SL_F + tid * 4) = pf.et; }
    gla_issue(pf, ws, nrowbase, ndir, h, ocol, tid);
    SBAR();
    if (lat) {
        const int l = 16 * w + l15; bf16x8 fb[4];
#pragma unroll
        for (int ks = 0; ks < 4; ++ks) fb[ks] = ldf(L + SL_AQ, l, ks * 64 + quad * 16);
#pragma unroll
        for (int half = 0; half < 2; ++half) {
            const bool need = dir == 0 ? (4 * half <= w) : (4 * half + 3 >= w);
            f32x4 sc[4];
            if (need) scores_half(L, fb, half, l15, quad, sc);
#pragma unroll
            for (int mi = 0; mi < 4; ++mi) { const int m0 = (4 * half + mi) * 16 + quad * 4; f32x4 v = need ? sc[mi] : (f32x4){0.f, 0.f, 0.f, 0.f};
#pragma unroll
                for (int r = 0; r < 4; ++r) { const bool keep = dir == 0 ? (m0 + r <= l) : (m0 + r >= l); v[r] = keep ? v[r] : 0.f; }
                *(LAS unsigned long long*)(L + SL_PM + l * ST_AQ + m0 * 2) = pack4(v); }
            SCHED();
        }
        SBAR();
    }
    if (lat) {
        f32x4 o0 = {0.f, 0.f, 0.f, 0.f}, o1 = o0;
        { bf16x8 pb[4], va[2][4];
#pragma unroll
          for (int ks = 0; ks < 4; ++ks) { pb[ks] = ldf(L + SL_PM, 16 * w + l15, ks * 64 + quad * 16); va[0][ks] = ldf(L + SL_VT, l15, ks * 64 + quad * 16); va[1][ks] = ldf(L + SL_VT, 16 + l15, ks * 64 + quad * 16); }
          SCHED();
#pragma unroll
          for (int ks = 0; ks < 4; ++ks) { o0 = MMA16(va[0][ks], pb[ks], o0); o1 = MMA16(va[1][ks], pb[ks], o1); } }
        SCHED();
        { bf16x8 qb[4], sa[2][4];
#pragma unroll
          for (int ks = 0; ks < 4; ++ks) { qb[ks] = ldf(L + SL_AQ, 16 * w + l15, ks * 64 + quad * 16); sa[0][ks] = ldf(L + SL_ST + dir * ST_DIR, l15, ks * 64 + quad * 16); sa[1][ks] = ldf(L + SL_ST + dir * ST_DIR, 16 + l15, ks * 64 + quad * 16); }
          SCHED();
#pragma unroll
          for (int ks = 0; ks < 4; ++ks) { o0 = MMA16(sa[0][ks], qb[ks], o0); o1 = MMA16(sa[1][ks], qb[ks], o1); } }
        bf16* optr = OUT + (size_t)(rowbase + 16 * w + l15) * 1024 + ocol + quad * 4;
        out4(optr, o0, rmw); out4(optr + 16, o1, rmw);
        SCHED();
    }
    {
        bf16x8 kf[4], vf[2][4];
#pragma unroll
        for (int ks = 0; ks < 4; ++ks) { kf[ks] = ldkt(L, 16 * w, ks, l15, quad); vf[0][ks] = ldf(L + SL_VT, l15, ks * 64 + quad * 16); vf[1][ks] = ldf(L + SL_VT, 16 + l15, ks * 64 + quad * 16); }
        const f32x4 dec = *(const LAS f32x4*)(L + SL_F + (16 * w + quad * 4) * 4);
        SCHED();
#pragma unroll
        for (int dvt = 0; dvt < 2; ++dvt) { f32x4 a4 = S[dvt];
#pragma unroll
            for (int ks = 0; ks < 4; ++ks) a4 = MMA16(kf[ks], vf[dvt][ks], a4);
            S[dvt] = a4 * dec; }
    }
    SBAR();
#pragma unroll
    for (int dvt = 0; dvt < 2; ++dvt) *(LAS unsigned long long*)(L + SL_ST + dir * ST_DIR + (dvt * 16 + l15) * ST_AQ + (16 * w + quad * 4) * 2) = pack4(S[dvt]);
}
__device__ __forceinline__ void scan_gla(Frame& F, const int b, const int h, const int slice) {
    LAS unsigned char* L = F.lds; const int tid = F.tid, w = F.wave, lane = F.lane;
    for (int i = tid; i < 2 * ST_DIR / 4; i += 512) ((LAS unsigned*)(L + SL_ST))[i] = 0u;
    f32x4 Sf[2], Sb[2];
#pragma unroll
    for (int i = 0; i < 2; ++i) { Sf[i] = (f32x4){0.f, 0.f, 0.f, 0.f}; Sb[i] = (f32x4){0.f, 0.f, 0.f, 0.f}; }
    const int ocol = 256 * h + 32 * slice; bf16* OUT = (bf16*)F.a->out; const unsigned char* ws = F.ws;
    GlaPF pf; gla_issue(pf, ws, gla_rowbase(b, 0, 0), 0, h, ocol, tid);
    SBAR();
    for (int step = 0; step < NSTEP; ++step) {
        const bool lat = step >= 2, rmw = step >= 18; const int ns = step < NSTEP - 1 ? step + 1 : NSTEP - 1;
        gla_substep(L, ws, OUT, 0, gla_rowbase(b, step, 0), lat, rmw, ocol, h, Sf, pf, gla_rowbase(b, step, 1), 1, tid, w, lane);
        gla_substep(L, ws, OUT, 1, gla_rowbase(b, step, 1), lat, rmw, ocol, h, Sb, pf, gla_rowbase(b, ns, 0), 0, tid, w, lane);
        if (step == 17) { VM_WAIT(); SBAR(); }
    }
    VM_WAIT(); SBAR();
}

struct MlPF { v4u q[4], k[4], v; float gb, ga, gx, gt, gm; };
__device__ __forceinline__ void ml_issue(MlPF& pf, const unsigned char* ws, const int b, const int cs, const int dir, const int h, const int ocol, const int tid) {
    const int tok0 = tid >> 4, c16 = tid & 15; const bf16* SINp = (const bf16*)(ws + WS_SIN);
#pragma unroll
    for (int i = 0; i < 4; ++i) { const bf16* qp = SINp + (size_t)ml_row(b, cs, tok0 + 32 * i) * 4096 + SC_MQ + 128 * h + c16 * 8; pf.q[i] = *(const v4u*)qp; pf.k[i] = *(const v4u*)(qp + 512); }
    pf.v = *(const v4u*)(SINp + (size_t)ml_row(b, cs, tid >> 2) * 4096 + SC_MV + ocol + (tid & 3) * 8);
    const float* gv = (const float*)(ws + WS_GV) + (size_t)(((dir * 4 + b) * 4 + h) * NSTEP + cs) * 400; const int t = tid & 127;
    pf.gb = gv[t]; pf.ga = gv[128 + t]; pf.gx = gv[256 + t]; pf.gt = gv[384]; pf.gm = gv[385];
}
__device__ __forceinline__ void mlstm_substep(LAS unsigned char* L, const unsigned char* ws, bf16* OUT, const int dir, const int b, const int cs, const bool lat, const bool rmw, const int ocol, const int h,
                                              f32x4 (&C)[3], float& mrun, MlPF& pf, const int ncs, const int ndir, const int tid, const int w, const int lane) {
    const int l15 = lane & 15, quad = lane >> 4;
    LAS float* Fp = (LAS float*)(L + SL_F);
    { const int tok0 = tid >> 4, c16 = tid & 15;
#pragma unroll
      for (int i = 0; i < 4; ++i) { *(LAS v4u*)(L + SL_AQ + (tok0 + 32 * i) * ST_AQ + c16 * 16) = pf.q[i]; *(LAS v4u*)(L + SL_AK + (tok0 + 32 * i) * ST_AQ + c16 * 16) = pf.k[i]; } }
    const v4u myv = pf.v;
    stage_v(L, myv, tid);
    {
        const float m = mrun, total = pf.gt, mnew = total + fmaxf(m, pf.gm);
        if (tid < 128) { const float bv = pf.gb, av = pf.ga, mq = bv + fmaxf(m, pf.gx);
            Fp[tid] = bv - mq; Fp[128 + tid] = av; Fp[256 + tid] = fexp(-mq); Fp[384 + tid] = fexp(bv + m - mq); Fp[512 + tid] = fexp(total + av - mnew);
            if (tid == 0) Fp[640] = fexp(total + m - mnew); }
        mrun = mnew;
    }
    ml_issue(pf, ws, b, ncs, ndir, h, ocol, tid);
    SBAR();
    {
        const int tok = tid >> 2, dv8 = (tid & 3) * 8; const float wk = Fp[512 + tok];
        LAS unsigned char* p = L + SL_VW + dv8 * ST_AQ + tok * 2;
#pragma unroll
        for (int j = 0; j < 4; ++j) { st_lds16(p + (2 * j) * ST_AQ, bf_lo(myv[j]) * wk); st_lds16(p + (2 * j + 1) * ST_AQ, bf_hi(myv[j]) * wk); }
        if (tid < 128) st_lds16(L + SL_VW + 32 * ST_AQ + tid * 2, Fp[512 + tid]);
    }
    if (lat) {
        const int l = 16 * w + l15; const float rowt = Fp[l]; bf16x8 fb[4];
#pragma unroll
        for (int ks = 0; ks < 4; ++ks) fb[ks] = ldf(L + SL_AQ, l, ks * 64 + quad * 16);
#pragma unroll
        for (int half = 0; half < 2; ++half) {
            const bool need = dir == 0 ? (4 * half <= w) : (4 * half + 3 >= w);
            f32x4 sc[4];
            if (need) scores_half(L, fb, half, l15, quad, sc);
#pragma unroll
            for (int mi = 0; mi < 4; ++mi) { const int m0 = (4 * half + mi) * 16 + quad * 4; f32x4 v = need ? sc[mi] : (f32x4){0.f, 0.f, 0.f, 0.f}; const f32x4 av = *(const LAS f32x4*)(Fp + 128 + m0);
#pragma unroll
                for (int r = 0; r < 4; ++r) { const bool keep = need && (dir == 0 ? (m0 + r <= l) : (m0 + r >= l)); v[r] = keep ? v[r] * fexp(rowt + av[r]) : 0.f; }
                *(LAS unsigned long long*)(L + SL_PM + l * ST_AQ + m0 * 2) = pack4(v); }
            SCHED();
        }
    }
    SBAR();
    if (lat) {
        f32x4 n0 = {0.f, 0.f, 0.f, 0.f}, n1 = n0, nd = n0, i0 = n0, i1 = n0, id = n0;
#pragma unroll
        for (int kh = 0; kh < 2; ++kh) { bf16x8 pb[2], va[3][2];
#pragma unroll
          for (int k2 = 0; k2 < 2; ++k2) { const int kb = (2 * kh + k2) * 64 + quad * 16; pb[k2] = ldf(L + SL_PM, 16 * w + l15, kb); va[0][k2] = ldf(L + SL_VT, l15, kb); va[1][k2] = ldf(L + SL_VT, 16 + l15, kb); va[2][k2] = ldf(L + SL_VT, 32, kb); }
          SCHED();
#pragma unroll
          for (int k2 = 0; k2 < 2; ++k2) { n0 = MMA16(va[0][k2], pb[k2], n0); n1 = MMA16(va[1][k2], pb[k2], n1); nd = MMA16(va[2][k2], pb[k2], nd); }
          SCHED(); }
        { LAS unsigned char* STp = L + SL_ST + dir * ST_DIR;
#pragma unroll
          for (int kh = 0; kh < 2; ++kh) { bf16x8 qb[2], sa[3][2];
#pragma unroll
            for (int k2 = 0; k2 < 2; ++k2) { const int kb = (2 * kh + k2) * 64 + quad * 16; qb[k2] = ldf(L + SL_AQ, 16 * w + l15, kb); sa[0][k2] = ldf(STp, l15, kb); sa[1][k2] = ldf(STp, 16 + l15, kb); sa[2][k2] = ldf(STp, 32, kb); }
            SCHED();
#pragma unroll
            for (int k2 = 0; k2 < 2; ++k2) { i0 = MMA16(sa[0][k2], qb[k2], i0); i1 = MMA16(sa[1][k2], qb[k2], i1); id = MMA16(sa[2][k2], qb[k2], id); }
            SCHED(); } }
        const int tok = 16 * w + l15; const float wi = Fp[384 + tok], flo = Fp[256 + tok];
        const float den = nd[0] + wi * id[0];
        const float inv = __builtin_amdgcn_rcpf(fmaxf(fabsf(den), flo));
        bf16* optr = OUT + (size_t)ml_row(b, cs, tok) * 1024 + ocol + quad * 4;
        out4(optr, (n0 + i0 * wi) * inv, rmw); out4(optr + 16, (n1 + i1 * wi) * inv, rmw);
        SCHED();
    }
    {
        const float decay = Fp[640];
#pragma unroll
        for (int dvt = 0; dvt < 3; ++dvt) C[dvt] = C[dvt] * decay;
#pragma unroll
        for (int kh = 0; kh < 2; ++kh) { bf16x8 kf[2], vf[3][2];
#pragma unroll
            for (int k2 = 0; k2 < 2; ++k2) { const int ks = 2 * kh + k2, kb = ks * 64 + quad * 16; kf[k2] = ldkt(L, 16 * w, ks, l15, quad); vf[0][k2] = ldf(L + SL_VW, l15, kb); vf[1][k2] = ldf(L + SL_VW, 16 + l15, kb); vf[2][k2] = ldf(L + SL_VW, 32, kb); }
            SCHED();
#pragma unroll
            for (int dvt = 0; dvt < 3; ++dvt)
#pragma unroll
                for (int k2 = 0; k2 < 2; ++k2) C[dvt] = MMA16(kf[k2], vf[dvt][k2], C[dvt]);
            SCHED(); }
    }
    SBAR();
#pragma unroll
    for (int dvt = 0; dvt < 2; ++dvt) *(LAS unsigned long long*)(L + SL_ST + dir * ST_DIR + (dvt * 16 + l15) * ST_AQ + (16 * w + quad * 4) * 2) = pack4(C[dvt]);
    if (l15 == 0) *(LAS unsigned long long*)(L + SL_ST + dir * ST_DIR + 32 * ST_AQ + (16 * w + quad * 4) * 2) = pack4(C[2]);
}
__device__ __forceinline__ void scan_mlstm(Frame& F, const int b, const int h, const int slice) {
    LAS unsigned char* L = F.lds; const int tid = F.tid, w = F.wave, lane = F.lane;
    if (tid < 128) *(LAS unsigned short*)(L + SL_VT + 32 * ST_AQ + tid * 2) = (unsigned short)0x3F80;
    for (int i = tid; i < 2 * ST_DIR / 4; i += 512) ((LAS unsigned*)(L + SL_ST))[i] = 0u;
    f32x4 Cf[3], Cb[3];
#pragma unroll
    for (int i = 0; i < 3; ++i) { Cf[i] = (f32x4){0.f, 0.f, 0.f, 0.f}; Cb[i] = (f32x4){0.f, 0.f, 0.f, 0.f}; }
    float mf = 0.f, mb = 0.f;
    const int ocol = 256 * h + 32 * slice; bf16* OUT = (bf16*)F.a->out + (size_t)ML * D; const unsigned char* ws = F.ws;
    MlPF pf; ml_issue(pf, ws, b, 0, 0, h, ocol, tid);
    SBAR();
    for (int step = 0; step < NSTEP; ++step) {
        const bool lat = step >= 2, rmw = step >= 18;
        const int csf = step, csb = lat ? 35 - step : 1 - step;
        const int ns = step < NSTEP - 1 ? step + 1 : NSTEP - 1;
        mlstm_substep(L, ws, OUT, 0, b, csf, lat, rmw, ocol, h, Cf, mf, pf, csb, 1, tid, w, lane);
        mlstm_substep(L, ws, OUT, 1, b, csb, lat, rmw, ocol, h, Cb, mb, pf, ns, 0, tid, w, lane);
        if (step == 17) { VM_WAIT(); SBAR(); }
    }
    VM_WAIT(); SBAR();
}
struct MergeOrder {
    int pm, pn; bool valid;
    __device__ __forceinline__ bool next(int i, pg8::Unit& u) const {
        if (!valid || i >= 4) return false;
        u.pm = pm + (i == 0 ? 68 : (i == 2 ? 132 : 0));
        u.pn = pn + (i == 0 ? WT_BR1 : (i == 1 ? WT_MRG1 : (i == 2 ? WT_BR2 : WT_MRG2)));
        return true;
    }
    __device__ __forceinline__ void a_ready(const pg8::Unit&) const {}
    __device__ __forceinline__ void done(const pg8::Unit&) const {}
};

__global__ void __launch_bounds__(NWAVES * 64, 2) mk_fwd(Args args) {
    extern __shared__ __attribute__((aligned(16))) unsigned char lds[];
    Frame F;
    F.lds = (LAS unsigned char*)lds;
    F.MISC = (volatile LAS unsigned*)(F.lds + MISC_OFF);
    F.tid = threadIdx.x; F.lane = F.tid & 63; F.wave = __builtin_amdgcn_readfirstlane(F.tid >> 6);
    F.G = gridDim.x; { const int bx = blockIdx.x; F.vcu = (F.G % 8 == 0) ? (bx % 8) * (F.G / 8) + bx / 8 : bx; }
    F.ctl = (gu32*)(args.ws + WS_CTL);
    F.a = (KArgsPtr)__builtin_amdgcn_kernarg_segment_ptr(); F.ws = F.a->ws;
    for (int u = F.tid; u < (LDS_BYTES - LDSCTL_OFF) / 4; u += NWAVES * 64) ((LAS unsigned*)(F.lds + LDSCTL_OFF))[u] = 0u;
    __syncthreads();
    XcdBarrier bar; bar.bar = (unsigned*)(F.ctl + CW_BAR); bar.x = 0; bar.st = nullptr;
    if (N_LAUNCHES != PER_PHASE) bar = xcd_barrier_post((unsigned*)(F.ctl + CW_BAR), F.MISC + 8);
#define GRID_BAR(seam) do { if (N_LAUNCHES == PER_PHASE) { if (F.tid == 0) __hip_atomic_store(F.ctl + CW_TMO, 0xBADBA0u | (unsigned)(seam), RLX_AGENT); } else { xcd_barrier(bar); } } while (0)
    const int lo = args.ph_lo, hi = args.ph_hi;
#define IN(k) (lo <= (k) && (k) < hi)
#define BOTH(k) (IN(k) && IN((k) + 1))
    const int gw = F.vcu * NWAVES + F.wave, NGW = F.G * NWAVES;

    if (IN(0)) { p0_prologue(F); if (BOTH(0)) GRID_BAR(0); }

    if (IN(1)) for (int rep = 0; rep <= ((MK_DUP >> 1) & 1); ++rep) { if (rep) GRID_BAR(100 + 1);
        for (int m = gw; m < MT; m += NGW) {
            const float* src = m < ML ? FIN(0) + (size_t)m * D : FIN(2) + (size_t)(m - ML) * D;
            const float* mod = ((float*)(F.ws + WS_CTL + CTL_MOD)) + (size_t)(m < ML ? (m >> 12) : 4) * 6144;
            norm_mod_row(F, src, -1.f, FIN(6), mod, mod + D, ((bf16*)(F.ws + WS_XN)) + (size_t)m * D);
        }
        if (rep == ((MK_DUP >> 1) & 1) && BOTH(1)) GRID_BAR(1);
    }

    if (IN(2)) for (int rep = 0; rep <= ((MK_DUP >> 2) & 1); ++rep) { if (rep) GRID_BAR(100 + 2);
        pg8::Gemm g{((bf16*)(F.ws + WS_XN)), ((bf16*)(F.ws + WS_WT)), MT, 17 * 256, D}; pg8::StaticOrder S; S.init(MT, 17 * 256, F.G, (int)blockIdx.x);
        pg8::EpiScanIn E{((bf16*)(F.ws + WS_SIN)), ((float*)(F.ws + WS_SMALL))};
        pg8::gemm_phase<pg8::EpiScanIn, pg8::StaticOrder, true, true>(F.lds + RING_OFF, g, S, E);
        if (rep == ((MK_DUP >> 2) & 1) && BOTH(2)) GRID_BAR(2);
    }

    if (IN(3)) {
        for (int it = F.vcu; it < 16 * NSTEP; it += F.G) pre_gla_item(F, it);
        for (int it = gw; it < 544 + 2 * 16 * NSTEP; it += NGW) { if (it < 544) pre_halo_item(F, it); else pre_gate_item(F, it - 544); }
        GRID_BAR(30);
        for (int it = F.vcu; it < 272; it += F.G) pre_conv_item(F, it);
        GRID_BAR(31);
        for (int u = F.vcu; u < 256; u += F.G) {
            const int mixer = u >> 7, bh = (u >> 3) & 15, b = bh >> 2, h = bh & 3, slice = u & 7;
            if (mixer == 0) scan_gla(F, b, h, slice); else scan_mlstm(F, b, h, slice);
        }
        if (BOTH(3)) GRID_BAR(3);
    }

    if (IN(4)) for (int rep = 0; rep <= ((MK_DUP >> 4) & 1); ++rep) { if (rep) GRID_BAR(100 + 4);
        pg8::Gemm g{((bf16*)(F.ws + WS_XN)), ((bf16*)(F.ws + WS_WT)) + (size_t)WT_OG * 256 * D, ML, 2048, D}; pg8::StaticOrder S; S.init(ML, 2048, F.G, (int)blockIdx.x);
        pg8::EpiOutGate E{(const bf16*)((float*)F.a->out), (const bf16*)((float*)F.a->out) + (size_t)ML * D, FIN(10), FIN(14), ((bf16*)(F.ws + WS_Y1)), ((bf16*)(F.ws + WS_Y2)), (LAS float*)(F.lds + EPI_ST_OFF)};
        pg8::gemm_phase<pg8::EpiOutGate, pg8::StaticOrder, true, true>(F.lds + RING_OFF, g, S, E);
        if (rep == ((MK_DUP >> 4) & 1) && BOTH(4)) GRID_BAR(4);
    }

    if (IN(5)) for (int rep = 0; rep <= ((MK_DUP >> 5) & 1); ++rep) { if (rep) GRID_BAR(100 + 5);
        pg8::StaticOrder SO; SO.init(ML, D, F.G, (int)blockIdx.x);
        pg8::Gemm g{((bf16*)(F.ws + WS_XN)), ((bf16*)(F.ws + WS_WT)), MT + 2 * ML, WT_TILES * 256, D};
        pg8::EpiMerge E{((float*)F.a->out), ((float*)(F.ws + WS_T2)), ((bf16*)(F.ws + WS_Y))};
        for (int r = 0;; ++r) { pg8::Unit t; MergeOrder S; S.valid = SO.next(r, t); if (!S.valid) break; S.pm = t.pm; S.pn = t.pn;
            pg8::gemm_phase<pg8::EpiMerge, MergeOrder, true, true>(F.lds + RING_OFF, g, S, E); }
        if (rep == ((MK_DUP >> 5) & 1) && BOTH(5)) GRID_BAR(5);
    }

    if (IN(6)) {
        pg8::Gemm g{((bf16*)(F.ws + WS_Y)), ((bf16*)(F.ws + WS_WT)) + (size_t)WT_OUT * 256 * D, ML, D, D}; pg8::StaticOrder S; S.init(ML, D, F.G, (int)blockIdx.x);
        pg8::EpiResid E{FIN(0), ((float*)F.a->out), ((float*)(F.ws + WS_CTL + CTL_MOD)), 2, ((float*)(F.ws + WS_CTL + CTL_SS1))};
        pg8::gemm_phase<pg8::EpiResid, pg8::StaticOrder, true, true>(F.lds + RING_OFF, g, S, E);
        if (BOTH(6)) GRID_BAR(6);
    }

    if (IN(7)) {
        for (int m = gw; m < ML; m += NGW) {
            const float* mod = ((float*)(F.ws + WS_CTL + CTL_MOD)) + (size_t)(m >> 12) * 6144;
            const float ss = __hip_atomic_load(((float*)(F.ws + WS_CTL + CTL_SS1)) + m, RLX_AGENT);
            norm_mod_row(F, ((float*)F.a->out) + (size_t)m * D, ss, FIN(18), mod + 3 * D, mod + 4 * D, ((bf16*)(F.ws + WS_XN)) + (size_t)m * D);
        }
        if (BOTH(7)) GRID_BAR(7);
    }

    if (IN(8)) for (int rep = 0; rep <= ((MK_DUP >> 8) & 1); ++rep) { if (rep) GRID_BAR(100 + 8);
        pg8::Gemm g{((bf16*)(F.ws + WS_XN)), ((bf16*)(F.ws + WS_WT)) + (size_t)WT_FFN1 * 256 * D, ML, 2 * DFF, D}; pg8::StaticOrder S; S.init(ML, 2 * DFF, F.G, (int)blockIdx.x);
        pg8::EpiSwiglu E{((bf16*)(F.ws + WS_HF))};
        pg8::gemm_phase<pg8::EpiSwiglu, pg8::StaticOrder, true, true>(F.lds + RING_OFF, g, S, E);
        if (rep == ((MK_DUP >> 8) & 1) && BOTH(8)) GRID_BAR(8);
    }

    if (IN(9)) {
        pg8::Gemm g{((bf16*)(F.ws + WS_HF)), ((bf16*)(F.ws + WS_W2T)), ML, D, DFF}; pg8::StaticOrder S; S.init(ML, D, F.G, (int)blockIdx.x);
        pg8::EpiResid E{((float*)F.a->out), ((float*)F.a->out), ((float*)(F.ws + WS_CTL + CTL_MOD)), 5, ((float*)(F.ws + WS_CTL + CTL_SS2))};
        pg8::gemm_phase<pg8::EpiResid, pg8::StaticOrder, true, true>(F.lds + RING_OFF, g, S, E);
        if (BOTH(9)) GRID_BAR(9);
    }

    if (IN(10)) {
        for (int m = gw; m < ML; m += NGW) {
            const float ss = __hip_atomic_load(((float*)(F.ws + WS_CTL + CTL_SS2)) + m, RLX_AGENT);
            const float rstd = 1.f / sqrtf(ss * (1.f / D) + RMS_EPS);
            GAS f32x4* xr = (GAS f32x4*)(((float*)F.a->out) + (size_t)m * D) + F.lane;
#pragma unroll
            for (int j = 0; j < 4; ++j) { const f32x4 gv = ((const GAS f32x4*)FIN(21))[F.lane + 64 * j]; xr[64 * j] = xr[64 * j] * rstd * gv; }
        }
    }
#undef IN
#undef BOTH
}

extern "C" void kernel_launch(void* const* d_in, const int* in_sizes, int n_in, void* d_out, int out_size, void* d_ws, size_t ws_size, hipStream_t stream) {
    static int grid = 0;
    if (grid == 0) {
        if (n_in != 22 || in_sizes[0] != ML * D || out_size != ML * D || ws_size < WS_END) { fprintf(stderr, "kernel_launch: unexpected shapes (n_in %d, in0 %d, out %d, ws %zu)\n", n_in, n_in > 0 ? in_sizes[0] : -1, out_size, ws_size); grid = -1; return; }
        int dev = 0, cus = 0;
        if (hipGetDevice(&dev) != hipSuccess || hipDeviceGetAttribute(&cus, hipDeviceAttributeMultiprocessorCount, dev) != hipSuccess) { grid = -1; return; }
        if (hipFuncSetAttribute((const void*)mk_fwd, hipFuncAttributeMaxDynamicSharedMemorySize, LDS_BYTES) != hipSuccess) { fprintf(stderr, "kernel_launch: hipFuncSetAttribute failed\n"); grid = -1; return; }
        int per_cu = 0;
        if (hipOccupancyMaxActiveBlocksPerMultiprocessor(&per_cu, (const void*)mk_fwd, NWAVES * 64, LDS_BYTES) != hipSuccess || per_cu < 1) fprintf(stderr, "kernel_launch: occupancy query reports %d\n", per_cu);
        (void)hipGetLastError();
        grid = cus;
    }
    if (grid < 0) return;
    if (hipMemsetAsync((char*)d_ws + WS_CTL, 0, CTL_ZERO_BYTES, stream) != hipSuccess) return;
    Args a{};
    for (int i = 0; i < 22; ++i) a.in[i] = (const float*)d_in[i];
    a.out = (float*)d_out; a.ws = (unsigned char*)d_ws;
    for (int li = 0; li < N_LAUNCHES; ++li) {
        a.ph_lo = (N_LAUNCHES == PER_PHASE) ? li : 0; a.ph_hi = (N_LAUNCHES == PER_PHASE) ? li + 1 : PER_PHASE; a.li = li;
        hipLaunchKernelGGL(mk_fwd, dim3(grid), dim3(NWAVES * 64), LDS_BYTES, stream, a);
    }
}
```
